# Optimizing an MI355X kernel written in HIP

```python
import math
import jax, jax.numpy as jnp
from jax import lax
import numpy as np

D_MODEL = 2048
BATCH = 4
SEQ = 2048
DEPTH = 1

D_MIX = D_MODEL
D_ATTN = D_MIX // 2
N_HEADS = 8
HEAD_DIM = D_ATTN // N_HEADS
D_SSM = D_MIX - D_ATTN
SSM_GROUP = 16
N_SSM_GROUPS = D_SSM // SSM_GROUP
SSM_STATE = 64
DT_MIN = 1e-3
DT_MAX = 1e-1
Q_BLOCK = 128
N_EXPERTS = 64
TOP_K = 6
D_EXPERT = 512
D_SHARED = 512
ROUTED_SCALE = 2.5
MOE_BLOCK = 128
D_PLE = 256
NORM_EPS = 1e-6

kernel_name = 'hybrid_sba_s5_moe_block'


def rmsnorm(x, g):
    xf = x.astype(jnp.float32)
    y = xf * lax.rsqrt(jnp.mean(xf * xf, axis=-1, keepdims=True) + NORM_EPS)
    return (y * g.astype(jnp.float32)).astype(x.dtype)


def stick_breaking_attention(q, k, v):
    q = q.astype(jnp.float32)
    k = k.astype(jnp.float32)
    v = v.astype(jnp.float32)
    seq = q.shape[2]
    scale = 1.0 / math.sqrt(q.shape[-1])
    outs = []
    for blk in range(seq // Q_BLOCK):
        q0 = blk * Q_BLOCK
        q1 = q0 + Q_BLOCK
        qb = q[:, :, q0:q1]
        kb = k[:, :, :q1]
        vb = v[:, :, :q1]
        z = jnp.einsum('bhqd,bhkd->bhqk', qb, kb) * scale
        t_pos = jnp.arange(q0, q1)[:, None]
        s_pos = jnp.arange(q1)[None, :]
        causal = s_pos < t_pos
        sp = jnp.where(causal, jax.nn.softplus(z), 0.0)
        after = lax.cumsum(sp, axis=3, reverse=True) - sp
        w = jnp.where(causal, jnp.exp(jax.nn.log_sigmoid(z) - after), 0.0)
        outs.append(jnp.einsum('bhqk,bhkd->bhqd', w, vb))
    return jnp.concatenate(outs, axis=2)


def s5_groups(u, lam_re, lam_im, log_dt, b_re, b_im, c_re, c_im, d_skip):
    u = u.astype(jnp.float32)
    lam_re = lam_re.astype(jnp.float32)
    lam_im = lam_im.astype(jnp.float32)
    dt = jnp.exp(log_dt.astype(jnp.float32))[:, None]
    mag = jnp.exp(lam_re * dt)
    ang = lam_im * dt
    abar_re = mag * jnp.cos(ang)
    abar_im = mag * jnp.sin(ang)
    nr = abar_re - 1.0
    ni = abar_im
    den = lam_re * lam_re + lam_im * lam_im
    coef_re = ((nr * lam_re + ni * lam_im) / den)[..., None]
    coef_im = ((ni * lam_re - nr * lam_im) / den)[..., None]
    b_re = b_re.astype(jnp.float32)
    b_im = b_im.astype(jnp.float32)
    bbar_re = coef_re * b_re - coef_im * b_im
    bbar_im = coef_re * b_im + coef_im * b_re
    bu_re = jnp.einsum('bsgh,gph->bsgp', u, bbar_re)
    bu_im = jnp.einsum('bsgh,gph->bsgp', u, bbar_im)
    seq = u.shape[1]
    a_re = jnp.broadcast_to(abar_re[None, None], (1, seq) + abar_re.shape)
    a_im = jnp.broadcast_to(abar_im[None, None], (1, seq) + abar_im.shape)

    def combine(left, right):
        a1r, a1i, b1r, b1i = left
        a2r, a2i, b2r, b2i = right
        return (a2r * a1r - a2i * a1i,
                a2r * a1i + a2i * a1r,
                a2r * b1r - a2i * b1i + b2r,
                a2r * b1i + a2i * b1r + b2i)

    _, _, x_re, x_im = lax.associative_scan(combine, (a_re, a_im, bu_re, bu_im), axis=1)
    y = (jnp.einsum('bsgp,ghp->bsgh', x_re, c_re.astype(jnp.float32))
         - jnp.einsum('bsgp,ghp->bsgh', x_im, c_im.astype(jnp.float32))
         + d_skip.astype(jnp.float32) * u)
    return y


def swiglu(x, wg, wu, wd):
    return (jax.nn.silu(x @ wg) * (x @ wu)) @ wd


def routed_moe(xf, w_router, router_bias, wg, wu, wd):
    T, D = xf.shape
    scores = jax.nn.sigmoid((xf @ w_router).astype(jnp.float32))
    _, idx = lax.top_k(scores + router_bias.astype(jnp.float32), TOP_K)
    gate = jnp.take_along_axis(scores, idx, axis=1)
    gate = gate / jnp.sum(gate, axis=1, keepdims=True) * ROUTED_SCALE
    n_assign = T * TOP_K
    flat_e = idx.reshape(-1)
    flat_tok = (jnp.arange(n_assign, dtype=jnp.int32) // TOP_K).astype(jnp.int32)
    flat_w = gate.reshape(-1)
    order = jnp.argsort(flat_e)
    se = flat_e[order]
    stok = flat_tok[order]
    sw = flat_w[order]
    counts = jnp.bincount(flat_e, length=N_EXPERTS).astype(jnp.int32)
    start = jnp.cumsum(counts) - counts
    pcounts = (counts + MOE_BLOCK - 1) // MOE_BLOCK * MOE_BLOCK
    pend = jnp.cumsum(pcounts)
    pstart = pend - pcounts
    dest = pstart[se] + jnp.arange(n_assign, dtype=jnp.int32) - start[se]
    n_pad = n_assign + N_EXPERTS * MOE_BLOCK
    n_blocks = n_pad // MOE_BLOCK
    buf_tok = jnp.full((n_pad,), T, dtype=jnp.int32).at[dest].set(stok)
    buf_w = jnp.zeros((n_pad,), jnp.float32).at[dest].set(sw)
    blk_start = jnp.arange(n_blocks, dtype=jnp.int32) * MOE_BLOCK
    blk_e = jnp.minimum(jnp.searchsorted(pend, blk_start, side='right'), N_EXPERTS - 1)
    x_pad = jnp.concatenate([xf, jnp.zeros((1, D), xf.dtype)], axis=0)

    def body(acc, blk):
        tok, w, e = blk
        xb = x_pad[tok]
        hb = jax.nn.silu(xb @ wg[e]) * (xb @ wu[e])
        yb = (hb @ wd[e]) * w[:, None].astype(xb.dtype)
        return acc.at[tok].add(yb.astype(acc.dtype)), None

    acc, _ = lax.scan(body, jnp.zeros((T + 1, D), xf.dtype),
                      (buf_tok.reshape(n_blocks, MOE_BLOCK), buf_w.reshape(n_blocks, MOE_BLOCK), blk_e))
    return acc[:T]


def setup_inputs(seed: int = 0) -> dict:
    key = jax.random.key(seed)
    ks = jax.random.split(key, 32)
    L, D, G, H, P = DEPTH, D_MODEL, N_SSM_GROUPS, SSM_GROUP, SSM_STATE
    nrm = lambda k, shape, s: jax.random.normal(k, shape, jnp.float32) * s
    gain = lambda k, shape: 1.0 + 0.02 * jax.random.normal(k, shape, jnp.float32)
    n_idx = jnp.arange(P, dtype=jnp.float32)
    return {
        'x': nrm(ks[0], (BATCH, SEQ, D), 1.0),
        'p': nrm(ks[1], (DEPTH, BATCH, SEQ, D_PLE), 1.0),
        'norm_mix': gain(ks[2], (L, D)),
        'w_in': nrm(ks[3], (L, D, 3 * D_ATTN + D_SSM), D ** -0.5),
        'q_norm': gain(ks[4], (L, HEAD_DIM)),
        'k_norm': gain(ks[5], (L, HEAD_DIM)),
        'ssm_lam_re': -0.5 + 0.01 * jax.random.normal(ks[6], (L, G, P), jnp.float32),
        'ssm_lam_im': math.pi * n_idx[None, None, :] + 0.01 * jax.random.normal(ks[7], (L, G, P), jnp.float32),
        'ssm_log_dt': jax.random.uniform(ks[8], (L, G), jnp.float32, math.log(DT_MIN), math.log(DT_MAX)),
        'ssm_b_re': nrm(ks[9], (L, G, P, H), (2.0 * H) ** -0.5),
        'ssm_b_im': nrm(ks[10], (L, G, P, H), (2.0 * H) ** -0.5),
        'ssm_c_re': nrm(ks[11], (L, G, H, P), (2.0 * P) ** -0.5),
        'ssm_c_im': nrm(ks[12], (L, G, H, P), (2.0 * P) ** -0.5),
        'ssm_d': nrm(ks[13], (L, G, H), 0.5),
        'w_glu': nrm(ks[14], (L, D_SSM, D_SSM), D_SSM ** -0.5),
        'attn_out_norm': gain(ks[15], (L, D_ATTN)),
        'ssm_out_norm': gain(ks[16], (L, D_SSM)),
        'w_out': nrm(ks[17], (L, D_MIX, D), D_MIX ** -0.5),
        'norm_ffn': gain(ks[18], (L, D)),
        'w_router': nrm(ks[19], (L, D, N_EXPERTS), D ** -0.5),
        'router_bias': nrm(ks[20], (L, N_EXPERTS), 0.01),
        'w_exp_gate': nrm(ks[21], (L, N_EXPERTS, D, D_EXPERT), D ** -0.5),
        'w_exp_up': nrm(ks[22], (L, N_EXPERTS, D, D_EXPERT), D ** -0.5),
        'w_exp_down': nrm(ks[23], (L, N_EXPERTS, D_EXPERT, D), D_EXPERT ** -0.5),
        'w_sh_gate': nrm(ks[24], (L, D, D_SHARED), D ** -0.5),
        'w_sh_up': nrm(ks[25], (L, D, D_SHARED), D ** -0.5),
        'w_sh_down': nrm(ks[26], (L, D_SHARED, D), D_SHARED ** -0.5),
        'norm_ple': gain(ks[27], (L, D)),
        'w_ple_gate': nrm(ks[28], (L, D, D), D ** -0.5),
        'w_ple_proj': nrm(ks[29], (L, D_PLE, D), D_PLE ** -0.5),
    }


def reference(x, p, norm_mix, w_in, q_norm, k_norm, ssm_lam_re, ssm_lam_im, ssm_log_dt,
              ssm_b_re, ssm_b_im, ssm_c_re, ssm_c_im, ssm_d, w_glu, attn_out_norm, ssm_out_norm,
              w_out, norm_ffn, w_router, router_bias, w_exp_gate, w_exp_up, w_exp_down,
              w_sh_gate, w_sh_up, w_sh_down, norm_ple, w_ple_gate, w_ple_proj):
    bsz, seq, _ = x.shape
    h = x
    for i in range(DEPTH):
        a = rmsnorm(h, norm_mix[i])
        z = a @ w_in[i]
        q, k, v, u = jnp.split(z, [D_ATTN, 2 * D_ATTN, 3 * D_ATTN], axis=-1)
        q = rmsnorm(q.reshape(bsz, seq, N_HEADS, HEAD_DIM), q_norm[i])
        k = rmsnorm(k.reshape(bsz, seq, N_HEADS, HEAD_DIM), k_norm[i])
        v = v.reshape(bsz, seq, N_HEADS, HEAD_DIM)
        o_attn = stick_breaking_attention(q.transpose(0, 2, 1, 3), k.transpose(0, 2, 1, 3),
                                          v.transpose(0, 2, 1, 3))
        o_attn = o_attn.transpose(0, 2, 1, 3).reshape(bsz, seq, D_ATTN).astype(x.dtype)
        y = s5_groups(u.reshape(bsz, seq, N_SSM_GROUPS, SSM_GROUP), ssm_lam_re[i], ssm_lam_im[i],
                      ssm_log_dt[i], ssm_b_re[i], ssm_b_im[i], ssm_c_re[i], ssm_c_im[i], ssm_d[i])
        y = jax.nn.gelu(y.reshape(bsz, seq, D_SSM)).astype(x.dtype)
        y = y * jax.nn.sigmoid(y @ w_glu[i])
        mix = jnp.concatenate([rmsnorm(o_attn, attn_out_norm[i]), rmsnorm(y, ssm_out_norm[i])], axis=-1)
        h = h + mix @ w_out[i]
        m = rmsnorm(h, norm_ffn[i]).reshape(bsz * seq, D_MODEL)
        ffn = (routed_moe(m, w_router[i], router_bias[i], w_exp_gate[i], w_exp_up[i], w_exp_down[i])
               + swiglu(m, w_sh_gate[i], w_sh_up[i], w_sh_down[i]))
        h = h + ffn.reshape(bsz, seq, D_MODEL)
        gate = jax.nn.sigmoid(rmsnorm(h, norm_ple[i]) @ w_ple_gate[i])
        h = h + gate * (p[i] @ w_ple_proj[i])
    return h
```

```cpp
#include <hip/hip_runtime.h>
#include <cstdio>
#include <cstdint>
#include <cstring>

#ifndef MK_LAUNCHES
#define MK_LAUNCHES 1
#endif

#ifndef REP_PHASE
#define REP_PHASE -1
#endif
#define LAS __attribute__((address_space(3)))
typedef unsigned short bf16_t;
typedef short bf16x8 __attribute__((ext_vector_type(8)));
typedef short s16x4 __attribute__((ext_vector_type(4)));
typedef float f32x4 __attribute__((ext_vector_type(4)));
typedef float f32x16 __attribute__((ext_vector_type(16)));
typedef unsigned u32x4 __attribute__((ext_vector_type(4)));
typedef unsigned u32x2 __attribute__((ext_vector_type(2)));

#define XB_TMO      128
#define XB_XCNT(j)  (256  + 64 * (j))
#define XB_XSUB(j)  (1280 + 64 * (j))
#define XB_XGEN(j)  (2304 + 64 * (j))
#define XB_TOP      3328
#define XB_TOPGEN   3392
#define XCD_BAR_WORDS 3456
#define XB_SPIN_CAP (1u << 18)

__device__ __forceinline__ unsigned xb_ld(unsigned* p)              { return __hip_atomic_load(p, __ATOMIC_RELAXED, __HIP_MEMORY_SCOPE_AGENT); }
__device__ __forceinline__ unsigned xb_add(unsigned* p, unsigned v) { return __hip_atomic_fetch_add(p, v, __ATOMIC_RELAXED, __HIP_MEMORY_SCOPE_AGENT); }
__device__ __forceinline__ unsigned xb_xcc_id() { return (unsigned)__builtin_amdgcn_s_getreg((3 << 11) | 20) & 0xFu; }
#define XB_SPIN(cond, bar) do { unsigned _sp = 0; while (cond) { __builtin_amdgcn_s_sleep(1); \
    if ((++_sp & 255u) == 0u) { if (xb_ld(&(bar)[XB_TMO])) break; if (_sp > XB_SPIN_CAP) { atomicAdd(&(bar)[XB_TMO], 1u); break; } } } } while (0)

struct XcdBarrier { unsigned* bar; unsigned x; volatile LAS unsigned* st; };

__device__ __forceinline__ XcdBarrier xcd_barrier_post(unsigned* bar, volatile LAS unsigned* st) {
    XcdBarrier b; b.bar = bar; b.x = xb_xcc_id(); b.st = st;
    if (threadIdx.x == 0) (void)xb_add(&bar[XB_XCNT(b.x)], 1u);
    return b;
}
__device__ __forceinline__ void xcd_barrier_complete(unsigned* bar, unsigned x, unsigned& nloc, unsigned& nx) {
    const unsigned G = gridDim.x * gridDim.y * gridDim.z;
    unsigned sum, cnt, mine, sp = 0u;
    for (;;) {
        sum = 0u; cnt = 0u; mine = 0u;
#pragma unroll
        for (unsigned j = 0; j < 16; ++j) { const unsigned c = xb_ld(&bar[XB_XCNT(j)]); sum += c; cnt += (c > 0u) ? 1u : 0u; mine = (j == x) ? c : mine; }
        if (sum == G) break;
        __builtin_amdgcn_s_sleep(1);
        if ((++sp & 255u) == 0u) { if (xb_ld(&bar[XB_TMO])) break; if (sp > XB_SPIN_CAP) { atomicAdd(&bar[XB_TMO], 1u); break; } }
    }
    nloc = mine > 0u ? mine : 1u; nx = cnt > 0u ? cnt : 1u;
}
__device__ __forceinline__ void xcd_barrier(const XcdBarrier& b) {
    asm volatile("s_waitcnt vmcnt(0)" ::: "memory");
    __syncthreads();
    if (threadIdx.x == 0) {
        unsigned* bar = b.bar;
        __builtin_amdgcn_s_waitcnt(0);
        unsigned nloc = b.st[0], nx = b.st[1];
        if (nloc == 0u) { xcd_barrier_complete(bar, b.x, nloc, nx); b.st[0] = nloc; b.st[1] = nx; }
        const unsigned old = xb_add(&bar[XB_XSUB(b.x)], 1u);
        const unsigned gen = old / nloc;
        if (old + 1u == (gen + 1u) * nloc) {
            __builtin_amdgcn_fence(__ATOMIC_RELEASE, "agent");
            asm volatile("s_waitcnt vmcnt(0)" ::: "memory");
            const unsigned og = xb_add(&bar[XB_TOP], 1u);
            const unsigned tg = og / nx;
            if (og + 1u == (tg + 1u) * nx) xb_add(&bar[XB_TOPGEN], 1u);
            else XB_SPIN(xb_ld(&bar[XB_TOPGEN]) == tg, bar);
            __builtin_amdgcn_fence(__ATOMIC_ACQUIRE, "agent");
            xb_add(&bar[XB_XGEN(b.x)], 1u);
            asm volatile("s_waitcnt vmcnt(0)" ::: "memory");
        } else {
            XB_SPIN(xb_ld(&bar[XB_XGEN(b.x)]) == gen, bar);
            __builtin_amdgcn_fence(__ATOMIC_ACQUIRE, "agent");
            asm volatile("s_waitcnt vmcnt(0)" ::: "memory");
        }
    }
    __syncthreads();
}

constexpr int T_ = 8192, DM = 2048, NZ = 4096, SEQ = 2048, NB = 4, NHEAD = 8, HD = 128;
constexpr int NG = 64, GH = 16, NP = 64, SCH = 256, NSC = SEQ / SCH;
constexpr int NE = 64, TOPK = 6, DE = 512, DPLE = 256, CAP = 8192;
constexpr int ZROW = T_;
constexpr float EPS = 1e-6f;

constexpr int LDS_STAGE = 131072;
constexpr int LDS_TAB = LDS_STAGE;
constexpr int LDS_BARW = LDS_STAGE + 4096;
constexpr int LDS_FLAGS = LDS_BARW + 16;
constexpr int LDS_BYTES = LDS_STAGE + 4096 + 256;

struct Params {
    const float *x, *p, *norm_mix, *w_in, *q_norm, *k_norm, *lam_re, *lam_im, *log_dt, *b_re, *b_im, *c_re, *c_im, *ssm_d, *w_glu,
                *attn_out_norm, *ssm_out_norm, *w_out, *norm_ffn, *w_router, *router_bias, *w_eg, *w_eu, *w_ed, *w_sg, *w_su, *w_sd,
                *norm_ple, *w_pg, *w_pp;
    float* out;
    unsigned* bar; unsigned* cnt;
    bf16_t *Wt_in, *Wt_glu, *Wt_out, *Wt_pg, *Wt_pp, *Wt_egu, *Wt_ed, *Wr_hi, *Wr_lo;
    bf16_t *R1, *zq, *mix, *ybuf, *H, *Hs, *Y, *Ysh, *proj, *pb;
    float *u, *h1, *sel_gate;
    float2 *Est, *abar, *aL, *bbar;
    int *tok_of_row, *sel_e, *sel_pos, *cntw, *basew;
    long long ph_lo, ph_hi;
};

typedef __bf16 bf16x2_t __attribute__((ext_vector_type(2)));
typedef float f32x2_t __attribute__((ext_vector_type(2)));
__device__ __forceinline__ unsigned cvt_pk_bf16(float lo, float hi) { const f32x2_t v = {lo, hi}; const bf16x2_t b = __builtin_convertvector(v, bf16x2_t); return __builtin_bit_cast(unsigned, b); }
__device__ __forceinline__ float bf_lo(unsigned w) { return __uint_as_float(w << 16); }
__device__ __forceinline__ float bf_hi(unsigned w) { return __uint_as_float(w & 0xffff0000u); }
__device__ __forceinline__ float sigmoidf_(float v) { return 1.0f / (1.0f + __expf(-v)); }
__device__ __forceinline__ float wave_sum(float v) {
#pragma unroll
    for (int o = 32; o >= 1; o >>= 1) v += __shfl_xor(v, o);
    return v;
}
__device__ __forceinline__ float wave_max(float v) {
#pragma unroll
    for (int o = 32; o >= 1; o >>= 1) v = fmaxf(v, __shfl_xor(v, o));
    return v;
}
__device__ __forceinline__ float gelu_tanh(float v) {
    const float c = 0.7978845608028654f;
    const float in = c * (v + 0.044715f * v * v * v);
    const float e = __expf(2.0f * in);
    const float th = 1.0f - 2.0f / (1.0f + e);
    return 0.5f * v * (1.0f + th);
}

namespace pg8 {
constexpr int BM = 256, BK = 64, HALF = 128, HTB = HALF * BK * 2, STAGE_BYTES = 8 * HTB, NXCD = 8, WGM = 8;
__host__ __device__ __forceinline__ int lds_byte(int r, int c) { const int st = (r >> 4) * 2 + (c >> 5), rr = r & 15, cc = c & 31, ob = rr * 64 + cc * 2; return st * 1024 + (ob ^ (((ob >> 9) & 1) << 5)); }
__host__ __device__ __forceinline__ void stage_rc(int b, int& R, int& C) { const int st = b / 1024, sb = b % 1024, swz = sb ^ (((sb >> 9) & 1) << 5); R = (st >> 1) * 16 + swz / 64; C = (st & 1) * 32 + (swz % 64) / 2; }
__host__ __device__ __forceinline__ int perm32(int rho) { const int n = rho >> 4, i = rho & 15; return 8 * (i >> 2) + 4 * n + (i & 3); }

struct Unit { int pm, pn, kind, nrows, arow, brow, orow0, gofs; };
struct Gemm { const bf16_t* A; const bf16_t* Bt; int K; const int* gtab; };

struct StaticOrder {
    int nM, nN, nwg, G, c, K;
    __device__ void init(int M, int N, int K_, int G_, int c_) { nM = M / BM; nN = N / BM; nwg = nM * nN; G = G_; c = c_; K = K_; }
    __device__ __forceinline__ Unit next(int i) const {
        Unit u; const long L = (long)i * G + c; const bool valid = L < nwg;
        int wgid = valid ? (int)L : 0; { const int q = nwg / NXCD, r = nwg % NXCD, xcd = wgid % NXCD, off = wgid / NXCD; wgid = (xcd < r ? xcd * (q + 1) : r * (q + 1) + (xcd - r) * q) + off; }
        const int nig = WGM * nN, gid = wgid / nig, fm = gid * WGM, gsz = (nM - fm) < WGM ? (nM - fm) : WGM;
        u.pm = fm + ((wgid % nig) % gsz); u.pn = (wgid % nig) / gsz;
        u.arow = u.pm * BM; u.brow = u.pn * BM; u.gofs = -1; u.nrows = BM; u.kind = 0; u.orow0 = u.pm * BM;
        if (!valid) u.pm = -1;
        return u;
    }
};

template <class Epi, class Sched, bool GATHER>
__device__ __forceinline__ void gemm_phase(LAS unsigned char* lds, const Gemm g, const Sched& S, const Epi& E) {
    const int tid = threadIdx.x, wid = __builtin_amdgcn_readfirstlane(tid >> 6), lane = tid & 63, wr = wid >> 2, wc = wid & 3, fr = lane & 15, fq = lane >> 4;
    const int K = g.K, nt = K / BK;
    unsigned voffA[2], voffB[2];
#pragma unroll
    for (int i = 0; i < 2; ++i) { int R, C; stage_rc(tid * 16 + i * 8192, R, C); const int Rb = Epi::PERM ? ((R & ~31) + perm32(R & 31)) : R;
        voffA[i] = (unsigned)(R * K + C) * 2u; voffB[i] = (unsigned)(Rb * K + C) * 2u; }
    const size_t kstep = (size_t)(BK * 2);
    const size_t hstep = (size_t)HALF * K * 2;
    const unsigned ldsw = (unsigned)wid * 1024u;
    const int aoff = lds_byte(wr * 64 + fr, fq * 8), boff = lds_byte(wc * 32 + fr, fq * 8);
#define PG8_SA(b, h) (((b) * 2 + (h)) * HTB)
#define PG8_SB(b, h) ((4 + (b) * 2 + (h)) * HTB)
#define PG8_STAGE(bufoff, gbase, voff) do { _Pragma("unroll") for (int _i = 0; _i < 2; ++_i) \
        __builtin_amdgcn_global_load_lds((const unsigned*)((const char*)(gbase) + (voff)[_i]), (LAS unsigned*)(lds + (bufoff) + ldsw + _i * 8192), 16, 0, 0); } while (0)
#define PG8_LDA(dst, b, h) do { _Pragma("unroll") for (int m = 0; m < 4; ++m) _Pragma("unroll") for (int k = 0; k < 2; ++k) dst[m][k] = *(const LAS bf16x8*)(lds + PG8_SA(b, h) + aoff + m * 2048 + k * 1024); } while (0)
#define PG8_LDB(dst, b, h) do { _Pragma("unroll") for (int n = 0; n < 2; ++n) _Pragma("unroll") for (int k = 0; k < 2; ++k) dst[n][k] = *(const LAS bf16x8*)(lds + PG8_SB(b, h) + boff + n * 2048 + k * 1024); } while (0)
#define PG8_MMA(ai, bj, At, Bt) do { __builtin_amdgcn_s_setprio(1); _Pragma("unroll") for (int m = 0; m < 4; ++m) _Pragma("unroll") for (int n = 0; n < 2; ++n) _Pragma("unroll") for (int k = 0; k < 2; ++k) \
        acc[ai][bj][m][n] = __builtin_amdgcn_mfma_f32_16x16x32_bf16(Bt[n][k], At[m][k], acc[ai][bj][m][n], 0, 0, 0); __builtin_amdgcn_s_setprio(0); } while (0)
#define PG8_WAIT_V(n) asm volatile("s_waitcnt vmcnt(" #n ")" ::: "memory")
#define PG8_WAIT_L(n) asm volatile("s_waitcnt lgkmcnt(" #n ")" ::: "memory")
#define PG8_BAR __builtin_amdgcn_s_barrier()
#define PG8_SCHED __builtin_amdgcn_sched_barrier(0)
    Unit cur = S.next(0), nxt; int ui = 0;
    if (cur.pm < 0) return;
    f32x4 acc[2][2][4][2];
#pragma unroll
    for (int a = 0; a < 2; ++a)
#pragma unroll
        for (int b = 0; b < 2; ++b)
#pragma unroll
            for (int m = 0; m < 4; ++m)
#pragma unroll
                for (int n = 0; n < 2; ++n) acc[a][b][m][n] = (f32x4){0.f, 0.f, 0.f, 0.f};
    bf16x8 At[4][2], B0[2][2], B1[2][2];
    unsigned cvo0[2] = {0u, 0u}, cvo1[2] = {0u, 0u}, nvo0[2] = {0u, 0u}, nvo1[2] = {0u, 0u};
    auto load_vo = [&](const Unit& u, unsigned (&v0)[2], unsigned (&v1)[2]) {
#pragma unroll
        for (int i = 0; i < 2; ++i) { int R, C; stage_rc(tid * 16 + i * 8192, R, C);
            int r0 = R, r1 = HALF + R;
            int t0, t1;
            if (u.gofs >= 0) { t0 = (r0 < u.nrows) ? g.gtab[u.gofs + r0] : ZROW; t1 = (r1 < u.nrows) ? g.gtab[u.gofs + r1] : ZROW; }
            else { t0 = u.orow0 + r0; t1 = u.orow0 + r1; }
            v0[i] = (unsigned)t0 * (unsigned)(K * 2) + (unsigned)(C * 2); v1[i] = (unsigned)t1 * (unsigned)(K * 2) + (unsigned)(C * 2); }
    };
    const size_t rowb = (size_t)K * 2;
    const char* cA = (const char*)g.A + (GATHER ? 0 : (size_t)cur.arow * rowb); const char* cB = (const char*)g.Bt + (size_t)cur.brow * rowb;
    if (GATHER) load_vo(cur, cvo0, cvo1);
    if (GATHER) {
        PG8_STAGE(PG8_SB(0, 0), cB, voffB); PG8_STAGE(PG8_SA(0, 0), cA, cvo0); PG8_STAGE(PG8_SB(0, 1), cB + hstep, voffB); PG8_STAGE(PG8_SA(0, 1), cA, cvo1);
    } else {
        PG8_STAGE(PG8_SB(0, 0), cB, voffB); PG8_STAGE(PG8_SA(0, 0), cA, voffA); PG8_STAGE(PG8_SB(0, 1), cB + hstep, voffB); PG8_STAGE(PG8_SA(0, 1), cA + hstep, voffA);
    }
    if (wr == 1) PG8_BAR;
    PG8_WAIT_V(4); PG8_BAR;
    if (GATHER) {
        PG8_STAGE(PG8_SB(1, 0), cB + kstep, voffB); PG8_STAGE(PG8_SA(1, 0), cA + kstep, cvo0); PG8_STAGE(PG8_SB(1, 1), cB + hstep + kstep, voffB);
    } else {
        PG8_STAGE(PG8_SB(1, 0), cB + kstep, voffB); PG8_STAGE(PG8_SA(1, 0), cA + kstep, voffA); PG8_STAGE(PG8_SB(1, 1), cB + hstep + kstep, voffB);
    }
    PG8_WAIT_V(6); PG8_BAR;
    for (;;) {
        nxt = S.next(ui + 1); const bool has_next = nxt.pm >= 0;
        const char* nA = GATHER ? cA : (has_next ? (const char*)g.A + (size_t)nxt.arow * rowb : cA); const char* nB = has_next ? (const char*)g.Bt + (size_t)nxt.brow * rowb : cB;
        if (GATHER) { if (has_next) load_vo(nxt, nvo0, nvo1); else { nvo0[0] = cvo0[0]; nvo0[1] = cvo0[1]; nvo1[0] = cvo1[0]; nvo1[1] = cvo1[1]; } }
        for (int t = 0; t < nt; t += 2) {
            const bool last = (t == nt - 2);
            const char* a1 = cA + (size_t)(t + 1) * kstep;
            const char* a2 = last ? nA : cA + (size_t)(t + 2) * kstep; const char* b2 = last ? nB : cB + (size_t)(t + 2) * kstep;
            const char* a3 = a2 + kstep; const char* b3 = b2 + kstep;
            unsigned s0[2], s1[2];
            if (GATHER) { s0[0] = last ? nvo0[0] : cvo0[0]; s0[1] = last ? nvo0[1] : cvo0[1]; s1[0] = last ? nvo1[0] : cvo1[0]; s1[1] = last ? nvo1[1] : cvo1[1]; }
            PG8_LDB(B0, 0, 0); PG8_SCHED; PG8_LDA(At, 0, 0);
            if (GATHER) PG8_STAGE(PG8_SA(1, 1), a1, cvo1); else PG8_STAGE(PG8_SA(1, 1), a1 + hstep, voffA);
            PG8_WAIT_L(8); PG8_BAR; PG8_WAIT_L(0); PG8_MMA(0, 0, At, B0); PG8_BAR; PG8_SCHED;
            PG8_LDB(B1, 0, 1); PG8_STAGE(PG8_SB(0, 0), b2, voffB);
            PG8_BAR; PG8_WAIT_L(0); PG8_MMA(0, 1, At, B1); PG8_BAR;
            PG8_LDA(At, 0, 1);
            if (GATHER) PG8_STAGE(PG8_SA(0, 0), a2, s0); else PG8_STAGE(PG8_SA(0, 0), a2, voffA);
            PG8_BAR; PG8_WAIT_L(0); PG8_MMA(1, 0, At, B0); PG8_BAR; PG8_SCHED;
            PG8_STAGE(PG8_SB(0, 1), b2 + hstep, voffB);
            PG8_WAIT_V(6); PG8_BAR; PG8_MMA(1, 1, At, B1); PG8_BAR;
            PG8_LDB(B0, 1, 0); PG8_SCHED; PG8_LDA(At, 1, 0);
            if (GATHER) PG8_STAGE(PG8_SA(0, 1), a2, s1); else PG8_STAGE(PG8_SA(0, 1), a2 + hstep, voffA);
            PG8_WAIT_L(8); PG8_BAR; PG8_WAIT_L(0); PG8_MMA(0, 0, At, B0); PG8_BAR; PG8_SCHED;
            PG8_LDB(B1, 1, 1); PG8_STAGE(PG8_SB(1, 0), b3, voffB);
            PG8_BAR; PG8_WAIT_L(0); PG8_MMA(0, 1, At, B1); PG8_BAR;
            PG8_LDA(At, 1, 1);
            if (GATHER) PG8_STAGE(PG8_SA(1, 0), a3, s0); else PG8_STAGE(PG8_SA(1, 0), a3, voffA);
            PG8_BAR; PG8_WAIT_L(0); PG8_MMA(1, 0, At, B0); PG8_BAR; PG8_SCHED;
            PG8_STAGE(PG8_SB(1, 1), b3 + hstep, voffB);
            PG8_WAIT_V(6); PG8_BAR; PG8_MMA(1, 1, At, B1); PG8_BAR;
        }
        E(acc, cur, wr, wc, fr, fq);
        if (!has_next) break;
#pragma unroll
        for (int a = 0; a < 2; ++a)
#pragma unroll
            for (int b = 0; b < 2; ++b)
#pragma unroll
                for (int m = 0; m < 4; ++m)
#pragma unroll
                    for (int n = 0; n < 2; ++n) acc[a][b][m][n] = (f32x4){0.f, 0.f, 0.f, 0.f};
        cur = nxt; cA = nA; cB = nB; ++ui;
        if (GATHER) { cvo0[0] = nvo0[0]; cvo0[1] = nvo0[1]; cvo1[0] = nvo1[0]; cvo1[1] = nvo1[1]; }
    }
    PG8_WAIT_V(0);
    if (wr == 0) PG8_BAR;
    PG8_BAR;
#undef PG8_SA
#undef PG8_SB
#undef PG8_STAGE
#undef PG8_LDA
#undef PG8_LDB
#undef PG8_MMA
#undef PG8_WAIT_V
#undef PG8_WAIT_L
#undef PG8_BAR
#undef PG8_SCHED
}
}
using pg8::Unit;

typedef f32x4 Acc[2][2][4][2];

template <int O0, int O1, int O2, int O3>
__device__ __forceinline__ void ld4x16(const void* p, f32x4& a, f32x4& b, f32x4& c, f32x4& d) {
    asm volatile("global_load_dwordx4 %0, %4, off offset:%5\n\tglobal_load_dwordx4 %1, %4, off offset:%6\n\tglobal_load_dwordx4 %2, %4, off offset:%7\n\tglobal_load_dwordx4 %3, %4, off offset:%8\n\ts_waitcnt vmcnt(0)"
                 : "=&v"(a), "=&v"(b), "=&v"(c), "=&v"(d) : "v"(p), "i"(O0), "i"(O1), "i"(O2), "i"(O3) : "memory");
}
template <int O0, int O1, int O2, int O3>
__device__ __forceinline__ void ld4x16_4x8(const void* p, f32x4& a, f32x4& b, f32x4& c, f32x4& d, const void* q, u32x2& e, u32x2& f, u32x2& g, u32x2& h) {
    asm volatile("global_load_dwordx4 %0, %8, off offset:%10\n\tglobal_load_dwordx4 %1, %8, off offset:%11\n\tglobal_load_dwordx4 %2, %8, off offset:%12\n\tglobal_load_dwordx4 %3, %8, off offset:%13\n\t"
                 "global_load_dwordx2 %4, %9, off offset:%14\n\tglobal_load_dwordx2 %5, %9, off offset:%15\n\tglobal_load_dwordx2 %6, %9, off offset:%16\n\tglobal_load_dwordx2 %7, %9, off offset:%17\n\ts_waitcnt vmcnt(0)"
                 : "=&v"(a), "=&v"(b), "=&v"(c), "=&v"(d), "=&v"(e), "=&v"(f), "=&v"(g), "=&v"(h)
                 : "v"(p), "v"(q), "i"(O0), "i"(O1), "i"(O2), "i"(O3), "i"(O0 / 2), "i"(O1 / 2), "i"(O2 / 2), "i"(O3 / 2) : "memory");
}
struct EpiQKVU {
    static constexpr bool PERM = true;
    bf16_t* zq; float* u;
    __device__ __forceinline__ void operator()(const Acc& acc, const Unit& un, int wr, int wc, int fr, int fq) const {
        const int row0 = un.pm * 256 + wr * 64 + fr, col0 = un.pn * 256 + wc * 32 + 8 * fq;
        if (un.pn < 12) {
#pragma unroll
            for (int ai = 0; ai < 2; ++ai)
#pragma unroll
                for (int m = 0; m < 4; ++m) { bf16_t* rowp = zq + (size_t)(row0 + ai * 128 + m * 16) * 3072 + col0;
#pragma unroll
                    for (int bj = 0; bj < 2; ++bj) { const f32x4 v0 = acc[ai][bj][m][0], v1 = acc[ai][bj][m][1];
                        u32x4 w; w.x = cvt_pk_bf16(v0[0], v0[1]); w.y = cvt_pk_bf16(v0[2], v0[3]); w.z = cvt_pk_bf16(v1[0], v1[1]); w.w = cvt_pk_bf16(v1[2], v1[3]);
                        *(u32x4*)(rowp + bj * 128) = w; } }
        } else {
#pragma unroll
            for (int ai = 0; ai < 2; ++ai)
#pragma unroll
                for (int m = 0; m < 4; ++m) { float* rowp = u + (size_t)(row0 + ai * 128 + m * 16) * 1024 + (col0 - 3072);
#pragma unroll
                    for (int bj = 0; bj < 2; ++bj) { *(f32x4*)(rowp + bj * 128) = acc[ai][bj][m][0]; *(f32x4*)(rowp + bj * 128 + 4) = acc[ai][bj][m][1]; } }
        }
    }
};
struct EpiGLU {
    static constexpr bool PERM = true;
    const bf16_t* __restrict__ y; bf16_t* __restrict__ mix;
    __device__ __forceinline__ void operator()(const Acc& acc, const Unit& un, int wr, int wc, int fr, int fq) const {
        const int row0 = un.pm * 256 + wr * 64 + fr, col0 = un.pn * 256 + wc * 32 + 8 * fq;
#pragma unroll
        for (int ai = 0; ai < 2; ++ai)
#pragma unroll
            for (int m = 0; m < 4; ++m) { const size_t row = (size_t)(row0 + ai * 128 + m * 16);
#pragma unroll
                for (int bj = 0; bj < 2; ++bj) { const f32x4 v0 = acc[ai][bj][m][0], v1 = acc[ai][bj][m][1];
                    const u32x4 yv = *(const u32x4*)(y + row * 1024 + col0 + bj * 128);
                    u32x4 w;
                    w.x = cvt_pk_bf16(bf_lo(yv.x) * sigmoidf_(v0[0]), bf_hi(yv.x) * sigmoidf_(v0[1]));
                    w.y = cvt_pk_bf16(bf_lo(yv.y) * sigmoidf_(v0[2]), bf_hi(yv.y) * sigmoidf_(v0[3]));
                    w.z = cvt_pk_bf16(bf_lo(yv.z) * sigmoidf_(v1[0]), bf_hi(yv.z) * sigmoidf_(v1[1]));
                    w.w = cvt_pk_bf16(bf_lo(yv.w) * sigmoidf_(v1[2]), bf_hi(yv.w) * sigmoidf_(v1[3]));
                    *(u32x4*)(mix + row * 2048 + 1024 + col0 + bj * 128) = w; } }
    }
};
struct EpiRes {
    static constexpr bool PERM = false;
    const float* x; float* h1;
    __device__ __forceinline__ void operator()(const Acc& acc, const Unit& un, int wr, int wc, int fr, int fq) const {
        const int row0 = un.pm * 256 + wr * 64 + fr, col0 = un.pn * 256 + wc * 32 + 4 * fq;
#pragma unroll
        for (int ai = 0; ai < 2; ++ai)
#pragma unroll
            for (int m = 0; m < 4; ++m) { const size_t ro = (size_t)(row0 + ai * 128 + m * 16) * 2048 + col0;
                f32x4 x00, x01, x10, x11; ld4x16<0, 64, 512, 576>(x + ro, x00, x01, x10, x11);
                *(f32x4*)(h1 + ro) = x00 + acc[ai][0][m][0]; *(f32x4*)(h1 + ro + 16) = x01 + acc[ai][0][m][1];
                *(f32x4*)(h1 + ro + 128) = x10 + acc[ai][1][m][0]; *(f32x4*)(h1 + ro + 144) = x11 + acc[ai][1][m][1]; }
    }
};
struct EpiSwiGLU {
    static constexpr bool PERM = true;
    bf16_t* H; bf16_t* Hs;
    __device__ __forceinline__ void operator()(const Acc& acc, const Unit& un, int wr, int wc, int fr, int fq) const {
        bf16_t* base = un.kind ? Hs : H;
        const size_t row0 = (size_t)un.orow0 + wr * 64 + fr; const int col0 = un.pn * 128 + wc * 32 + 8 * fq;
#pragma unroll
        for (int ai = 0; ai < 2; ++ai)
#pragma unroll
            for (int m = 0; m < 4; ++m) { const f32x4 g0 = acc[ai][0][m][0], g1 = acc[ai][0][m][1], u0 = acc[ai][1][m][0], u1 = acc[ai][1][m][1];
                u32x4 w;
                w.x = cvt_pk_bf16(g0[0] * sigmoidf_(g0[0]) * u0[0], g0[1] * sigmoidf_(g0[1]) * u0[1]);
                w.y = cvt_pk_bf16(g0[2] * sigmoidf_(g0[2]) * u0[2], g0[3] * sigmoidf_(g0[3]) * u0[3]);
                w.z = cvt_pk_bf16(g1[0] * sigmoidf_(g1[0]) * u1[0], g1[1] * sigmoidf_(g1[1]) * u1[1]);
                w.w = cvt_pk_bf16(g1[2] * sigmoidf_(g1[2]) * u1[2], g1[3] * sigmoidf_(g1[3]) * u1[3]);
                *(u32x4*)(base + (row0 + ai * 128 + m * 16) * 512 + col0) = w; }
    }
};
struct EpiDown {
    static constexpr bool PERM = true;
    bf16_t* Y; bf16_t* Ysh;
    __device__ __forceinline__ void operator()(const Acc& acc, const Unit& un, int wr, int wc, int fr, int fq) const {
        const int col0 = un.pn * 256 + wc * 32 + 8 * fq; bf16_t* base = (un.kind ? Ysh : Y) + (size_t)un.orow0 * 2048 + col0;
#pragma unroll
        for (int ai = 0; ai < 2; ++ai)
#pragma unroll
            for (int m = 0; m < 4; ++m) { const int r = ai * 128 + wr * 64 + m * 16 + fr;
                if (r < un.nrows) { bf16_t* rowp = base + (size_t)r * 2048;
#pragma unroll
                    for (int bj = 0; bj < 2; ++bj) { const f32x4 v0 = acc[ai][bj][m][0], v1 = acc[ai][bj][m][1];
                        u32x4 w; w.x = cvt_pk_bf16(v0[0], v0[1]); w.y = cvt_pk_bf16(v0[2], v0[3]); w.z = cvt_pk_bf16(v1[0], v1[1]); w.w = cvt_pk_bf16(v1[2], v1[3]);
                        *(u32x4*)(rowp + bj * 128) = w; } } }
    }
};
struct EpiBf16 {
    static constexpr bool PERM = true;
    bf16_t* O; int ldo;
    __device__ __forceinline__ void operator()(const Acc& acc, const Unit& un, int wr, int wc, int fr, int fq) const {
        const int row0 = un.pm * 256 + wr * 64 + fr, col0 = un.pn * 256 + wc * 32 + 8 * fq;
#pragma unroll
        for (int ai = 0; ai < 2; ++ai)
#pragma unroll
            for (int m = 0; m < 4; ++m) { bf16_t* rowp = O + (size_t)(row0 + ai * 128 + m * 16) * ldo + col0;
#pragma unroll
                for (int bj = 0; bj < 2; ++bj) { const f32x4 v0 = acc[ai][bj][m][0], v1 = acc[ai][bj][m][1];
                    u32x4 w; w.x = cvt_pk_bf16(v0[0], v0[1]); w.y = cvt_pk_bf16(v0[2], v0[3]); w.z = cvt_pk_bf16(v1[0], v1[1]); w.w = cvt_pk_bf16(v1[2], v1[3]);
                    *(u32x4*)(rowp + bj * 128) = w; } }
    }
};
struct EpiPle {
    static constexpr bool PERM = false;
    float* out; const bf16_t* proj; const float* h2;
    __device__ __forceinline__ void operator()(const Acc& acc, const Unit& un, int wr, int wc, int fr, int fq) const {
        const int row0 = un.pm * 256 + wr * 64 + fr, col0 = un.pn * 256 + wc * 32 + 4 * fq;
#pragma unroll
        for (int ai = 0; ai < 2; ++ai)
#pragma unroll
            for (int m = 0; m < 4; ++m) { const size_t ro = (size_t)(row0 + ai * 128 + m * 16) * 2048 + col0;
                f32x4 hv[4]; u32x2 pv[4]; ld4x16_4x8<0, 64, 512, 576>(h2 + ro, hv[0], hv[1], hv[2], hv[3], proj + ro, pv[0], pv[1], pv[2], pv[3]);
#pragma unroll
                for (int q = 0; q < 4; ++q) { const int bj = q >> 1, n = q & 1; const f32x4 a = acc[ai][bj][m][n]; f32x4 r;
                    r[0] = hv[q][0] + sigmoidf_(a[0]) * bf_lo(pv[q].x); r[1] = hv[q][1] + sigmoidf_(a[1]) * bf_hi(pv[q].x);
                    r[2] = hv[q][2] + sigmoidf_(a[2]) * bf_lo(pv[q].y); r[3] = hv[q][3] + sigmoidf_(a[3]) * bf_hi(pv[q].y);
                    *(f32x4*)(out + ro + bj * 128 + n * 16) = r; } }
    }
};

struct MoeSched {
    int G, c, n_rt, NPN, K; bool down;
    const LAS int* rt_e; const LAS int* rt_j; const LAS int* rt_n;
    __device__ __forceinline__ Unit next(int i) const {
        Unit u; const int L = i * G + c; const int nr = n_rt * NPN; const int tot = nr + 32 * NPN;
        const bool valid = L < tot, routed = L < nr;
        const int Lr = routed ? L : 0, Ls = (!routed && valid) ? (L - nr) : 0;
        const int rt = Lr / NPN;
        const int e = __builtin_amdgcn_readfirstlane(rt_e[rt]), j = __builtin_amdgcn_readfirstlane(rt_j[rt]);
        const int rem = __builtin_amdgcn_readfirstlane(rt_n[rt]);
        const int spm = Ls / NPN;
        u.kind = routed ? 0 : 1;
        u.pn = routed ? (Lr % NPN) : (Ls % NPN);
        u.pm = routed ? rt : spm;
        u.nrows = routed ? rem : 256;
        const int ee = routed ? e : NE;
        if (!down) {
            u.arow = 0; u.gofs = routed ? (e * CAP + j * 256) : -1;
            u.brow = ee * 1024 + u.pn * 256;
            u.orow0 = routed ? rt * 256 : spm * 256;
        } else {
            u.gofs = -1;
            u.arow = routed ? rt * 256 : 65536 + spm * 256;
            u.brow = ee * 2048 + u.pn * 256;
            u.orow0 = routed ? rt * 256 : spm * 256;
        }
        if (!valid) u.pm = -1;
        return u;
    }
};

__device__ __forceinline__ void cvt_tile(const float* __restrict__ src, int ldw, int k0, int n0, const float* __restrict__ gain, bf16_t* __restrict__ dst, int ldd, int dk0,
                                         int inter, int roff, LAS float* lt) {
    const int tid = threadIdx.x, c4 = tid & 63, r8 = tid >> 6;
    f32x4 v[8];
#pragma unroll
    for (int i = 0; i < 8; ++i) v[i] = *(const f32x4*)(src + (size_t)(k0 + r8 + 8 * i) * ldw + n0 + 4 * c4);
#pragma unroll
    for (int i = 0; i < 8; ++i) { const int k = r8 + 8 * i; const float gsc = gain ? gain[k0 + k] : 1.0f; LAS float* q = lt + k * 257 + 4 * c4;
        q[0] = v[i][0] * gsc; q[1] = v[i][1] * gsc; q[2] = v[i][2] * gsc; q[3] = v[i][3] * gsc; }
    __syncthreads();
#pragma unroll
    for (int i = 0; i < 4; ++i) { const int q = tid + 512 * i, kg = q & 7, n = q >> 3; const LAS float* s = lt + (8 * kg) * 257 + n;
        u32x4 w; w.x = cvt_pk_bf16(s[0], s[257]); w.y = cvt_pk_bf16(s[2 * 257], s[3 * 257]); w.z = cvt_pk_bf16(s[4 * 257], s[5 * 257]); w.w = cvt_pk_bf16(s[6 * 257], s[7 * 257]);
        const int ng = n0 + n; const int drow = inter ? ((ng >> 7) * 256 + roff + (ng & 127)) : ng;
        *(u32x4*)(dst + (size_t)drow * ldd + dk0 + k0 + 8 * kg) = w; }
    __syncthreads();
}
__device__ __forceinline__ void cvt_job(long& base, const float* src, int K, int N, const float* gain, bf16_t* dst, int ldd, int dk0, int inter, int roff, LAS float* lt) {
    const int nk = K / 64, nn = N / 256, ntl = nk * nn, G = gridDim.x;
    int t = (int)(((long)blockIdx.x - base % G + G) % G);
    for (; t < ntl; t += G) { const int kt = t % nk, ntile = t / nk; cvt_tile(src, N, kt * 64, ntile * 256, gain, dst, ldd, dk0, inter, roff, lt); }
    base += ntl;
}
__device__ void phase_prologue(const Params& P, LAS unsigned char* lds) {
    LAS float* lt = (LAS float*)lds;
    const int tid = threadIdx.x, wid = tid >> 6, lane = tid & 63, G = gridDim.x;
    for (int row = blockIdx.x * 8 + wid; row < T_; row += G * 8) {
        const float* xr = P.x + (size_t)row * DM; f32x4 v[8]; float ss = 0.f;
#pragma unroll
        for (int i = 0; i < 8; ++i) { v[i] = *(const f32x4*)(xr + 4 * lane + 256 * i); ss += v[i][0] * v[i][0] + v[i][1] * v[i][1] + v[i][2] * v[i][2] + v[i][3] * v[i][3]; }
        ss = wave_sum(ss); const float r = rsqrtf(ss * (1.0f / DM) + EPS);
#pragma unroll
        for (int i = 0; i < 8; ++i) { u32x2 w; w.x = cvt_pk_bf16(v[i][0] * r, v[i][1] * r); w.y = cvt_pk_bf16(v[i][2] * r, v[i][3] * r); *(u32x2*)(P.R1 + (size_t)row * DM + 4 * lane + 256 * i) = w; }
    }
    if (blockIdx.x == 0) { for (int i = tid; i < DM / 2; i += 512) ((unsigned*)(P.R1 + (size_t)ZROW * DM))[i] = 0u; }
    for (size_t i = (size_t)blockIdx.x * 512 + tid; i < (size_t)T_ * DPLE / 8; i += (size_t)G * 512) { const f32x4 a = *(const f32x4*)(P.p + i * 8), b2 = *(const f32x4*)(P.p + i * 8 + 4);
        u32x4 w; w.x = cvt_pk_bf16(a[0], a[1]); w.y = cvt_pk_bf16(a[2], a[3]); w.z = cvt_pk_bf16(b2[0], b2[1]); w.w = cvt_pk_bf16(b2[2], b2[3]); *(u32x4*)(P.pb + i * 8) = w; }
    for (int i = blockIdx.x * 512 + tid; i < NG * NP; i += G * 512) {
        const int g = i / NP;
        const float lr = P.lam_re[i], li = P.lam_im[i]; const float dt = expf(P.log_dt[g]);
        const double mag = exp((double)lr * (double)dt), ang = (double)li * (double)dt;
        const float ar = (float)(mag * cos(ang)), ai = (float)(mag * sin(ang));
        const double magL = exp((double)lr * (double)dt * SCH), angL = ang * SCH;
        P.abar[i] = make_float2(ar, ai); P.aL[i] = make_float2((float)(magL * cos(angL)), (float)(magL * sin(angL)));
        const float nr = ar - 1.0f, ni = ai, den = lr * lr + li * li;
        const float cr = (nr * lr + ni * li) / den, ci = (ni * lr - nr * li) / den;
#pragma unroll
        for (int h = 0; h < GH; ++h) { const float br = P.b_re[(size_t)i * GH + h], bi = P.b_im[(size_t)i * GH + h];
            P.bbar[(size_t)i * GH + h] = make_float2(cr * br - ci * bi, cr * bi + ci * br); }
    }
    for (int i = blockIdx.x * 512 + tid; i < NE * DM; i += G * 512) { const int e = i / DM, k = i % DM; const float w = P.w_router[(size_t)k * NE + e] * P.norm_ffn[k];
        const unsigned hw = cvt_pk_bf16(w, 0.f); const float hf = bf_lo(hw); P.Wr_hi[i] = (bf16_t)(hw & 0xffffu); P.Wr_lo[i] = (bf16_t)(cvt_pk_bf16(w - hf, 0.f) & 0xffffu); }
    long base = 0;
    cvt_job(base, P.w_in, 2048, 4096, P.norm_mix, P.Wt_in, 2048, 0, 0, 0, lt);
    cvt_job(base, P.w_glu, 1024, 1024, nullptr, P.Wt_glu, 1024, 0, 0, 0, lt);
    cvt_job(base, P.w_out, 1024, 2048, P.attn_out_norm, P.Wt_out, 2048, 0, 0, 0, lt);
    cvt_job(base, P.w_out + (size_t)1024 * 2048, 1024, 2048, P.ssm_out_norm, P.Wt_out, 2048, 1024, 0, 0, lt);
    cvt_job(base, P.w_sg, 2048, 512, nullptr, P.Wt_egu + (size_t)NE * 1024 * 2048, 2048, 0, 1, 0, lt);
    cvt_job(base, P.w_su, 2048, 512, nullptr, P.Wt_egu + (size_t)NE * 1024 * 2048, 2048, 0, 1, 128, lt);
    cvt_job(base, P.w_sd, 512, 2048, nullptr, P.Wt_ed + (size_t)NE * 2048 * 512, 512, 0, 0, 0, lt);
    cvt_job(base, P.w_pg, 2048, 2048, P.norm_ple, P.Wt_pg, 2048, 0, 0, 0, lt);
    cvt_job(base, P.w_pp, 256, 2048, nullptr, P.Wt_pp, 256, 0, 0, 0, lt);
    {
        const int ntl = NE * 192; int t = (int)(((long)blockIdx.x - base % G + G) % G);
        for (; t < ntl; t += G) { const int e = t / 192, r = t % 192;
            if (r < 128) { const int up = r >> 6, q = r & 63, kt = q & 31, ntile = q >> 5;
                cvt_tile((up ? P.w_eu : P.w_eg) + (size_t)e * 2048 * 512, 512, kt * 64, ntile * 256, nullptr, P.Wt_egu + (size_t)e * 1024 * 2048, 2048, 0, 1, up ? 128 : 0, lt); }
            else { const int q = r - 128, kt = q & 7, ntile = q >> 3;
                cvt_tile(P.w_ed + (size_t)e * 512 * 2048, 2048, kt * 64, ntile * 256, nullptr, P.Wt_ed + (size_t)e * 2048 * 512, 512, 0, 0, 0, lt); } }
    }
}

#define KSWZ(row, colB) ((row) * 256 + ((colB) ^ (((row) & 7) << 4)))
#define SBAR() __builtin_amdgcn_sched_barrier(0)
__device__ __forceinline__ int crow(int r, int hi) { return (r & 3) + 8 * (r >> 2) + 4 * hi; }
__device__ __forceinline__ void qkt(f32x16& p0, f32x16& p1, const LAS unsigned char* Ks, const bf16x8* qr, int r32, int hi) {
    p0 = f32x16{}; p1 = f32x16{};
#pragma unroll
    for (int d0 = 0; d0 < 8; ++d0) { const int cb = (d0 * 16 + hi * 8) * 2;
        const bf16x8 b0 = *(const LAS bf16x8*)(Ks + KSWZ(r32, cb));
        const bf16x8 b1 = *(const LAS bf16x8*)(Ks + KSWZ(32 + r32, cb));
        p0 = __builtin_amdgcn_mfma_f32_32x32x16_bf16(b0, qr[d0], p0, 0, 0, 0);
        p1 = __builtin_amdgcn_mfma_f32_32x32x16_bf16(b1, qr[d0], p1, 0, 0, 0); }
}
__device__ __forceinline__ int v_st(int k, int c) { const int kk = (k & ~0xC) | ((k & 4) << 1) | ((k & 8) >> 1); return ((kk >> 3) * 4 + (c >> 5)) * 512 + ((kk & 7) * 32 + (c & 31)) * 2; }
__device__ __forceinline__ int v_rd_base(int lane) { return ((lane & 3) << 3) | (((lane >> 2) & 3) << 6) | (((lane >> 4) & 1) << 5) | (((lane >> 5) & 1) << 8); }
constexpr int v_rd_off(int d0, int ks, int half) { return d0 * 512 + ks * 4096 + half * 2048; }
template <int D0> __device__ __forceinline__ void pv_one(f32x16& od, int vb, bf16x8 pa0, bf16x8 pa1, bf16x8 pa2, bf16x8 pa3) {
    s16x4 l0, h0, l1, h1, l2, h2, l3, h3;
    asm volatile("ds_read_b64_tr_b16 %0, %8 offset:%9\n\t"
                 "ds_read_b64_tr_b16 %1, %8 offset:%10\n\t"
                 "ds_read_b64_tr_b16 %2, %8 offset:%11\n\t"
                 "ds_read_b64_tr_b16 %3, %8 offset:%12\n\t"
                 "ds_read_b64_tr_b16 %4, %8 offset:%13\n\t"
                 "ds_read_b64_tr_b16 %5, %8 offset:%14\n\t"
                 "ds_read_b64_tr_b16 %6, %8 offset:%15\n\t"
                 "ds_read_b64_tr_b16 %7, %8 offset:%16\n\t"
                 "s_waitcnt lgkmcnt(0)"
                 : "=&v"(l0), "=&v"(h0), "=&v"(l1), "=&v"(h1), "=&v"(l2), "=&v"(h2), "=&v"(l3), "=&v"(h3)
                 : "v"(vb), "i"(v_rd_off(D0, 0, 0)), "i"(v_rd_off(D0, 0, 1)), "i"(v_rd_off(D0, 1, 0)), "i"(v_rd_off(D0, 1, 1)),
                   "i"(v_rd_off(D0, 2, 0)), "i"(v_rd_off(D0, 2, 1)), "i"(v_rd_off(D0, 3, 0)), "i"(v_rd_off(D0, 3, 1))
                 : "memory");
    SBAR();
#define PK(L, H) (bf16x8){L[0], L[1], L[2], L[3], H[0], H[1], H[2], H[3]}
    od = __builtin_amdgcn_mfma_f32_32x32x16_bf16(pa0, PK(l0, h0), od, 0, 0, 0);
    od = __builtin_amdgcn_mfma_f32_32x32x16_bf16(pa1, PK(l1, h1), od, 0, 0, 0);
    od = __builtin_amdgcn_mfma_f32_32x32x16_bf16(pa2, PK(l2, h2), od, 0, 0, 0);
    od = __builtin_amdgcn_mfma_f32_32x32x16_bf16(pa3, PK(l3, h3), od, 0, 0, 0);
#undef PK
}
__device__ __forceinline__ float softplus_(float z) { return fmaxf(z, 0.f) + __logf(1.0f + __expf(-fabsf(z))); }

__device__ void attn_unit(const Params& P, int unit, LAS unsigned char* lds) {
    const int qb = unit & 7, h = (unit >> 3) & 7, b = unit >> 6;
    const int tid = threadIdx.x, wid = tid >> 6, lane = tid & 63, r32 = lane & 31, hi = lane >> 5;
    const int q0 = qb * 256; const size_t tokbase = (size_t)b * SEQ;
    LAS unsigned char* K_lds = lds; LAS unsigned char* V_lds = lds + 16384; volatile LAS int* flags = (volatile LAS int*)(lds + LDS_FLAGS);
    const int tq = q0 + wid * 32 + r32;
    bf16x8 qr[8];
    {
        const bf16_t* qp = P.zq + (tokbase + tq) * 3072 + h * HD + hi * 8;
        u32x4 raw[8]; float ss = 0.f;
#pragma unroll
        for (int d0 = 0; d0 < 8; ++d0) { raw[d0] = *(const u32x4*)(qp + d0 * 16);
            const float a0 = bf_lo(raw[d0].x), a1 = bf_hi(raw[d0].x), a2 = bf_lo(raw[d0].y), a3 = bf_hi(raw[d0].y), a4 = bf_lo(raw[d0].z), a5 = bf_hi(raw[d0].z), a6 = bf_lo(raw[d0].w), a7 = bf_hi(raw[d0].w);
            ss += a0 * a0 + a1 * a1 + a2 * a2 + a3 * a3 + a4 * a4 + a5 * a5 + a6 * a6 + a7 * a7; }
        ss += __shfl_xor(ss, 32);
        const float rq = rsqrtf(ss * (1.0f / HD) + EPS) * 0.088388347648318440f;
#pragma unroll
        for (int d0 = 0; d0 < 8; ++d0) { const float* gq = P.q_norm + d0 * 16 + hi * 8; const f32x4 g0 = *(const f32x4*)gq, g1 = *(const f32x4*)(gq + 4);
            u32x4 w;
            w.x = cvt_pk_bf16(bf_lo(raw[d0].x) * rq * g0[0], bf_hi(raw[d0].x) * rq * g0[1]); w.y = cvt_pk_bf16(bf_lo(raw[d0].y) * rq * g0[2], bf_hi(raw[d0].y) * rq * g0[3]);
            w.z = cvt_pk_bf16(bf_lo(raw[d0].z) * rq * g1[0], bf_hi(raw[d0].z) * rq * g1[1]); w.w = cvt_pk_bf16(bf_lo(raw[d0].w) * rq * g1[2], bf_hi(raw[d0].w) * rq * g1[3]);
            qr[d0] = *(bf16x8*)&w; }
    }
    const int sr = tid >> 4, sc = (tid & 15) * 8, vst0 = v_st(sr, sc), vst1 = v_st(32 + sr, sc);
    const int vb0 = (int)(unsigned)(uintptr_t)V_lds + v_rd_base(lane);
    const f32x4 gk0 = *(const f32x4*)(P.k_norm + sc), gk1 = *(const f32x4*)(P.k_norm + sc + 4);
    f32x16 o[4]; o[0] = f32x16{}; o[1] = f32x16{}; o[2] = f32x16{}; o[3] = f32x16{};
    float Rc = 0.f; bool done = false;
    const int tw_max = q0 + wid * 32 + 31;
    if (tid < 8) flags[tid] = 0;
    for (int kt = (q0 >> 6) + 3; kt >= 0; --kt) {
        {
            const bf16_t* kp0 = P.zq + (tokbase + kt * 64 + sr) * 3072 + 1024 + h * HD + sc; const bf16_t* kp1 = kp0 + (size_t)32 * 3072;
            const u32x4 k0 = *(const u32x4*)kp0, k1 = *(const u32x4*)kp1, v0 = *(const u32x4*)(kp0 + 1024), v1 = *(const u32x4*)(kp1 + 1024);
            float s0 = bf_lo(k0.x) * bf_lo(k0.x) + bf_hi(k0.x) * bf_hi(k0.x) + bf_lo(k0.y) * bf_lo(k0.y) + bf_hi(k0.y) * bf_hi(k0.y) + bf_lo(k0.z) * bf_lo(k0.z) + bf_hi(k0.z) * bf_hi(k0.z) + bf_lo(k0.w) * bf_lo(k0.w) + bf_hi(k0.w) * bf_hi(k0.w);
            float s1 = bf_lo(k1.x) * bf_lo(k1.x) + bf_hi(k1.x) * bf_hi(k1.x) + bf_lo(k1.y) * bf_lo(k1.y) + bf_hi(k1.y) * bf_hi(k1.y) + bf_lo(k1.z) * bf_lo(k1.z) + bf_hi(k1.z) * bf_hi(k1.z) + bf_lo(k1.w) * bf_lo(k1.w) + bf_hi(k1.w) * bf_hi(k1.w);
#pragma unroll
            for (int o_ = 8; o_ >= 1; o_ >>= 1) { s0 += __shfl_xor(s0, o_); s1 += __shfl_xor(s1, o_); }
            const float r0 = rsqrtf(s0 * (1.0f / HD) + EPS), r1 = rsqrtf(s1 * (1.0f / HD) + EPS);
            u32x4 w0, w1;
            w0.x = cvt_pk_bf16(bf_lo(k0.x) * r0 * gk0[0], bf_hi(k0.x) * r0 * gk0[1]); w0.y = cvt_pk_bf16(bf_lo(k0.y) * r0 * gk0[2], bf_hi(k0.y) * r0 * gk0[3]);
            w0.z = cvt_pk_bf16(bf_lo(k0.z) * r0 * gk1[0], bf_hi(k0.z) * r0 * gk1[1]); w0.w = cvt_pk_bf16(bf_lo(k0.w) * r0 * gk1[2], bf_hi(k0.w) * r0 * gk1[3]);
            w1.x = cvt_pk_bf16(bf_lo(k1.x) * r1 * gk0[0], bf_hi(k1.x) * r1 * gk0[1]); w1.y = cvt_pk_bf16(bf_lo(k1.y) * r1 * gk0[2], bf_hi(k1.y) * r1 * gk0[3]);
            w1.z = cvt_pk_bf16(bf_lo(k1.z) * r1 * gk1[0], bf_hi(k1.z) * r1 * gk1[1]); w1.w = cvt_pk_bf16(bf_lo(k1.w) * r1 * gk1[2], bf_hi(k1.w) * r1 * gk1[3]);
            *(LAS u32x4*)(K_lds + KSWZ(sr, sc * 2)) = w0; *(LAS u32x4*)(K_lds + KSWZ(32 + sr, sc * 2)) = w1;
            *(LAS u32x4*)(V_lds + vst0) = v0; *(LAS u32x4*)(V_lds + vst1) = v1;
        }
        __syncthreads();
        if (!done && kt * 64 < tw_max) {
            f32x16 p0, p1; qkt(p0, p1, K_lds, qr, r32, hi);
            const int kb = kt * 64;
            float gs[8], pg[8], lz[32];
#pragma unroll
            for (int hf = 0; hf < 2; ++hf)
#pragma unroll
                for (int g = 0; g < 4; ++g) { float s = 0.f;
#pragma unroll
                    for (int i = 0; i < 4; ++i) { const int r = 4 * g + i; const float z = hf ? p1[r] : p0[r]; const bool causal = (kb + 32 * hf + crow(r, hi)) < tq;
                        const float spv = softplus_(z); lz[hf * 16 + r] = causal ? (z - spv) : -1e30f; const float spm = causal ? spv : 0.f;
                        if (hf) p1[r] = spm; else p0[r] = spm; s += spm; }
                    gs[hf * 4 + g] = s; }
#pragma unroll
            for (int i = 0; i < 8; ++i) pg[i] = __shfl_xor(gs[i], 32);
            float suf = 0.f;
            float aft[8];
#pragma unroll
            for (int i = 7; i >= 0; --i) { aft[i] = Rc + suf + (hi == 0 ? pg[i] : 0.f); suf += gs[i] + pg[i]; }
            Rc += suf;
#pragma unroll
            for (int hf = 0; hf < 2; ++hf)
#pragma unroll
                for (int g = 0; g < 4; ++g) { float a = aft[hf * 4 + g];
#pragma unroll
                    for (int i = 3; i >= 0; --i) { const int r = 4 * g + i; const float spm = hf ? p1[r] : p0[r]; const float wv = __expf(lz[hf * 16 + r] - a); a += spm;
                        if (hf) p1[r] = wv; else p0[r] = wv; } }
            bf16x8 pa0, pa1, pa2, pa3;
#define PK4(Pv, BASE, OUT) do { unsigned a0 = cvt_pk_bf16(Pv[BASE + 0], Pv[BASE + 1]), a1 = cvt_pk_bf16(Pv[BASE + 2], Pv[BASE + 3]);   \
    unsigned b0 = cvt_pk_bf16(Pv[BASE + 4], Pv[BASE + 5]), b1 = cvt_pk_bf16(Pv[BASE + 6], Pv[BASE + 7]);                              \
    auto r0 = __builtin_amdgcn_permlane32_swap(a0, b0, false, false); auto r1 = __builtin_amdgcn_permlane32_swap(a1, b1, false, false); \
    u32x4 w = {r0[0], r1[0], r0[1], r1[1]}; OUT = *reinterpret_cast<bf16x8*>(&w); } while (0)
            PK4(p0, 0, pa0); PK4(p0, 8, pa1); PK4(p1, 0, pa2); PK4(p1, 8, pa3);
#undef PK4
            SBAR();
            pv_one<0>(o[0], vb0, pa0, pa1, pa2, pa3); pv_one<1>(o[1], vb0, pa0, pa1, pa2, pa3); pv_one<2>(o[2], vb0, pa0, pa1, pa2, pa3); pv_one<3>(o[3], vb0, pa0, pa1, pa2, pa3);
            done = __all(Rc > 110.0f);
            if (done && lane == 0) flags[wid] = 1;
        }
        __syncthreads();
        int nd = 0;
#pragma unroll
        for (int w = 0; w < 8; ++w) nd += flags[w];
        if (nd == 8) break;
    }
    bf16_t* ob = P.mix + (tokbase + q0 + wid * 32) * 2048 + h * HD;
#pragma unroll
    for (int r = 0; r < 16; ++r) { const int orow = crow(r, hi);
#pragma unroll
        for (int d0 = 0; d0 < 4; ++d0) ob[(size_t)orow * 2048 + d0 * 32 + r32] = (bf16_t)(cvt_pk_bf16(o[d0][r], 0.f) & 0xffffu); }
    __syncthreads();
}

__device__ __forceinline__ float xhalf(float x, int hi) { const auto r = __builtin_amdgcn_permlane32_swap(__float_as_uint(x), __float_as_uint(x), false, false); return __uint_as_float(hi ? r[0] : r[1]); }
__device__ __forceinline__ float2 cmul(float2 a, float2 b) { return make_float2(a.x * b.x - a.y * b.y, a.x * b.y + a.y * b.x); }
__device__ __forceinline__ float2 cfma(float2 a, float2 x, float2 c) { return make_float2(a.x * x.x - a.y * x.y + c.x, a.x * x.y + a.y * x.x + c.y); }
template <bool OUT>
__device__ __forceinline__ void ssm_item(const Params& P, int item, LAS unsigned char* lds) {
    const int tid = threadIdx.x, wid = tid >> 6, lane = tid & 63, r32 = lane & 31, hi = lane >> 5, hh = lane & 15, kq = lane >> 4;
    const int g = item % NG, sc = (item / NG) % NSC, b = item / (NSC * NG);
    LAS unsigned* xs = (LAS unsigned*)(lds + wid * 8192);
    float2 a1[2], a2[2], a3[2], a4[2], cst[2]; bf16x8 bre[2], bim[2];
#pragma unroll
    for (int pb = 0; pb < 2; ++pb) { const int gp = g * NP + pb * 32 + r32;
        a1[pb] = P.abar[gp]; a2[pb] = cmul(a1[pb], a1[pb]); a3[pb] = cmul(a2[pb], a1[pb]); a4[pb] = cmul(a2[pb], a2[pb]);
        const float* bp = (const float*)(P.bbar + (size_t)gp * GH + 8 * hi); const f32x4 v0 = *(const f32x4*)bp, v1 = *(const f32x4*)(bp + 4), v2 = *(const f32x4*)(bp + 8), v3 = *(const f32x4*)(bp + 12);
        u32x4 wr_, wi_; wr_.x = cvt_pk_bf16(v0[0], v0[2]); wr_.y = cvt_pk_bf16(v1[0], v1[2]); wr_.z = cvt_pk_bf16(v2[0], v2[2]); wr_.w = cvt_pk_bf16(v3[0], v3[2]);
        wi_.x = cvt_pk_bf16(v0[1], v0[3]); wi_.y = cvt_pk_bf16(v1[1], v1[3]); wi_.z = cvt_pk_bf16(v2[1], v2[3]); wi_.w = cvt_pk_bf16(v3[1], v3[3]);
        bre[pb] = *(bf16x8*)&wr_; bim[pb] = *(bf16x8*)&wi_;
        cst[pb] = make_float2(0.f, 0.f);
        if (OUT) { const float2 aL = P.aL[gp]; const float2* ep = P.Est + ((size_t)(b * NG + g) * NSC) * NP + pb * 32 + r32; float2 e[NSC - 1];
#pragma unroll
            for (int cc = 0; cc < NSC - 1; ++cc) e[cc] = ep[(size_t)cc * NP];
#pragma unroll
            for (int cc = 0; cc < NSC - 1; ++cc) if (cc < sc) cst[pb] = cfma(aL, cst[pb], e[cc]); } }
    bf16x8 cf[4], dfr; float dsk = 0.f;
    if (OUT) {
#pragma unroll
        for (int s_ = 0; s_ < 4; ++s_) { const size_t ci = ((size_t)g * GH + hh) * NP + 16 * s_ + 4 * kq; const f32x4 cr = *(const f32x4*)(P.c_re + ci), cim = *(const f32x4*)(P.c_im + ci);
            u32x4 w; w.x = cvt_pk_bf16(cr[0], -cim[0]); w.y = cvt_pk_bf16(cr[1], -cim[1]); w.z = cvt_pk_bf16(cr[2], -cim[2]); w.w = cvt_pk_bf16(cr[3], -cim[3]); cf[s_] = *(bf16x8*)&w; }
        dsk = P.ssm_d[g * GH + hh];
        float dv[8];
#pragma unroll
        for (int j = 0; j < 8; ++j) dv[j] = (8 * kq + j == hh) ? dsk : 0.f;
        u32x4 w; w.x = cvt_pk_bf16(dv[0], dv[1]); w.y = cvt_pk_bf16(dv[2], dv[3]); w.z = cvt_pk_bf16(dv[4], dv[5]); w.w = cvt_pk_bf16(dv[6], dv[7]); dfr = *(bf16x8*)&w;
    }
    const float* ubase = P.u + ((size_t)b * SEQ + sc * SCH) * 1024 + g * GH;
    f32x4 un0 = *(const f32x4*)(ubase + (size_t)r32 * 1024 + 8 * hi), un1 = *(const f32x4*)(ubase + (size_t)r32 * 1024 + 8 * hi + 4);
    for (int blk = 0; blk < SCH / 32; ++blk) {
        u32x4 aw; aw.x = cvt_pk_bf16(un0[0], un0[1]); aw.y = cvt_pk_bf16(un0[2], un0[3]); aw.z = cvt_pk_bf16(un1[0], un1[1]); aw.w = cvt_pk_bf16(un1[2], un1[3]);
        const bf16x8 Au = *(bf16x8*)&aw;
        if (blk + 1 < SCH / 32) { const float* up = ubase + (size_t)((blk + 1) * 32 + r32) * 1024 + 8 * hi; un0 = *(const f32x4*)up; un1 = *(const f32x4*)(up + 4); }
#pragma unroll
        for (int pb = 0; pb < 2; ++pb) {
            f32x16 dre = __builtin_amdgcn_mfma_f32_32x32x16_bf16(Au, bre[pb], f32x16{}, 0, 0, 0);
            f32x16 dim = __builtin_amdgcn_mfma_f32_32x32x16_bf16(Au, bim[pb], f32x16{}, 0, 0, 0);
#pragma unroll
            for (int q = 0; q < 4; ++q)
#pragma unroll
                for (int i = 1; i < 4; ++i) { const float2 x = cfma(a1[pb], make_float2(dre[4 * q + i - 1], dim[4 * q + i - 1]), make_float2(dre[4 * q + i], dim[4 * q + i])); dre[4 * q + i] = x.x; dim[4 * q + i] = x.y; }
            float2 cin[4]; float2 cc = cst[pb];
#pragma unroll
            for (int q = 0; q < 4; ++q) { const float2 le = make_float2(dre[4 * q + 3], dim[4 * q + 3]);
                const float2 e0 = cfma(a4[pb], cc, le);
                const float2 pe0 = make_float2(xhalf(e0.x, hi), xhalf(e0.y, hi));
                const float2 e1 = cfma(a4[pb], pe0, le);
                const float2 pe1 = make_float2(xhalf(e1.x, hi), xhalf(e1.y, hi));
                cin[q] = hi ? pe0 : cc; cc = hi ? e1 : pe1; }
            cst[pb] = cc;
            if (OUT) {
#pragma unroll
                for (int q = 0; q < 4; ++q) { const float2 f1 = cmul(a1[pb], cin[q]), f2 = cmul(a2[pb], cin[q]), f3 = cmul(a3[pb], cin[q]), f4 = cmul(a4[pb], cin[q]);
                    const float2 x0 = make_float2(dre[4 * q + 0] + f1.x, dim[4 * q + 0] + f1.y), x1 = make_float2(dre[4 * q + 1] + f2.x, dim[4 * q + 1] + f2.y);
                    const float2 x2 = make_float2(dre[4 * q + 2] + f3.x, dim[4 * q + 2] + f3.y), x3 = make_float2(dre[4 * q + 3] + f4.x, dim[4 * q + 3] + f4.y);
                    LAS unsigned* xp = xs + (8 * q + 4 * hi) * 64 + pb * 32 + r32;
                    xp[0] = cvt_pk_bf16(x0.x, x0.y); xp[64] = cvt_pk_bf16(x1.x, x1.y); xp[128] = cvt_pk_bf16(x2.x, x2.y); xp[192] = cvt_pk_bf16(x3.x, x3.y); }
            }
        }
        if (OUT) {
            asm volatile("s_waitcnt lgkmcnt(0)" ::: "memory");
#pragma unroll
            for (int th = 0; th < 2; ++th) {
                f32x4 yacc = (f32x4){0.f, 0.f, 0.f, 0.f};
#pragma unroll
                for (int s_ = 0; s_ < 4; ++s_) { const bf16x8 af = *(const LAS bf16x8*)((const LAS unsigned char*)xs + (th * 16 + hh) * 256 + s_ * 64 + kq * 16);
                    yacc = __builtin_amdgcn_mfma_f32_16x16x32_bf16(af, cf[s_], yacc, 0, 0, 0); }
                u32x4 uw;
                { const float* up = ubase + (size_t)(blk * 32 + th * 16 + hh) * 1024 + 8 * (kq & 1); const f32x4 y0 = *(const f32x4*)up, y1 = *(const f32x4*)(up + 4);
                    uw.x = cvt_pk_bf16(y0[0], y0[1]); uw.y = cvt_pk_bf16(y0[2], y0[3]); uw.z = cvt_pk_bf16(y1[0], y1[1]); uw.w = cvt_pk_bf16(y1[2], y1[3]); }
                yacc = __builtin_amdgcn_mfma_f32_16x16x32_bf16(*(bf16x8*)&uw, dfr, yacc, 0, 0, 0);
#pragma unroll
                for (int j = 0; j < 4; ++j) { const int t = blk * 32 + th * 16 + 4 * kq + j; const float yv = gelu_tanh(yacc[j]);
                    P.ybuf[((size_t)b * SEQ + sc * SCH + t) * 1024 + g * GH + hh] = (bf16_t)(cvt_pk_bf16(yv, 0.f) & 0xffffu); }
            }
            asm volatile("s_waitcnt lgkmcnt(0)" ::: "memory");
        }
    }
    if (!OUT) { if (hi == 0) {
#pragma unroll
        for (int pb = 0; pb < 2; ++pb) P.Est[((size_t)(b * NG + g) * NSC + sc) * NP + pb * 32 + r32] = cst[pb]; } }
}

__device__ void phase_mixnorm(const Params& P) {
    const int tid = threadIdx.x, wid = tid >> 6, lane = tid & 63, G = gridDim.x;
    for (int row = blockIdx.x * 8 + wid; row < T_; row += G * 8) {
        const bf16_t* mp = P.mix + (size_t)row * 2048; u32x4 v[4]; float ssa = 0.f, ssb = 0.f;
#pragma unroll
        for (int i = 0; i < 4; ++i) { v[i] = *(const u32x4*)(mp + lane * 8 + 512 * i);
            const float s = bf_lo(v[i].x) * bf_lo(v[i].x) + bf_hi(v[i].x) * bf_hi(v[i].x) + bf_lo(v[i].y) * bf_lo(v[i].y) + bf_hi(v[i].y) * bf_hi(v[i].y) + bf_lo(v[i].z) * bf_lo(v[i].z) + bf_hi(v[i].z) * bf_hi(v[i].z) + bf_lo(v[i].w) * bf_lo(v[i].w) + bf_hi(v[i].w) * bf_hi(v[i].w);
            if (i < 2) ssa += s; else ssb += s; }
        ssa = wave_sum(ssa); ssb = wave_sum(ssb);
        const float ra = rsqrtf(ssa * (1.0f / 1024) + EPS), rb = rsqrtf(ssb * (1.0f / 1024) + EPS);
#pragma unroll
        for (int i = 0; i < 4; ++i) { const float r = i < 2 ? ra : rb; u32x4 w;
            w.x = cvt_pk_bf16(bf_lo(v[i].x) * r, bf_hi(v[i].x) * r); w.y = cvt_pk_bf16(bf_lo(v[i].y) * r, bf_hi(v[i].y) * r);
            w.z = cvt_pk_bf16(bf_lo(v[i].z) * r, bf_hi(v[i].z) * r); w.w = cvt_pk_bf16(bf_lo(v[i].w) * r, bf_hi(v[i].w) * r);
            *(u32x4*)(P.R1 + (size_t)row * 2048 + lane * 8 + 512 * i) = w; }
    }
}

__device__ void phase_router(const Params& P, LAS unsigned char* lds) {
    const int tid = threadIdx.x, wid = tid >> 6, lane = tid & 63, r32 = lane & 31, kh = lane >> 5, G = gridDim.x;
    LAS float* part = (LAS float*)lds;
    LAS float* ssq = (LAS float*)(lds + 65536);
    LAS float* rinv = (LAS float*)(lds + 65536 + 1024);
    LAS int* lsel = (LAS int*)(lds + 65536 + 2048); LAS int* lrank = lsel + 32 * TOPK;
    for (int unit = blockIdx.x; unit < T_ / 32; unit += G) {
        const int tok0 = unit * 32;
        f32x16 acc0 = f32x16{}, acc1 = f32x16{}; float ss = 0.f;
        const float* ap = P.h1 + (size_t)(tok0 + r32) * DM + 256 * wid + 8 * kh;
        const bf16_t* bh = P.Wr_hi + (size_t)r32 * DM + 256 * wid + 8 * kh; const bf16_t* bl = P.Wr_lo + (size_t)r32 * DM + 256 * wid + 8 * kh;
#pragma unroll 4
        for (int s_ = 0; s_ < 16; ++s_) {
            const f32x4 x0 = *(const f32x4*)(ap + 16 * s_), x1 = *(const f32x4*)(ap + 16 * s_ + 4);
            ss += x0[0] * x0[0] + x0[1] * x0[1] + x0[2] * x0[2] + x0[3] * x0[3] + x1[0] * x1[0] + x1[1] * x1[1] + x1[2] * x1[2] + x1[3] * x1[3];
            u32x4 hw, lw;
            hw.x = cvt_pk_bf16(x0[0], x0[1]); hw.y = cvt_pk_bf16(x0[2], x0[3]); hw.z = cvt_pk_bf16(x1[0], x1[1]); hw.w = cvt_pk_bf16(x1[2], x1[3]);
            lw.x = cvt_pk_bf16(x0[0] - bf_lo(hw.x), x0[1] - bf_hi(hw.x)); lw.y = cvt_pk_bf16(x0[2] - bf_lo(hw.y), x0[3] - bf_hi(hw.y));
            lw.z = cvt_pk_bf16(x1[0] - bf_lo(hw.z), x1[1] - bf_hi(hw.z)); lw.w = cvt_pk_bf16(x1[2] - bf_lo(hw.w), x1[3] - bf_hi(hw.w));
            const bf16x8 Ah = *(bf16x8*)&hw, Al = *(bf16x8*)&lw;
            const bf16x8 Bh0 = *(const bf16x8*)(bh + 16 * s_), Bh1 = *(const bf16x8*)(bh + (size_t)32 * DM + 16 * s_);
            const bf16x8 Bl0 = *(const bf16x8*)(bl + 16 * s_), Bl1 = *(const bf16x8*)(bl + (size_t)32 * DM + 16 * s_);
            acc0 = __builtin_amdgcn_mfma_f32_32x32x16_bf16(Ah, Bh0, acc0, 0, 0, 0); acc1 = __builtin_amdgcn_mfma_f32_32x32x16_bf16(Ah, Bh1, acc1, 0, 0, 0);
            acc0 = __builtin_amdgcn_mfma_f32_32x32x16_bf16(Ah, Bl0, acc0, 0, 0, 0); acc1 = __builtin_amdgcn_mfma_f32_32x32x16_bf16(Ah, Bl1, acc1, 0, 0, 0);
            acc0 = __builtin_amdgcn_mfma_f32_32x32x16_bf16(Al, Bh0, acc0, 0, 0, 0); acc1 = __builtin_amdgcn_mfma_f32_32x32x16_bf16(Al, Bh1, acc1, 0, 0, 0);
        }
#pragma unroll
        for (int r = 0; r < 16; ++r) { const int tl = crow(r, kh); part[(wid * 32 + tl) * 64 + r32] = acc0[r]; part[(wid * 32 + tl) * 64 + 32 + r32] = acc1[r]; }
        ss += __shfl_xor(ss, 32); if (kh == 0) ssq[wid * 32 + r32] = ss;
        __syncthreads();
        if (tid < 32) { float sq = 0.f;
#pragma unroll
            for (int w = 0; w < 8; ++w) sq += ssq[w * 32 + tid];
            rinv[tid] = rsqrtf(sq * (1.0f / DM) + EPS); }
        __syncthreads();
        int selE[4]; float selG[4];
#pragma unroll
        for (int tt = 0; tt < 4; ++tt) { const int tl = 4 * wid + tt; float lg = 0.f;
#pragma unroll
            for (int w = 0; w < 8; ++w) lg += part[(w * 32 + tl) * 64 + lane];
            lg *= rinv[tl];
            const float score = 1.0f / (1.0f + expf(-lg)); float selv = score + P.router_bias[lane];
            int myE = 0; float myG = 0.f, gsum = 0.f;
#pragma unroll
            for (int j = 0; j < TOPK; ++j) { const float mx = wave_max(selv); const unsigned long long bal = __ballot(selv == mx); const int first = __builtin_amdgcn_readfirstlane((int)__builtin_ctzll(bal));
                const float gsel = __shfl(score, first); gsum += gsel; if (lane == j) { myE = first; myG = gsel; } if (lane == first) selv = -3.0e38f; }
            selE[tt] = myE; selG[tt] = myG / gsum * 2.5f;
            if (lane < TOPK) lsel[tl * TOPK + lane] = myE; }
        __syncthreads();
        if (wid == 0) { int cn = 0;
            for (int i = 0; i < 32 * TOPK; ++i) { const int se = lsel[i]; if (se == lane) { lrank[i] = cn; ++cn; } }
            P.cntw[unit * NE + lane] = cn; }
        __syncthreads();
        if (lane < TOPK) {
#pragma unroll
            for (int tt = 0; tt < 4; ++tt) { const int tl = 4 * wid + tt, tok = tok0 + tl;
                P.sel_e[tok * TOPK + lane] = selE[tt]; P.sel_pos[tok * TOPK + lane] = lrank[tl * TOPK + lane]; P.sel_gate[tok * TOPK + lane] = selG[tt]; } }
#pragma unroll
        for (int tt = 0; tt < 4; ++tt) { const int tl = 4 * wid + tt; const float r = rinv[tl]; const float* hp = P.h1 + (size_t)(tok0 + tl) * DM;
#pragma unroll
            for (int i = 0; i < 8; ++i) { const f32x4 v = *(const f32x4*)(hp + 4 * lane + 256 * i); const f32x4 gn = *(const f32x4*)(P.norm_ffn + 4 * lane + 256 * i); const f32x4 mv = v * r * gn;
                u32x2 w; w.x = cvt_pk_bf16(mv[0], mv[1]); w.y = cvt_pk_bf16(mv[2], mv[3]); *(u32x2*)(P.R1 + (size_t)(tok0 + tl) * DM + 4 * lane + 256 * i) = w; } }
        __syncthreads();
    }
}

constexpr int NU = T_ / 32;
__device__ __forceinline__ void moe_counts(const Params& P, LAS int* cnt_l) {
    if (threadIdx.x < NE) { int sacc = 0;
#pragma unroll 8
        for (int u = 0; u < NU; ++u) sacc += P.cntw[u * NE + threadIdx.x];
        cnt_l[threadIdx.x] = sacc; }
}
__device__ int build_moe_tables(const Params& P, LAS unsigned char* lds) {
    LAS int* rt_e = (LAS int*)(lds + LDS_TAB); LAS int* rt_j = rt_e + 256; volatile LAS int* nrt = (volatile LAS int*)(rt_e + 512); LAS int* rt_n = rt_e + 640; LAS int* cnt_l = rt_e + 900;
    __syncthreads();
    moe_counts(P, cnt_l);
    __syncthreads();
    if (threadIdx.x == 0) { int rt = 0;
        for (int e = 0; e < NE; ++e) { const int n = cnt_l[e]; const int ntile = (n + 255) >> 8; for (int j = 0; j < ntile && rt < 256; ++j) { rt_e[rt] = e; rt_j[rt] = j; rt_n[rt] = (n - j * 256) < 256 ? (n - j * 256) : 256; ++rt; } }
        *nrt = rt; }
    __syncthreads();
    return *nrt;
}
__device__ void moe_scatter(const Params& P, LAS unsigned char* lds) {
    LAS int* bs = (LAS int*)(lds + LDS_TAB + 2100);
    const int tid = threadIdx.x, G = gridDim.x;
    for (int u = blockIdx.x; u < NU; u += G) {
        __syncthreads();
        if (tid < NE) { int b = 0;
            for (int v = 0; v < u; ++v) b += P.cntw[v * NE + tid];
            P.basew[u * NE + tid] = b; bs[tid] = b; }
        __syncthreads();
        if (tid < 32 * TOPK) { const int tok = u * 32 + tid / TOPK, k = tid % TOPK; const int e = P.sel_e[tok * TOPK + k], loc = P.sel_pos[tok * TOPK + k];
            __hip_atomic_store(&P.tok_of_row[(size_t)e * CAP + bs[e] + loc], tok, __ATOMIC_RELAXED, __HIP_MEMORY_SCOPE_AGENT); }
    }
}

__device__ void phase_combine(const Params& P, LAS unsigned char* lds) {
    const int tid = threadIdx.x, wid = tid >> 6, lane = tid & 63, G = gridDim.x;
    LAS int* rt0 = (LAS int*)(lds + LDS_TAB);
    LAS int* cnt_l = rt0 + 64;
    __syncthreads();
    moe_counts(P, cnt_l);
    __syncthreads();
    if (tid == 0) { int rt = 0; for (int e = 0; e < NE; ++e) { rt0[e] = rt; rt += (cnt_l[e] + 255) >> 8; } }
    __syncthreads();
    for (int row = blockIdx.x * 8 + wid; row < T_; row += G * 8) {
        int crw = 0; float gte = 0.f;
        if (lane < TOPK) { const int e = P.sel_e[row * TOPK + lane]; crw = rt0[e] * 256 + P.basew[(row >> 5) * NE + e] + P.sel_pos[row * TOPK + lane]; gte = P.sel_gate[row * TOPK + lane]; }
        float hv[4][8]; float ss = 0.f;
#pragma unroll
        for (int i = 0; i < 4; ++i) { const size_t o = (size_t)row * DM + lane * 8 + 512 * i; const f32x4 a = *(const f32x4*)(P.h1 + o), b2 = *(const f32x4*)(P.h1 + o + 4);
            hv[i][0] = a[0]; hv[i][1] = a[1]; hv[i][2] = a[2]; hv[i][3] = a[3]; hv[i][4] = b2[0]; hv[i][5] = b2[1]; hv[i][6] = b2[2]; hv[i][7] = b2[3];
            const u32x4 sv = *(const u32x4*)(P.Ysh + o);
            hv[i][0] += bf_lo(sv.x); hv[i][1] += bf_hi(sv.x); hv[i][2] += bf_lo(sv.y); hv[i][3] += bf_hi(sv.y); hv[i][4] += bf_lo(sv.z); hv[i][5] += bf_hi(sv.z); hv[i][6] += bf_lo(sv.w); hv[i][7] += bf_hi(sv.w); }
#pragma unroll
        for (int k = 0; k < TOPK; ++k) { const int cr = __builtin_amdgcn_readlane(crw, k); const float gt = __uint_as_float((unsigned)__builtin_amdgcn_readlane((int)__float_as_uint(gte), k)); const bf16_t* yp = P.Y + (size_t)cr * DM + lane * 8;
#pragma unroll
            for (int i = 0; i < 4; ++i) { const u32x4 y = *(const u32x4*)(yp + 512 * i);
                hv[i][0] += gt * bf_lo(y.x); hv[i][1] += gt * bf_hi(y.x); hv[i][2] += gt * bf_lo(y.y); hv[i][3] += gt * bf_hi(y.y); hv[i][4] += gt * bf_lo(y.z); hv[i][5] += gt * bf_hi(y.z); hv[i][6] += gt * bf_lo(y.w); hv[i][7] += gt * bf_hi(y.w); } }
#pragma unroll
        for (int i = 0; i < 4; ++i)
#pragma unroll
            for (int j = 0; j < 8; ++j) ss += hv[i][j] * hv[i][j];
        ss = wave_sum(ss); const float r = rsqrtf(ss * (1.0f / DM) + EPS);
#pragma unroll
        for (int i = 0; i < 4; ++i) { const size_t o = (size_t)row * DM + lane * 8 + 512 * i;
            *(f32x4*)(P.h1 + o) = (f32x4){hv[i][0], hv[i][1], hv[i][2], hv[i][3]}; *(f32x4*)(P.h1 + o + 4) = (f32x4){hv[i][4], hv[i][5], hv[i][6], hv[i][7]};
            u32x4 w; w.x = cvt_pk_bf16(hv[i][0] * r, hv[i][1] * r); w.y = cvt_pk_bf16(hv[i][2] * r, hv[i][3] * r); w.z = cvt_pk_bf16(hv[i][4] * r, hv[i][5] * r); w.w = cvt_pk_bf16(hv[i][6] * r, hv[i][7] * r);
            *(u32x4*)(P.R1 + o) = w; }
    }
}

constexpr int NPHASE = 13;
__global__ void __launch_bounds__(512, 2) fwd(Params P) {
    extern __shared__ __attribute__((aligned(16))) unsigned char shm_raw[];
    LAS unsigned char* lds = (LAS unsigned char*)shm_raw;
    const int G = gridDim.x, c = blockIdx.x;
    for (int i = threadIdx.x; i < LDS_BYTES / 16; i += 512) ((LAS u32x4*)lds)[i] = (u32x4){0u, 0u, 0u, 0u};
    __syncthreads();
    XcdBarrier bar; bar.bar = P.bar; bar.x = 0; bar.st = (volatile LAS unsigned*)(lds + LDS_BARW);
    const int lo = (int)P.ph_lo, hi = (int)P.ph_hi;
    if (hi - lo > 1) bar = xcd_barrier_post(P.bar, (volatile LAS unsigned*)(lds + LDS_BARW));
#define RUN(k) (lo <= (k) && (k) < hi)
#define SEAM(k) do { if (lo <= (k) && (k) + 1 < hi) xcd_barrier(bar); } while (0)
    auto phase_fn_0 = [&]() {
    if (RUN(0)) phase_prologue(P, lds);
    };
    phase_fn_0();
#if REP_PHASE == 0
    xcd_barrier(bar); phase_fn_0();
#endif
    SEAM(0);
    auto phase_fn_1 = [&]() {
    if (RUN(1)) { pg8::StaticOrder S; S.init(T_, NZ, DM, G, c); pg8::Gemm g{P.R1, P.Wt_in, DM, nullptr}; EpiQKVU E{P.zq, P.u}; pg8::gemm_phase<EpiQKVU, pg8::StaticOrder, false>(lds, g, S, E); }
    };
    phase_fn_1();
#if REP_PHASE == 1
    xcd_barrier(bar); phase_fn_1();
#endif
    SEAM(1);
    auto phase_fn_2 = [&]() {
    if (RUN(2)) {
        for (int u = c; u < NB * NHEAD * 8; u += G) attn_unit(P, u, lds);
        for (int it = c * 8 + (threadIdx.x >> 6); it < NB * NG * NSC; it += G * 8) ssm_item<false>(P, it, lds);
    }
    };
    phase_fn_2();
#if REP_PHASE == 2
    xcd_barrier(bar); phase_fn_2();
#endif
    SEAM(2);
    auto phase_fn_3 = [&]() {
    if (RUN(3)) { for (int it = c * 8 + (threadIdx.x >> 6); it < NB * NG * NSC; it += G * 8) ssm_item<true>(P, it, lds); }
    };
    phase_fn_3();
#if REP_PHASE == 3
    xcd_barrier(bar); phase_fn_3();
#endif
    SEAM(3);
    auto phase_fn_4 = [&]() {
    if (RUN(4)) { pg8::StaticOrder S; S.init(T_, 1024, 1024, G, c); pg8::Gemm g{P.ybuf, P.Wt_glu, 1024, nullptr}; EpiGLU E{P.ybuf, P.mix}; pg8::gemm_phase<EpiGLU, pg8::StaticOrder, false>(lds, g, S, E); }
    };
    phase_fn_4();
#if REP_PHASE == 4
    xcd_barrier(bar); phase_fn_4();
#endif
    SEAM(4);
#if REP_PHASE == 100
    xcd_barrier(bar); xcd_barrier(bar); xcd_barrier(bar); xcd_barrier(bar);
#endif
    auto phase_fn_5 = [&]() {
    if (RUN(5)) phase_mixnorm(P);
    };
    phase_fn_5();
#if REP_PHASE == 5
    xcd_barrier(bar); phase_fn_5();
#endif
    SEAM(5);
    auto phase_fn_6 = [&]() {
    if (RUN(6)) { pg8::StaticOrder S; S.init(T_, DM, DM, G, c); pg8::Gemm g{P.R1, P.Wt_out, DM, nullptr}; EpiRes E{P.x, P.h1}; pg8::gemm_phase<EpiRes, pg8::StaticOrder, false>(lds, g, S, E); }
    };
    phase_fn_6();
#if REP_PHASE == 6
    xcd_barrier(bar); phase_fn_6();
#endif
    SEAM(6);
    auto phase_fn_7 = [&]() {
    if (RUN(7)) phase_router(P, lds);
    };
    phase_fn_7();
#if REP_PHASE == 7
    xcd_barrier(bar); if (blockIdx.x == 0 && threadIdx.x < NE) P.cnt[threadIdx.x * 64] = 0u; xcd_barrier(bar); phase_fn_7();
#endif
    SEAM(7);
    auto phase_fn_8 = [&]() {
    if (RUN(8)) { moe_scatter(P, lds); if (hi - lo > 1) xcd_barrier(bar);
        const int n_rt = build_moe_tables(P, lds);
        MoeSched S; S.G = G; S.c = c; S.n_rt = n_rt; S.NPN = 4; S.K = DM; S.down = false; S.rt_e = (const LAS int*)(lds + LDS_TAB); S.rt_j = S.rt_e + 256; S.rt_n = S.rt_e + 640;
        pg8::Gemm g{P.R1, P.Wt_egu, DM, P.tok_of_row}; EpiSwiGLU E{P.H, P.Hs};
        pg8::gemm_phase<EpiSwiGLU, MoeSched, true>(lds, g, S, E); }
    };
    phase_fn_8();
#if REP_PHASE == 8
    xcd_barrier(bar); phase_fn_8();
#endif
    SEAM(8);
    auto phase_fn_9 = [&]() {
    if (RUN(9)) { const int n_rt = build_moe_tables(P, lds);
        MoeSched S; S.G = G; S.c = c; S.n_rt = n_rt; S.NPN = 8; S.K = DE; S.down = true; S.rt_e = (const LAS int*)(lds + LDS_TAB); S.rt_j = S.rt_e + 256; S.rt_n = S.rt_e + 640;
        pg8::Gemm g{P.H, P.Wt_ed, DE, nullptr}; EpiDown E{P.Y, P.Ysh};
        pg8::gemm_phase<EpiDown, MoeSched, false>(lds, g, S, E); }
    };
    phase_fn_9();
#if REP_PHASE == 9
    xcd_barrier(bar); phase_fn_9();
#endif
    SEAM(9);
    auto phase_fn_10 = [&]() {
    if (RUN(10)) phase_combine(P, lds);
    };
    phase_fn_10();
#if REP_PHASE == 10
    xcd_barrier(bar); phase_fn_10();
#endif
    SEAM(10);
    auto phase_fn_11 = [&]() {
    if (RUN(11)) { pg8::StaticOrder S; S.init(T_, DM, DPLE, G, c); pg8::Gemm g{P.pb, P.Wt_pp, DPLE, nullptr}; EpiBf16 E{P.proj, DM}; pg8::gemm_phase<EpiBf16, pg8::StaticOrder, false>(lds, g, S, E); }
    };
    phase_fn_11();
#if REP_PHASE == 11
    xcd_barrier(bar); phase_fn_11();
#endif
    SEAM(11);
    auto phase_fn_12 = [&]() {
    if (RUN(12)) { pg8::StaticOrder S; S.init(T_, DM, DM, G, c); pg8::Gemm g{P.R1, P.Wt_pg, DM, nullptr}; EpiPle E{P.out, P.proj, P.h1}; pg8::gemm_phase<EpiPle, pg8::StaticOrder, false>(lds, g, S, E); }
    };
    phase_fn_12();
#if REP_PHASE == 12
    xcd_barrier(bar); phase_fn_12();
#endif
#undef RUN
#undef SEAM
}

extern "C" void kernel_launch(void* const* d_in, const int* in_sizes, int n_in, void* d_out, int out_size, void* d_ws, size_t ws_size, hipStream_t stream) {
    static int grid = 0;
    size_t off = 0;
    auto take = [&](size_t bytes) { const size_t o = off; off += (bytes + 255) & ~(size_t)255; return o; };
    const size_t o_ctl = take(32768);
    const size_t o_Wt_in = take((size_t)4096 * 2048 * 2), o_Wt_glu = take((size_t)1024 * 1024 * 2), o_Wt_out = take((size_t)2048 * 2048 * 2), o_Wt_pg = take((size_t)2048 * 2048 * 2),
                 o_Wt_pp = take((size_t)2048 * 256 * 2), o_Wt_egu = take((size_t)(NE + 1) * 1024 * 2048 * 2), o_Wt_ed = take((size_t)(NE + 1) * 2048 * 512 * 2);
    const size_t o_R1 = take((size_t)(T_ + 1) * DM * 2), o_h1 = take((size_t)T_ * DM * 4), o_tok = take((size_t)NE * CAP * 4), o_sele = take((size_t)T_ * TOPK * 4), o_selp = take((size_t)T_ * TOPK * 4),
                 o_selg = take((size_t)T_ * TOPK * 4), o_cntw = take((size_t)(T_ / 32) * NE * 4), o_basew = take((size_t)(T_ / 32) * NE * 4), o_H = take((size_t)(65536 + T_) * DE * 2), o_Ysh = take((size_t)T_ * DM * 2), o_proj = take((size_t)T_ * DM * 2), o_pb = take((size_t)T_ * DPLE * 2),
                 o_abar = take((size_t)NG * NP * 8), o_aL = take((size_t)NG * NP * 8), o_bbar = take((size_t)NG * NP * GH * 8), o_wrh = take((size_t)NE * DM * 2), o_wrl = take((size_t)NE * DM * 2);
    const size_t o_Y = take((size_t)65536 * DM * 2);
    size_t off2 = o_Y; auto take2 = [&](size_t bytes) { const size_t o = off2; off2 += (bytes + 255) & ~(size_t)255; return o; };
    const size_t o_zq = take2((size_t)T_ * 3072 * 2), o_u = take2((size_t)T_ * 1024 * 4), o_mix = take2((size_t)T_ * 2048 * 2), o_y = take2((size_t)T_ * 1024 * 2), o_E = take2((size_t)NB * NG * NSC * NP * 8);
    const size_t ws_need = off > off2 ? off : off2;
    if (grid == 0) {
        if (n_in != 30 || in_sizes[0] != T_ * DM || out_size != T_ * DM || ws_size < ws_need) {
            fprintf(stderr, "kernel_launch: unexpected shapes: n_in %d in0 %d out %d ws %zu (need %zu); nothing launched\n", n_in, n_in > 0 ? in_sizes[0] : -1, out_size, ws_size, ws_need); grid = -1; return; }
        int dev = 0, cus = 0, per_cu = 0;
        if (hipGetDevice(&dev) != hipSuccess || hipDeviceGetAttribute(&cus, hipDeviceAttributeMultiprocessorCount, dev) != hipSuccess) { fprintf(stderr, "kernel_launch: device query failed\n"); grid = -1; return; }
        if (hipFuncSetAttribute((const void*)fwd, hipFuncAttributeMaxDynamicSharedMemorySize, LDS_BYTES) != hipSuccess) { fprintf(stderr, "kernel_launch: hipFuncSetAttribute failed\n"); grid = -1; return; }
        if (hipOccupancyMaxActiveBlocksPerMultiprocessor(&per_cu, (const void*)fwd, 512, LDS_BYTES) != hipSuccess || per_cu < 1) fprintf(stderr, "kernel_launch: note: occupancy query reports %d\n", per_cu);
        (void)hipGetLastError();
        grid = cus;
    }
    if (grid < 0) return;
    char* ws = (char*)d_ws;
    if (hipMemsetAsync(ws + o_ctl, 0, 32768, stream) != hipSuccess) { fprintf(stderr, "kernel_launch: memset failed\n"); return; }
    Params P; memset(&P, 0, sizeof(P));
    const float** inp = &P.x;
    for (int i = 0; i < 30; ++i) inp[i] = (const float*)d_in[i];
    P.out = (float*)d_out;
    P.bar = (unsigned*)(ws + o_ctl); P.cnt = (unsigned*)(ws + o_ctl + 16384);
    P.Wt_in = (bf16_t*)(ws + o_Wt_in); P.Wt_glu = (bf16_t*)(ws + o_Wt_glu); P.Wt_out = (bf16_t*)(ws + o_Wt_out); P.Wt_pg = (bf16_t*)(ws + o_Wt_pg); P.Wt_pp = (bf16_t*)(ws + o_Wt_pp);
    P.Wt_egu = (bf16_t*)(ws + o_Wt_egu); P.Wt_ed = (bf16_t*)(ws + o_Wt_ed);
    P.R1 = (bf16_t*)(ws + o_R1); P.zq = (bf16_t*)(ws + o_zq); P.mix = (bf16_t*)(ws + o_mix); P.ybuf = (bf16_t*)(ws + o_y);
    P.H = (bf16_t*)(ws + o_H); P.Hs = P.H + (size_t)65536 * DE; P.Y = (bf16_t*)(ws + o_Y); P.Ysh = (bf16_t*)(ws + o_Ysh); P.proj = (bf16_t*)(ws + o_proj); P.pb = (bf16_t*)(ws + o_pb);
    P.u = (float*)(ws + o_u); P.h1 = (float*)(ws + o_h1); P.sel_gate = (float*)(ws + o_selg);
    P.Est = (float2*)(ws + o_E); P.abar = (float2*)(ws + o_abar); P.aL = (float2*)(ws + o_aL); P.bbar = (float2*)(ws + o_bbar);
    P.tok_of_row = (int*)(ws + o_tok); P.sel_e = (int*)(ws + o_sele); P.sel_pos = (int*)(ws + o_selp); P.cntw = (int*)(ws + o_cntw); P.basew = (int*)(ws + o_basew); P.Wr_hi = (bf16_t*)(ws + o_wrh); P.Wr_lo = (bf16_t*)(ws + o_wrl);
#if MK_LAUNCHES == 1
    P.ph_lo = 0; P.ph_hi = NPHASE;
    hipLaunchKernelGGL(fwd, dim3(grid), dim3(512), LDS_BYTES, stream, P);
#else
    for (int k = 0; k < NPHASE; ++k) { P.ph_lo = k; P.ph_hi = k + 1; hipLaunchKernelGGL(fwd, dim3(grid), dim3(512), LDS_BYTES, stream, P); }
#endif
    const hipError_t le = hipPeekAtLastError();
    if (le != hipSuccess) fprintf(stderr, "kernel_launch: launch failed: %s\n", hipGetErrorName(le));
}
```

```cpp
#include <hip/hip_runtime.h>
#include <cstdio>
#include <cstdint>
#include <cstring>

#ifndef MK_LAUNCHES
#define MK_LAUNCHES 1
#endif

#ifndef REP_PHASE
#define REP_PHASE -1
#endif
#define LAS __attribute__((address_space(3)))
typedef unsigned short bf16_t;
typedef short bf16x8 __attribute__((ext_vector_type(8)));
typedef short s16x4 __attribute__((ext_vector_type(4)));
typedef float f32x4 __attribute__((ext_vector_type(4)));
typedef float f32x16 __attribute__((ext_vector_type(16)));
typedef unsigned u32x4 __attribute__((ext_vector_type(4)));
typedef unsigned u32x2 __attribute__((ext_vector_type(2)));

#define XB_TMO      128
#define XB_XCNT(j)  (256  + 64 * (j))
#define XB_XSUB(j)  (1280 + 64 * (j))
#define XB_XGEN(j)  (2304 + 64 * (j))
#define XB_TOP      3328
#define XB_TOPGEN   3392
#define XCD_BAR_WORDS 3456
#define XB_SPIN_CAP (1u << 18)

__device__ __forceinline__ unsigned xb_ld(unsigned* p)              { return __hip_atomic_load(p, __ATOMIC_RELAXED, __HIP_MEMORY_SCOPE_AGENT); }
__device__ __forceinline__ unsigned xb_add(unsigned* p, unsigned v) { return __hip_atomic_fetch_add(p, v, __ATOMIC_RELAXED, __HIP_MEMORY_SCOPE_AGENT); }
__device__ __forceinline__ unsigned xb_xcc_id() { return (unsigned)__builtin_amdgcn_s_getreg((3 << 11) | 20) & 0xFu; }
#define XB_SPIN(cond, bar) do { unsigned _sp = 0; while (cond) { __builtin_amdgcn_s_sleep(1); \
    if ((++_sp & 255u) == 0u) { if (xb_ld(&(bar)[XB_TMO])) break; if (_sp > XB_SPIN_CAP) { atomicAdd(&(bar)[XB_TMO], 1u); break; } } } } while (0)

struct XcdBarrier { unsigned* bar; unsigned x; volatile LAS unsigned* st; };

__device__ __forceinline__ XcdBarrier xcd_barrier_post(unsigned* bar, volatile LAS unsigned* st) {
    XcdBarrier b; b.bar = bar; b.x = xb_xcc_id(); b.st = st;
    if (threadIdx.x == 0) (void)xb_add(&bar[XB_XCNT(b.x)], 1u);
    return b;
}
__device__ __forceinline__ void xcd_barrier_complete(unsigned* bar, unsigned x, unsigned& nloc, unsigned& nx) {
    const unsigned G = gridDim.x * gridDim.y * gridDim.z;
    unsigned sum, cnt, mine, sp = 0u;
    for (;;) {
        sum = 0u; cnt = 0u; mine = 0u;
#pragma unroll
        for (unsigned j = 0; j < 16; ++j) { const unsigned c = xb_ld(&bar[XB_XCNT(j)]); sum += c; cnt += (c > 0u) ? 1u : 0u; mine = (j == x) ? c : mine; }
        if (sum == G) break;
        __builtin_amdgcn_s_sleep(1);
        if ((++sp & 255u) == 0u) { if (xb_ld(&bar[XB_TMO])) break; if (sp > XB_SPIN_CAP) { atomicAdd(&bar[XB_TMO], 1u); break; } }
    }
    nloc = mine > 0u ? mine : 1u; nx = cnt > 0u ? cnt : 1u;
}
__device__ __forceinline__ void xcd_barrier(const XcdBarrier& b) {
    asm volatile("s_waitcnt vmcnt(0)" ::: "memory");
    __syncthreads();
    if (threadIdx.x == 0) {
        unsigned* bar = b.bar;
        __builtin_amdgcn_s_waitcnt(0);
        unsigned nloc = b.st[0], nx = b.st[1];
        if (nloc == 0u) { xcd_barrier_complete(bar, b.x, nloc, nx); b.st[0] = nloc; b.st[1] = nx; }
        const unsigned old = xb_add(&bar[XB_XSUB(b.x)], 1u);
        const unsigned gen = old / nloc;
        if (old + 1u == (gen + 1u) * nloc) {
            __builtin_amdgcn_fence(__ATOMIC_RELEASE, "agent");
            asm volatile("s_waitcnt vmcnt(0)" ::: "memory");
            const unsigned og = xb_add(&bar[XB_TOP], 1u);
            const unsigned tg = og / nx;
            if (og + 1u == (tg + 1u) * nx) xb_add(&bar[XB_TOPGEN], 1u);
            else XB_SPIN(xb_ld(&bar[XB_TOPGEN]) == tg, bar);
            __builtin_amdgcn_fence(__ATOMIC_ACQUIRE, "agent");
            xb_add(&bar[XB_XGEN(b.x)], 1u);
            asm volatile("s_waitcnt vmcnt(0)" ::: "memory");
        } else {
            XB_SPIN(xb_ld(&bar[XB_XGEN(b.x)]) == gen, bar);
            __builtin_amdgcn_fence(__ATOMIC_ACQUIRE, "agent");
            asm volatile("s_waitcnt vmcnt(0)" ::: "memory");
        }
    }
    __syncthreads();
}

constexpr int T_ = 8192, DM = 2048, NZ = 4096, SEQ = 2048, NB = 4, NHEAD = 8, HD = 128;
constexpr int NG = 64, GH = 16, NP = 64, SCH = 256, NSC = SEQ / SCH;
constexpr int NE = 64, TOPK = 6, DE = 512, DPLE = 256, CAP = 8192;
constexpr int ZROW = T_;
constexpr float EPS = 1e-6f;

constexpr int LDS_STAGE = 131072;
constexpr int LDS_TAB = LDS_STAGE;
constexpr int LDS_BARW = LDS_STAGE + 4096;
constexpr int LDS_FLAGS = LDS_BARW + 16;
constexpr int LDS_BYTES = LDS_STAGE + 4096 + 256;

struct Params {
    const float *x, *p, *norm_mix, *w_in, *q_norm, *k_norm, *lam_re, *lam_im, *log_dt, *b_re, *b_im, *c_re, *c_im, *ssm_d, *w_glu,
                *attn_out_norm, *ssm_out_norm, *w_out, *norm_ffn, *w_router, *router_bias, *w_eg, *w_eu, *w_ed, *w_sg, *w_su, *w_sd,
                *norm_ple, *w_pg, *w_pp;
    float* out;
    unsigned* bar; unsigned* cnt;
    bf16_t *Wt_in, *Wt_glu, *Wt_out, *Wt_pg, *Wt_pp, *Wt_egu, *Wt_ed, *Wr_hi, *Wr_lo;
    bf16_t *R1, *zq, *mix, *ybuf, *H, *Hs, *Y, *Ysh, *proj, *pb;
    float *u, *h1, *sel_gate;
    float2 *Est, *abar, *aL, *bbar;
    int *tok_of_row, *sel_e, *sel_pos, *cntw, *basew;
    long long ph_lo, ph_hi;
};

typedef __bf16 bf16x2_t __attribute__((ext_vector_type(2)));
typedef float f32x2_t __attribute__((ext_vector_type(2)));
__device__ __forceinline__ unsigned cvt_pk_bf16(float lo, float hi) { const f32x2_t v = {lo, hi}; const bf16x2_t b = __builtin_convertvector(v, bf16x2_t); return __builtin_bit_cast(unsigned, b); }
__device__ __forceinline__ float bf_lo(unsigned w) { return __uint_as_float(w << 16); }
__device__ __forceinline__ float bf_hi(unsigned w) { return __uint_as_float(w & 0xffff0000u); }
__device__ __forceinline__ float sigmoidf_(float v) { return 1.0f / (1.0f + __expf(-v)); }
__device__ __forceinline__ float wave_sum(float v) {
#pragma unroll
    for (int o = 32; o >= 1; o >>= 1) v += __shfl_xor(v, o);
    return v;
}
__device__ __forceinline__ float wave_max(float v) {
#pragma unroll
    for (int o = 32; o >= 1; o >>= 1) v = fmaxf(v, __shfl_xor(v, o));
    return v;
}
__device__ __forceinline__ float gelu_tanh(float v) {
    const float c = 0.7978845608028654f;
    const float in = c * (v + 0.044715f * v * v * v);
    const float e = __expf(2.0f * in);
    const float th = 1.0f - 2.0f / (1.0f + e);
    return 0.5f * v * (1.0f + th);
}

namespace pg8 {
constexpr int BM = 256, BK = 64, HALF = 128, HTB = HALF * BK * 2, STAGE_BYTES = 8 * HTB, NXCD = 8, WGM = 8;
__host__ __device__ __forceinline__ int lds_byte(int r, int c) { const int st = (r >> 4) * 2 + (c >> 5), rr = r & 15, cc = c & 31, ob = rr * 64 + cc * 2; return st * 1024 + (ob ^ (((ob >> 9) & 1) << 5)); }
__host__ __device__ __forceinline__ void stage_rc(int b, int& R, int& C) { const int st = b / 1024, sb = b % 1024, swz = sb ^ (((sb >> 9) & 1) << 5); R = (st >> 1) * 16 + swz / 64; C = (st & 1) * 32 + (swz % 64) / 2; }
__host__ __device__ __forceinline__ int perm32(int rho) { const int n = rho >> 4, i = rho & 15; return 8 * (i >> 2) + 4 * n + (i & 3); }

struct Unit { int pm, pn, kind, nrows, arow, brow, orow0, gofs; };
struct Gemm { const bf16_t* A; const bf16_t* Bt; int K; const int* gtab; };

struct StaticOrder {
    int nM, nN, nwg, G, c, K;
    __device__ void init(int M, int N, int K_, int G_, int c_) { nM = M / BM; nN = N / BM; nwg = nM * nN; G = G_; c = c_; K = K_; }
    __device__ __forceinline__ Unit next(int i) const {
        Unit u; const long L = (long)i * G + c; const bool valid = L < nwg;
        int wgid = valid ? (int)L : 0; { const int q = nwg / NXCD, r = nwg % NXCD, xcd = wgid % NXCD, off = wgid / NXCD; wgid = (xcd < r ? xcd * (q + 1) : r * (q + 1) + (xcd - r) * q) + off; }
        const int nig = WGM * nN, gid = wgid / nig, fm = gid * WGM, gsz = (nM - fm) < WGM ? (nM - fm) : WGM;
        u.pm = fm + ((wgid % nig) % gsz); u.pn = (wgid % nig) / gsz;
        u.arow = u.pm * BM; u.brow = u.pn * BM; u.gofs = -1; u.nrows = BM; u.kind = 0; u.orow0 = u.pm * BM;
        if (!valid) u.pm = -1;
        return u;
    }
};

template <class Epi, class Sched, bool GATHER>
__device__ __forceinline__ void gemm_phase(LAS unsigned char* lds, const Gemm g, const Sched& S, const Epi& E) {
    const int tid = threadIdx.x, wid = __builtin_amdgcn_readfirstlane(tid >> 6), lane = tid & 63, wr = wid >> 2, wc = wid & 3, fr = lane & 15, fq = lane >> 4;
    const int K = g.K, nt = K / BK;
    unsigned voffA[2], voffB[2];
#pragma unroll
    for (int i = 0; i < 2; ++i) { int R, C; stage_rc(tid * 16 + i * 8192, R, C); const int Rb = Epi::PERM ? ((R & ~31) + perm32(R & 31)) : R;
        voffA[i] = (unsigned)(R * K + C) * 2u; voffB[i] = (unsigned)(Rb * K + C) * 2u; }
    const size_t kstep = (size_t)(BK * 2);
    const size_t hstep = (size_t)HALF * K * 2;
    const unsigned ldsw = (unsigned)wid * 1024u;
    const int aoff = lds_byte(wr * 64 + fr, fq * 8), boff = lds_byte(wc * 32 + fr, fq * 8);
#define PG8_SA(b, h) (((b) * 2 + (h)) * HTB)
#define PG8_SB(b, h) ((4 + (b) * 2 + (h)) * HTB)
#define PG8_STAGE(bufoff, gbase, voff) do { _Pragma("unroll") for (int _i = 0; _i < 2; ++_i) \
        __builtin_amdgcn_global_load_lds((const unsigned*)((const char*)(gbase) + (voff)[_i]), (LAS unsigned*)(lds + (bufoff) + ldsw + _i * 8192), 16, 0, 0); } while (0)
#define PG8_LDA(dst, b, h) do { _Pragma("unroll") for (int m = 0; m < 4; ++m) _Pragma("unroll") for (int k = 0; k < 2; ++k) dst[m][k] = *(const LAS bf16x8*)(lds + PG8_SA(b, h) + aoff + m * 2048 + k * 1024); } while (0)
#define PG8_LDB(dst, b, h) do { _Pragma("unroll") for (int n = 0; n < 2; ++n) _Pragma("unroll") for (int k = 0; k < 2; ++k) dst[n][k] = *(const LAS bf16x8*)(lds + PG8_SB(b, h) + boff + n * 2048 + k * 1024); } while (0)
#define PG8_MMA(ai, bj, At, Bt) do { __builtin_amdgcn_s_setprio(1); _Pragma("unroll") for (int m = 0; m < 4; ++m) _Pragma("unroll") for (int n = 0; n < 2; ++n) _Pragma("unroll") for (int k = 0; k < 2; ++k) \
        acc[ai][bj][m][n] = __builtin_amdgcn_mfma_f32_16x16x32_bf16(Bt[n][k], At[m][k], acc[ai][bj][m][n], 0, 0, 0); __builtin_amdgcn_s_setprio(0); } while (0)
#define PG8_WAIT_V(n) asm volatile("s_waitcnt vmcnt(" #n ")" ::: "memory")
#define PG8_WAIT_L(n) asm volatile("s_waitcnt lgkmcnt(" #n ")" ::: "memory")
#define PG8_BAR __builtin_amdgcn_s_barrier()
#define PG8_SCHED __builtin_amdgcn_sched_barrier(0)
    Unit cur = S.next(0), nxt; int ui = 0;
    if (cur.pm < 0) return;
    f32x4 acc[2][2][4][2];
#pragma unroll
    for (int a = 0; a < 2; ++a)
#pragma unroll
        for (int b = 0; b < 2; ++b)
#pragma unroll
            for (int m = 0; m < 4; ++m)
#pragma unroll
                for (int n = 0; n < 2; ++n) acc[a][b][m][n] = (f32x4){0.f, 0.f, 0.f, 0.f};
    bf16x8 At[4][2], B0[2][2], B1[2][2];
    unsigned cvo0[2] = {0u, 0u}, cvo1[2] = {0u, 0u}, nvo0[2] = {0u, 0u}, nvo1[2] = {0u, 0u};
    auto load_vo = [&](const Unit& u, unsigned (&v0)[2], unsigned (&v1)[2]) {
#pragma unroll
        for (int i = 0; i < 2; ++i) { int R, C; stage_rc(tid * 16 + i * 8192, R, C);
            int r0 = R, r1 = HALF + R;
            int t0, t1;
            if (u.gofs >= 0) { t0 = (r0 < u.nrows) ? g.gtab[u.gofs + r0] : ZROW; t1 = (r1 < u.nrows) ? g.gtab[u.gofs + r1] : ZROW; }
            else { t0 = u.orow0 + r0; t1 = u.orow0 + r1; }
            v0[i] = (unsigned)t0 * (unsigned)(K * 2) + (unsigned)(C * 2); v1[i] = (unsigned)t1 * (unsigned)(K * 2) + (unsigned)(C * 2); }
    };
    const size_t rowb = (size_t)K * 2;
    const char* cA = (const char*)g.A + (GATHER ? 0 : (size_t)cur.arow * rowb); const char* cB = (const char*)g.Bt + (size_t)cur.brow * rowb;
    if (GATHER) load_vo(cur, cvo0, cvo1);
    if (GATHER) {
        PG8_STAGE(PG8_SB(0, 0), cB, voffB); PG8_STAGE(PG8_SA(0, 0), cA, cvo0); PG8_STAGE(PG8_SB(0, 1), cB + hstep, voffB); PG8_STAGE(PG8_SA(0, 1), cA, cvo1);
    } else {
        PG8_STAGE(PG8_SB(0, 0), cB, voffB); PG8_STAGE(PG8_SA(0, 0), cA, voffA); PG8_STAGE(PG8_SB(0, 1), cB + hstep, voffB); PG8_STAGE(PG8_SA(0, 1), cA + hstep, voffA);
    }
    if (wr == 1) PG8_BAR;
    PG8_WAIT_V(4); PG8_BAR;
    if (GATHER) {
        PG8_STAGE(PG8_SB(1, 0), cB + kstep, voffB); PG8_STAGE(PG8_SA(1, 0), cA + kstep, cvo0); PG8_STAGE(PG8_SB(1, 1), cB + hstep + kstep, voffB);
    } else {
        PG8_STAGE(PG8_SB(1, 0), cB + kstep, voffB); PG8_STAGE(PG8_SA(1, 0), cA + kstep, voffA); PG8_STAGE(PG8_SB(1, 1), cB + hstep + kstep, voffB);
    }
    PG8_WAIT_V(6); PG8_BAR;
    for (;;) {
        nxt = S.next(ui + 1); const bool has_next = nxt.pm >= 0;
        const char* nA = GATHER ? cA : (has_next ? (const char*)g.A + (size_t)nxt.arow * rowb : cA); const char* nB = has_next ? (const char*)g.Bt + (size_t)nxt.brow * rowb : cB;
        if (GATHER) { if (has_next) load_vo(nxt, nvo0, nvo1); else { nvo0[0] = cvo0[0]; nvo0[1] = cvo0[1]; nvo1[0] = cvo1[0]; nvo1[1] = cvo1[1]; } }
        for (int t = 0; t < nt; t += 2) {
            const bool last = (t == nt - 2);
            const char* a1 = cA + (size_t)(t + 1) * kstep;
            const char* a2 = last ? nA : cA + (size_t)(t + 2) * kstep; const char* b2 = last ? nB : cB + (size_t)(t + 2) * kstep;
            const char* a3 = a2 + kstep; const char* b3 = b2 + kstep;
            unsigned s0[2], s1[2];
            if (GATHER) { s0[0] = last ? nvo0[0] : cvo0[0]; s0[1] = last ? nvo0[1] : cvo0[1]; s1[0] = last ? nvo1[0] : cvo1[0]; s1[1] = last ? nvo1[1] : cvo1[1]; }
            PG8_LDB(B0, 0, 0); PG8_SCHED; PG8_LDA(At, 0, 0);
            if (GATHER) PG8_STAGE(PG8_SA(1, 1), a1, cvo1); else PG8_STAGE(PG8_SA(1, 1), a1 + hstep, voffA);
            PG8_WAIT_L(8); PG8_BAR; PG8_WAIT_L(0); PG8_MMA(0, 0, At, B0); PG8_BAR; PG8_SCHED;
            PG8_LDB(B1, 0, 1); PG8_STAGE(PG8_SB(0, 0), b2, voffB);
            PG8_BAR; PG8_WAIT_L(0); PG8_MMA(0, 1, At, B1); PG8_BAR;
            PG8_LDA(At, 0, 1);
            if (GATHER) PG8_STAGE(PG8_SA(0, 0), a2, s0); else PG8_STAGE(PG8_SA(0, 0), a2, voffA);
            PG8_BAR; PG8_WAIT_L(0); PG8_MMA(1, 0, At, B0); PG8_BAR; PG8_SCHED;
            PG8_STAGE(PG8_SB(0, 1), b2 + hstep, voffB);
            PG8_WAIT_V(6); PG8_BAR; PG8_MMA(1, 1, At, B1); PG8_BAR;
            PG8_LDB(B0, 1, 0); PG8_SCHED; PG8_LDA(At, 1, 0);
            if (GATHER) PG8_STAGE(PG8_SA(0, 1), a2, s1); else PG8_STAGE(PG8_SA(0, 1), a2 + hstep, voffA);
            PG8_WAIT_L(8); PG8_BAR; PG8_WAIT_L(0); PG8_MMA(0, 0, At, B0); PG8_BAR; PG8_SCHED;
            PG8_LDB(B1, 1, 1); PG8_STAGE(PG8_SB(1, 0), b3, voffB);
            PG8_BAR; PG8_WAIT_L(0); PG8_MMA(0, 1, At, B1); PG8_BAR;
            PG8_LDA(At, 1, 1);
            if (GATHER) PG8_STAGE(PG8_SA(1, 0), a3, s0); else PG8_STAGE(PG8_SA(1, 0), a3, voffA);
            PG8_BAR; PG8_WAIT_L(0); PG8_MMA(1, 0, At, B0); PG8_BAR; PG8_SCHED;
            PG8_STAGE(PG8_SB(1, 1), b3 + hstep, voffB);
            PG8_WAIT_V(6); PG8_BAR; PG8_MMA(1, 1, At, B1); PG8_BAR;
        }
        E(acc, cur, wr, wc, fr, fq);
        if (!has_next) break;
#pragma unroll
        for (int a = 0; a < 2; ++a)
#pragma unroll
            for (int b = 0; b < 2; ++b)
#pragma unroll
                for (int m = 0; m < 4; ++m)
#pragma unroll
                    for (int n = 0; n < 2; ++n) acc[a][b][m][n] = (f32x4){0.f, 0.f, 0.f, 0.f};
        cur = nxt; cA = nA; cB = nB; ++ui;
        if (GATHER) { cvo0[0] = nvo0[0]; cvo0[1] = nvo0[1]; cvo1[0] = nvo1[0]; cvo1[1] = nvo1[1]; }
    }
    PG8_WAIT_V(0);
    if (wr == 0) PG8_BAR;
    PG8_BAR;
#undef PG8_SA
#undef PG8_SB
#undef PG8_STAGE
#undef PG8_LDA
#undef PG8_LDB
#undef PG8_MMA
#undef PG8_WAIT_V
#undef PG8_WAIT_L
#undef PG8_BAR
#undef PG8_SCHED
}
}
using pg8::Unit;

typedef f32x4 Acc[2][2][4][2];

template <int O0, int O1, int O2, int O3>
__device__ __forceinline__ void ld4x16(const void* p, f32x4& a, f32x4& b, f32x4& c, f32x4& d) {
    asm volatile("global_load_dwordx4 %0, %4, off offset:%5\n\tglobal_load_dwordx4 %1, %4, off offset:%6\n\tglobal_load_dwordx4 %2, %4, off offset:%7\n\tglobal_load_dwordx4 %3, %4, off offset:%8\n\ts_waitcnt vmcnt(0)"
                 : "=&v"(a), "=&v"(b), "=&v"(c), "=&v"(d) : "v"(p), "i"(O0), "i"(O1), "i"(O2), "i"(O3) : "memory");
}
template <int O0, int O1, int O2, int O3>
__device__ __forceinline__ void ld4x16_4x8(const void* p, f32x4& a, f32x4& b, f32x4& c, f32x4& d, const void* q, u32x2& e, u32x2& f, u32x2& g, u32x2& h) {
    asm volatile("global_load_dwordx4 %0, %8, off offset:%10\n\tglobal_load_dwordx4 %1, %8, off offset:%11\n\tglobal_load_dwordx4 %2, %8, off offset:%12\n\tglobal_load_dwordx4 %3, %8, off offset:%13\n\t"
                 "global_load_dwordx2 %4, %9, off offset:%14\n\tglobal_load_dwordx2 %5, %9, off offset:%15\n\tglobal_load_dwordx2 %6, %9, off offset:%16\n\tglobal_load_dwordx2 %7, %9, off offset:%17\n\ts_waitcnt vmcnt(0)"
                 : "=&v"(a), "=&v"(b), "=&v"(c), "=&v"(d), "=&v"(e), "=&v"(f), "=&v"(g), "=&v"(h)
                 : "v"(p), "v"(q), "i"(O0), "i"(O1), "i"(O2), "i"(O3), "i"(O0 / 2), "i"(O1 / 2), "i"(O2 / 2), "i"(O3 / 2) : "memory");
}
struct EpiQKVU {
    static constexpr bool PERM = true;
    bf16_t* zq; float* u;
    __device__ __forceinline__ void operator()(const Acc& acc, const Unit& un, int wr, int wc, int fr, int fq) const {
        const int row0 = un.pm * 256 + wr * 64 + fr, col0 = un.pn * 256 + wc * 32 + 8 * fq;
        if (un.pn < 12) {
#pragma unroll
            for (int ai = 0; ai < 2; ++ai)
#pragma unroll
                for (int m = 0; m < 4; ++m) { bf16_t* rowp = zq + (size_t)(row0 + ai * 128 + m * 16) * 3072 + col0;
#pragma unroll
                    for (int bj = 0; bj < 2; ++bj) { const f32x4 v0 = acc[ai][bj][m][0], v1 = acc[ai][bj][m][1];
                        u32x4 w; w.x = cvt_pk_bf16(v0[0], v0[1]); w.y = cvt_pk_bf16(v0[2], v0[3]); w.z = cvt_pk_bf16(v1[0], v1[1]); w.w = cvt_pk_bf16(v1[2], v1[3]);
                        *(u32x4*)(rowp + bj * 128) = w; } }
        } else {
#pragma unroll
            for (int ai = 0; ai < 2; ++ai)
#pragma unroll
                for (int m = 0; m < 4; ++m) { float* rowp = u + (size_t)(row0 + ai * 128 + m * 16) * 1024 + (col0 - 3072);
#pragma unroll
                    for (int bj = 0; bj < 2; ++bj) { *(f32x4*)(rowp + bj * 128) = acc[ai][bj][m][0]; *(f32x4*)(rowp + bj * 128 + 4) = acc[ai][bj][m][1]; } }
        }
    }
};
struct EpiGLU {
    static constexpr bool PERM = true;
    const bf16_t* __restrict__ y; bf16_t* __restrict__ mix;
    __device__ __forceinline__ void operator()(const Acc& acc, const Unit& un, int wr, int wc, int fr, int fq) const {
        const int row0 = un.pm * 256 + wr * 64 + fr, col0 = un.pn * 256 + wc * 32 + 8 * fq;
#pragma unroll
        for (int ai = 0; ai < 2; ++ai)
#pragma unroll
            for (int m = 0; m < 4; ++m) { const size_t row = (size_t)(row0 + ai * 128 + m * 16);
#pragma unroll
                for (int bj = 0; bj < 2; ++bj) { const f32x4 v0 = acc[ai][bj][m][0], v1 = acc[ai][bj][m][1];
                    const u32x4 yv = *(const u32x4*)(y + row * 1024 + col0 + bj * 128);
                    u32x4 w;
                    w.x = cvt_pk_bf16(bf_lo(yv.x) * sigmoidf_(v0[0]), bf_hi(yv.x) * sigmoidf_(v0[1]));
                    w.y = cvt_pk_bf16(bf_lo(yv.y) * sigmoidf_(v0[2]), bf_hi(yv.y) * sigmoidf_(v0[3]));
                    w.z = cvt_pk_bf16(bf_lo(yv.z) * sigmoidf_(v1[0]), bf_hi(yv.z) * sigmoidf_(v1[1]));
                    w.w = cvt_pk_bf16(bf_lo(yv.w) * sigmoidf_(v1[2]), bf_hi(yv.w) * sigmoidf_(v1[3]));
                    *(u32x4*)(mix + row * 2048 + 1024 + col0 + bj * 128) = w; } }
    }
};
struct EpiRes {
    static constexpr bool PERM = false;
    const float* x; float* h1;
    __device__ __forceinline__ void operator()(const Acc& acc, const Unit& un, int wr, int wc, int fr, int fq) const {
        const int row0 = un.pm * 256 + wr * 64 + fr, col0 = un.pn * 256 + wc * 32 + 4 * fq;
#pragma unroll
        for (int ai = 0; ai < 2; ++ai)
#pragma unroll
            for (int m = 0; m < 4; ++m) { const size_t ro = (size_t)(row0 + ai * 128 + m * 16) * 2048 + col0;
                f32x4 x00, x01, x10, x11; ld4x16<0, 64, 512, 576>(x + ro, x00, x01, x10, x11);
                *(f32x4*)(h1 + ro) = x00 + acc[ai][0][m][0]; *(f32x4*)(h1 + ro + 16) = x01 + acc[ai][0][m][1];
                *(f32x4*)(h1 + ro + 128) = x10 + acc[ai][1][m][0]; *(f32x4*)(h1 + ro + 144) = x11 + acc[ai][1][m][1]; }
    }
};
struct EpiSwiGLU {
    static constexpr bool PERM = true;
    bf16_t* H; bf16_t* Hs;
    __device__ __forceinline__ void operator()(const Acc& acc, const Unit& un, int wr, int wc, int fr, int fq) const {
        bf16_t* base = un.kind ? Hs : H;
        const size_t row0 = (size_t)un.orow0 + wr * 64 + fr; const int col0 = un.pn * 128 + wc * 32 + 8 * fq;
#pragma unroll
        for (int ai = 0; ai < 2; ++ai)
#pragma unroll
            for (int m = 0; m < 4; ++m) { const f32x4 g0 = acc[ai][0][m][0], g1 = acc[ai][0][m][1], u0 = acc[ai][1][m][0], u1 = acc[ai][1][m][1];
                u32x4 w;
                w.x = cvt_pk_bf16(g0[0] * sigmoidf_(g0[0]) * u0[0], g0[1] * sigmoidf_(g0[1]) * u0[1]);
                w.y = cvt_pk_bf16(g0[2] * sigmoidf_(g0[2]) * u0[2], g0[3] * sigmoidf_(g0[3]) * u0[3]);
                w.z = cvt_pk_bf16(g1[0] * sigmoidf_(g1[0]) * u1[0], g1[1] * sigmoidf_(g1[1]) * u1[1]);
                w.w = cvt_pk_bf16(g1[2] * sigmoidf_(g1[2]) * u1[2], g1[3] * sigmoidf_(g1[3]) * u1[3]);
                *(u32x4*)(base + (row0 + ai * 128 + m * 16) * 512 + col0) = w; }
    }
};
struct EpiDown {
    static constexpr bool PERM = true;
    bf16_t* Y; bf16_t* Ysh;
    __device__ __forceinline__ void operator()(const Acc& acc, const Unit& un, int wr, int wc, int fr, int fq) const {
        const int col0 = un.pn * 256 + wc * 32 + 8 * fq; bf16_t* base = (un.kind ? Ysh : Y) + (size_t)un.orow0 * 2048 + col0;
#pragma unroll
        for (int ai = 0; ai < 2; ++ai)
#pragma unroll
            for (int m = 0; m < 4; ++m) { const int r = ai * 128 + wr * 64 + m * 16 + fr;
                if (r < un.nrows) { bf16_t* rowp = base + (size_t)r * 2048;
#pragma unroll
                    for (int bj = 0; bj < 2; ++bj) { const f32x4 v0 = acc[ai][bj][m][0], v1 = acc[ai][bj][m][1];
                        u32x4 w; w.x = cvt_pk_bf16(v0[0], v0[1]); w.y = cvt_pk_bf16(v0[2], v0[3]); w.z = cvt_pk_bf16(v1[0], v1[1]); w.w = cvt_pk_bf16(v1[2], v1[3]);
                        *(u32x4*)(rowp + bj * 128) = w; } } }
    }
};
struct EpiBf16 {
    static constexpr bool PERM = true;
    bf16_t* O; int ldo;
    __device__ __forceinline__ void operator()(const Acc& acc, const Unit& un, int wr, int wc, int fr, int fq) const {
        const int row0 = un.pm * 256 + wr * 64 + fr, col0 = un.pn * 256 + wc * 32 + 8 * fq;
#pragma unroll
        for (int ai = 0; ai < 2; ++ai)
#pragma unroll
            for (int m = 0; m < 4; ++m) { bf16_t* rowp = O + (size_t)(row0 + ai * 128 + m * 16) * ldo + col0;
#pragma unroll
                for (int bj = 0; bj < 2; ++bj) { const f32x4 v0 = acc[ai][bj][m][0], v1 = acc[ai][bj][m][1];
                    u32x4 w; w.x = cvt_pk_bf16(v0[0], v0[1]); w.y = cvt_pk_bf16(v0[2], v0[3]); w.z = cvt_pk_bf16(v1[0], v1[1]); w.w = cvt_pk_bf16(v1[2], v1[3]);
                    *(u32x4*)(rowp + bj * 128) = w; } }
    }
};
struct EpiPle {
    static constexpr bool PERM = false;
    float* out; const bf16_t* proj; const float* h2;
    __device__ __forceinline__ void operator()(const Acc& acc, const Unit& un, int wr, int wc, int fr, int fq) const {
        const int row0 = un.pm * 256 + wr * 64 + fr, col0 = un.pn * 256 + wc * 32 + 4 * fq;
#pragma unroll
        for (int ai = 0; ai < 2; ++ai)
#pragma unroll
            for (int m = 0; m < 4; ++m) { const size_t ro = (size_t)(row0 + ai * 128 + m * 16) * 2048 + col0;
                f32x4 hv[4]; u32x2 pv[4]; ld4x16_4x8<0, 64, 512, 576>(h2 + ro, hv[0], hv[1], hv[2], hv[3], proj + ro, pv[0], pv[1], pv[2], pv[3]);
#pragma unroll
                for (int q = 0; q < 4; ++q) { const int bj = q >> 1, n = q & 1; const f32x4 a = acc[ai][bj][m][n]; f32x4 r;
                    r[0] = hv[q][0] + sigmoidf_(a[0]) * bf_lo(pv[q].x); r[1] = hv[q][1] + sigmoidf_(a[1]) * bf_hi(pv[q].x);
                    r[2] = hv[q][2] + sigmoidf_(a[2]) * bf_lo(pv[q].y); r[3] = hv[q][3] + sigmoidf_(a[3]) * bf_hi(pv[q].y);
                    *(f32x4*)(out + ro + bj * 128 + n * 16) = r; } }
    }
};

struct MoeSched {
    int G, c, n_rt, NPN, K; bool down;
    const LAS int* rt_e; const LAS int* rt_j; const LAS int* rt_n;
    __device__ __forceinline__ Unit next(int i) const {
        Unit u; const int L = i * G + c; const int nr = n_rt * NPN; const int tot = nr + 32 * NPN;
        const bool valid = L < tot, routed = L < nr;
        const int Lr = routed ? L : 0, Ls = (!routed && valid) ? (L - nr) : 0;
        const int rt = Lr / NPN;
        const int e = __builtin_amdgcn_readfirstlane(rt_e[rt]), j = __builtin_amdgcn_readfirstlane(rt_j[rt]);
        const int rem = __builtin_amdgcn_readfirstlane(rt_n[rt]);
        const int spm = Ls / NPN;
        u.kind = routed ? 0 : 1;
        u.pn = routed ? (Lr % NPN) : (Ls % NPN);
        u.pm = routed ? rt : spm;
        u.nrows = routed ? rem : 256;
        const int ee = routed ? e : NE;
        if (!down) {
            u.arow = 0; u.gofs = routed ? (e * CAP + j * 256) : -1;
            u.brow = ee * 1024 + u.pn * 256;
            u.orow0 = routed ? rt * 256 : spm * 256;
        } else {
            u.gofs = -1;
            u.arow = routed ? rt * 256 : 65536 + spm * 256;
            u.brow = ee * 2048 + u.pn * 256;
            u.orow0 = routed ? rt * 256 : spm * 256;
        }
        if (!valid) u.pm = -1;
        return u;
    }
};

__device__ __forceinline__ void cvt_tile(const float* __restrict__ src, int ldw, int k0, int n0, const float* __restrict__ gain, bf16_t* __restrict__ dst, int ldd, int dk0,
                                         int inter, int roff, LAS float* lt) {
    const int tid = threadIdx.x, c4 = tid & 63, r8 = tid >> 6;
    f32x4 v[8];
#pragma unroll
    for (int i = 0; i < 8; ++i) v[i] = *(const f32x4*)(src + (size_t)(k0 + r8 + 8 * i) * ldw + n0 + 4 * c4);
#pragma unroll
    for (int i = 0; i < 8; ++i) { const int k = r8 + 8 * i; const float gsc = gain ? gain[k0 + k] : 1.0f; LAS float* q = lt + k * 257 + 4 * c4;
        q[0] = v[i][0] * gsc; q[1] = v[i][1] * gsc; q[2] = v[i][2] * gsc; q[3] = v[i][3] * gsc; }
    __syncthreads();
#pragma unroll
    for (int i = 0; i < 4; ++i) { const int q = tid + 512 * i, kg = q & 7, n = q >> 3; const LAS float* s = lt + (8 * kg) * 257 + n;
        u32x4 w; w.x = cvt_pk_bf16(s[0], s[257]); w.y = cvt_pk_bf16(s[2 * 257], s[3 * 257]); w.z = cvt_pk_bf16(s[4 * 257], s[5 * 257]); w.w = cvt_pk_bf16(s[6 * 257], s[7 * 257]);
        const int ng = n0 + n; const int drow = inter ? ((ng >> 7) * 256 + roff + (ng & 127)) : ng;
        *(u32x4*)(dst + (size_t)drow * ldd + dk0 + k0 + 8 * kg) = w; }
    __syncthreads();
}
__device__ __forceinline__ void cvt_job(long& base, const float* src, int K, int N, const float* gain, bf16_t* dst, int ldd, int dk0, int inter, int roff, LAS float* lt) {
    const int nk = K / 64, nn = N / 256, ntl = nk * nn, G = gridDim.x;
    int t = (int)(((long)blockIdx.x - base % G + G) % G);
    for (; t < ntl; t += G) { const int kt = t % nk, ntile = t / nk; cvt_tile(src, N, kt * 64, ntile * 256, gain, dst, ldd, dk0, inter, roff, lt); }
    base += ntl;
}
__device__ void phase_prologue(const Params& P, LAS unsigned char* lds) {
    LAS float* lt = (LAS float*)lds;
    const int tid = threadIdx.x, wid = tid >> 6, lane = tid & 63, G = gridDim.x;
    for (int row = blockIdx.x * 8 + wid; row < T_; row += G * 8) {
        const float* xr = P.x + (size_t)row * DM; f32x4 v[8]; float ss = 0.f;
#pragma unroll
        for (int i = 0; i < 8; ++i) { v[i] = *(const f32x4*)(xr + 4 * lane + 256 * i); ss += v[i][0] * v[i][0] + v[i][1] * v[i][1] + v[i][2] * v[i][2] + v[i][3] * v[i][3]; }
        ss = wave_sum(ss); const float r = rsqrtf(ss * (1.0f / DM) + EPS);
#pragma unroll
        for (int i = 0; i < 8; ++i) { u32x2 w; w.x = cvt_pk_bf16(v[i][0] * r, v[i][1] * r); w.y = cvt_pk_bf16(v[i][2] * r, v[i][3] * r); *(u32x2*)(P.R1 + (size_t)row * DM + 4 * lane + 256 * i) = w; }
    }
    if (blockIdx.x == 0) { for (int i = tid; i < DM / 2; i += 512) ((unsigned*)(P.R1 + (size_t)ZROW * DM))[i] = 0u; }
    for (size_t i = (size_t)blockIdx.x * 512 + tid; i < (size_t)T_ * DPLE / 8; i += (size_t)G * 512) { const f32x4 a = *(const f32x4*)(P.p + i * 8), b2 = *(const f32x4*)(P.p + i * 8 + 4);
        u32x4 w; w.x = cvt_pk_bf16(a[0], a[1]); w.y = cvt_pk_bf16(a[2], a[3]); w.z = cvt_pk_bf16(b2[0], b2[1]); w.w = cvt_pk_bf16(b2[2], b2[3]); *(u32x4*)(P.pb + i * 8) = w; }
    for (int i = blockIdx.x * 512 + tid; i < NG * NP; i += G * 512) {
        const int g = i / NP;
        const float lr = P.lam_re[i], li = P.lam_im[i]; const float dt = expf(P.log_dt[g]);
        const double mag = exp((double)lr * (double)dt), ang = (double)li * (double)dt;
        const float ar = (float)(mag * cos(ang)), ai = (float)(mag * sin(ang));
        const double magL = exp((double)lr * (double)dt * SCH), angL = ang * SCH;
        P.abar[i] = make_float2(ar, ai); P.aL[i] = make_float2((float)(magL * cos(angL)), (float)(magL * sin(angL)));
        const float nr = ar - 1.0f, ni = ai, den = lr * lr + li * li;
        const float cr = (nr * lr + ni * li) / den, ci = (ni * lr - nr * li) / den;
#pragma unroll
        for (int h = 0; h < GH; ++h) { const float br = P.b_re[(size_t)i * GH + h], bi = P.b_im[(size_t)i * GH + h];
            P.bbar[(size_t)i * GH + h] = make_float2(cr * br - ci * bi, cr * bi + ci * br); }
    }
    for (int i = blockIdx.x * 512 + tid; i < NE * DM; i += G * 512) { const int e = i / DM, k = i % DM; const float w = P.w_router[(size_t)k * NE + e] * P.norm_ffn[k];
        const unsigned hw = cvt_pk_bf16(w, 0.f); const float hf = bf_lo(hw); P.Wr_hi[i] = (bf16_t)(hw & 0xffffu); P.Wr_lo[i] = (bf16_t)(cvt_pk_bf16(w - hf, 0.f) & 0xffffu); }
    long base = 0;
    cvt_job(base, P.w_in, 2048, 4096, P.norm_mix, P.Wt_in, 2048, 0, 0, 0, lt);
    cvt_job(base, P.w_glu, 1024, 1024, nullptr, P.Wt_glu, 1024, 0, 0, 0, lt);
    cvt_job(base, P.w_out, 1024, 2048, P.attn_out_norm, P.Wt_out, 2048, 0, 0, 0, lt);
    cvt_job(base, P.w_out + (size_t)1024 * 2048, 1024, 2048, P.ssm_out_norm, P.Wt_out, 2048, 1024, 0, 0, lt);
    cvt_job(base, P.w_sg, 2048, 512, nullptr, P.Wt_egu + (size_t)NE * 1024 * 2048, 2048, 0, 1, 0, lt);
    cvt_job(base, P.w_su, 2048, 512, nullptr, P.Wt_egu + (size_t)NE * 1024 * 2048, 2048, 0, 1, 128, lt);
    cvt_job(base, P.w_sd, 512, 2048, nullptr, P.Wt_ed + (size_t)NE * 2048 * 512, 512, 0, 0, 0, lt);
    cvt_job(base, P.w_pg, 2048, 2048, P.norm_ple, P.Wt_pg, 2048, 0, 0, 0, lt);
    cvt_job(base, P.w_pp, 256, 2048, nullptr, P.Wt_pp, 256, 0, 0, 0, lt);
    {
        const int ntl = NE * 192; int t = (int)(((long)blockIdx.x - base % G + G) % G);
        for (; t < ntl; t += G) { const int e = t / 192, r = t % 192;
            if (r < 128) { const int up = r >> 6, q = r & 63, kt = q & 31, ntile = q >> 5;
                cvt_tile((up ? P.w_eu : P.w_eg) + (size_t)e * 2048 * 512, 512, kt * 64, ntile * 256, nullptr, P.Wt_egu + (size_t)e * 1024 * 2048, 2048, 0, 1, up ? 128 : 0, lt); }
            else { const int q = r - 128, kt = q & 7, ntile = q >> 3;
                cvt_tile(P.w_ed + (size_t)e * 512 * 2048, 2048, kt * 64, ntile * 256, nullptr, P.Wt_ed + (size_t)e * 2048 * 512, 512, 0, 0, 0, lt); } }
    }
}

#define KSWZ(row, colB) ((row) * 256 + ((colB) ^ (((row) & 7) << 4)))
#define SBAR() __builtin_amdgcn_sched_barrier(0)
__device__ __forceinline__ int crow(int r, int hi) { return (r & 3) + 8 * (r >> 2) + 4 * hi; }
__device__ __forceinline__ void qkt(f32x16& p0, f32x16& p1, const LAS unsigned char* Ks, const bf16x8* qr, int r32, int hi) {
    p0 = f32x16{}; p1 = f32x16{};
#pragma unroll
    for (int d0 = 0; d0 < 8; ++d0) { const int cb = (d0 * 16 + hi * 8) * 2;
        const bf16x8 b0 = *(const LAS bf16x8*)(Ks + KSWZ(r32, cb));
        const bf16x8 b1 = *(const LAS bf16x8*)(Ks + KSWZ(32 + r32, cb));
        p0 = __builtin_amdgcn_mfma_f32_32x32x16_bf16(b0, qr[d0], p0, 0, 0, 0);
        p1 = __builtin_amdgcn_mfma_f32_32x32x16_bf16(b1, qr[d0], p1, 0, 0, 0); }
}
__device__ __forceinline__ int v_st(int k, int c) { const int kk = (k & ~0xC) | ((k & 4) << 1) | ((k & 8) >> 1); return ((kk >> 3) * 4 + (c >> 5)) * 512 + ((kk & 7) * 32 + (c & 31)) * 2; }
__device__ __forceinline__ int v_rd_base(int lane) { return ((lane & 3) << 3) | (((lane >> 2) & 3) << 6) | (((lane >> 4) & 1) << 5) | (((lane >> 5) & 1) << 8); }
constexpr int v_rd_off(int d0, int ks, int half) { return d0 * 512 + ks * 4096 + half * 2048; }
template <int D0> __device__ __forceinline__ void pv_one(f32x16& od, int vb, bf16x8 pa0, bf16x8 pa1, bf16x8 pa2, bf16x8 pa3) {
    s16x4 l0, h0, l1, h1, l2, h2, l3, h3;
    asm volatile("ds_read_b64_tr_b16 %0, %8 offset:%9\n\t"
                 "ds_read_b64_tr_b16 %1, %8 offset:%10\n\t"
                 "ds_read_b64_tr_b16 %2, %8 offset:%11\n\t"
                 "ds_read_b64_tr_b16 %3, %8 offset:%12\n\t"
                 "ds_read_b64_tr_b16 %4, %8 offset:%13\n\t"
                 "ds_read_b64_tr_b16 %5, %8 offset:%14\n\t"
                 "ds_read_b64_tr_b16 %6, %8 offset:%15\n\t"
                 "ds_read_b64_tr_b16 %7, %8 offset:%16\n\t"
                 "s_waitcnt lgkmcnt(0)"
                 : "=&v"(l0), "=&v"(h0), "=&v"(l1), "=&v"(h1), "=&v"(l2), "=&v"(h2), "=&v"(l3), "=&v"(h3)
                 : "v"(vb), "i"(v_rd_off(D0, 0, 0)), "i"(v_rd_off(D0, 0, 1)), "i"(v_rd_off(D0, 1, 0)), "i"(v_rd_off(D0, 1, 1)),
                   "i"(v_rd_off(D0, 2, 0)), "i"(v_rd_off(D0, 2, 1)), "i"(v_rd_off(D0, 3, 0)), "i"(v_rd_off(D0, 3, 1))
                 : "memory");
    SBAR();
#define PK(L, H) (bf16x8){L[0], L[1], L[2], L[3], H[0], H[1], H[2], H[3]}
    od = __builtin_amdgcn_mfma_f32_32x32x16_bf16(pa0, PK(l0, h0), od, 0, 0, 0);
    od = __builtin_amdgcn_mfma_f32_32x32x16_bf16(pa1, PK(l1, h1), od, 0, 0, 0);
    od = __builtin_amdgcn_mfma_f32_32x32x16_bf16(pa2, PK(l2, h2), od, 0, 0, 0);
    od = __builtin_amdgcn_mfma_f32_32x32x16_bf16(pa3, PK(l3, h3), od, 0, 0, 0);
#undef PK
}
__device__ __forceinline__ float softplus_(float z) { return fmaxf(z, 0.f) + __logf(1.0f + __expf(-fabsf(z))); }

__device__ void attn_unit(const Params& P, int unit, LAS unsigned char* lds) {
    const int qb = unit & 7, h = (unit >> 3) & 7, b = unit >> 6;
    const int tid = threadIdx.x, wid = tid >> 6, lane = tid & 63, r32 = lane & 31, hi = lane >> 5;
    const int q0 = qb * 256; const size_t tokbase = (size_t)b * SEQ;
    LAS unsigned char* K_lds = lds; LAS unsigned char* V_lds = lds + 16384; volatile LAS int* flags = (volatile LAS int*)(lds + LDS_FLAGS);
    const int tq = q0 + wid * 32 + r32;
    bf16x8 qr[8];
    {
        const bf16_t* qp = P.zq + (tokbase + tq) * 3072 + h * HD + hi * 8;
        u32x4 raw[8]; float ss = 0.f;
#pragma unroll
        for (int d0 = 0; d0 < 8; ++d0) { raw[d0] = *(const u32x4*)(qp + d0 * 16);
            const float a0 = bf_lo(raw[d0].x), a1 = bf_hi(raw[d0].x), a2 = bf_lo(raw[d0].y), a3 = bf_hi(raw[d0].y), a4 = bf_lo(raw[d0].z), a5 = bf_hi(raw[d0].z), a6 = bf_lo(raw[d0].w), a7 = bf_hi(raw[d0].w);
            ss += a0 * a0 + a1 * a1 + a2 * a2 + a3 * a3 + a4 * a4 + a5 * a5 + a6 * a6 + a7 * a7; }
        ss += __shfl_xor(ss, 32);
        const float rq = rsqrtf(ss * (1.0f / HD) + EPS) * 0.088388347648318440f;
#pragma unroll
        for (int d0 = 0; d0 < 8; ++d0) { const float* gq = P.q_norm + d0 * 16 + hi * 8; const f32x4 g0 = *(const f32x4*)gq, g1 = *(const f32x4*)(gq + 4);
            u32x4 w;
            w.x = cvt_pk_bf16(bf_lo(raw[d0].x) * rq * g0[0], bf_hi(raw[d0].x) * rq * g0[1]); w.y = cvt_pk_bf16(bf_lo(raw[d0].y) * rq * g0[2], bf_hi(raw[d0].y) * rq * g0[3]);
            w.z = cvt_pk_bf16(bf_lo(raw[d0].z) * rq * g1[0], bf_hi(raw[d0].z) * rq * g1[1]); w.w = cvt_pk_bf16(bf_lo(raw[d0].w) * rq * g1[2], bf_hi(raw[d0].w) * rq * g1[3]);
            qr[d0] = *(bf16x8*)&w; }
    }
    const int sr = tid >> 4, sc = (tid & 15) * 8, vst0 = v_st(sr, sc), vst1 = v_st(32 + sr, sc);
    const int vb0 = (int)(unsigned)(uintptr_t)V_lds + v_rd_base(lane);
    const f32x4 gk0 = *(const f32x4*)(P.k_norm + sc), gk1 = *(const f32x4*)(P.k_norm + sc + 4);
    f32x16 o[4]; o[0] = f32x16{}; o[1] = f32x16{}; o[2] = f32x16{}; o[3] = f32x16{};
    float Rc = 0.f; bool done = false;
    const int tw_max = q0 + wid * 32 + 31;
    if (tid < 8) flags[tid] = 0;
    for (int kt = (q0 >> 6) + 3; kt >= 0; --kt) {
        {
            const bf16_t* kp0 = P.zq + (tokbase + kt * 64 + sr) * 3072 + 1024 + h * HD + sc; const bf16_t* kp1 = kp0 + (size_t)32 * 3072;
            const u32x4 k0 = *(const u32x4*)kp0, k1 = *(const u32x4*)kp1, v0 = *(const u32x4*)(kp0 + 1024), v1 = *(const u32x4*)(kp1 + 1024);
            float s0 = bf_lo(k0.x) * bf_lo(k0.x) + bf_hi(k0.x) * bf_hi(k0.x) + bf_lo(k0.y) * bf_lo(k0.y) + bf_hi(k0.y) * bf_hi(k0.y) + bf_lo(k0.z) * bf_lo(k0.z) + bf_hi(k0.z) * bf_hi(k0.z) + bf_lo(k0.w) * bf_lo(k0.w) + bf_hi(k0.w) * bf_hi(k0.w);
            float s1 = bf_lo(k1.x) * bf_lo(k1.x) + bf_hi(k1.x) * bf_hi(k1.x) + bf_lo(k1.y) * bf_lo(k1.y) + bf_hi(k1.y) * bf_hi(k1.y) + bf_lo(k1.z) * bf_lo(k1.z) + bf_hi(k1.z) * bf_hi(k1.z) + bf_lo(k1.w) * bf_lo(k1.w) + bf_hi(k1.w) * bf_hi(k1.w);
#pragma unroll
            for (int o_ = 8; o_ >= 1; o_ >>= 1) { s0 += __shfl_xor(s0, o_); s1 += __shfl_xor(s1, o_); }
            const float r0 = rsqrtf(s0 * (1.0f / HD) + EPS), r1 = rsqrtf(s1 * (1.0f / HD) + EPS);
            u32x4 w0, w1;
            w0.x = cvt_pk_bf16(bf_lo(k0.x) * r0 * gk0[0], bf_hi(k0.x) * r0 * gk0[1]); w0.y = cvt_pk_bf16(bf_lo(k0.y) * r0 * gk0[2], bf_hi(k0.y) * r0 * gk0[3]);
            w0.z = cvt_pk_bf16(bf_lo(k0.z) * r0 * gk1[0], bf_hi(k0.z) * r0 * gk1[1]); w0.w = cvt_pk_bf16(bf_lo(k0.w) * r0 * gk1[2], bf_hi(k0.w) * r0 * gk1[3]);
            w1.x = cvt_pk_bf16(bf_lo(k1.x) * r1 * gk0[0], bf_hi(k1.x) * r1 * gk0[1]); w1.y = cvt_pk_bf16(bf_lo(k1.y) * r1 * gk0[2], bf_hi(k1.y) * r1 * gk0[3]);
            w1.z = cvt_pk_bf16(bf_lo(k1.z) * r1 * gk1[0], bf_hi(k1.z) * r1 * gk1[1]); w1.w = cvt_pk_bf16(bf_lo(k1.w) * r1 * gk1[2], bf_hi(k1.w) * r1 * gk1[3]);
            *(LAS u32x4*)(K_lds + KSWZ(sr, sc * 2)) = w0; *(LAS u32x4*)(K_lds + KSWZ(32 + sr, sc * 2)) = w1;
            *(LAS u32x4*)(V_lds + vst0) = v0; *(LAS u32x4*)(V_lds + vst1) = v1;
        }
        __syncthreads();
        if (!done && kt * 64 < tw_max) {
            f32x16 p0, p1; qkt(p0, p1, K_lds, qr, r32, hi);
            const int kb = kt * 64;
            float gs[8], pg[8], lz[32];
#pragma unroll
            for (int hf = 0; hf < 2; ++hf)
#pragma unroll
                for (int g = 0; g < 4; ++g) { float s = 0.f;
#pragma unroll
                    for (int i = 0; i < 4; ++i) { const int r = 4 * g + i; const float z = hf ? p1[r] : p0[r]; const bool causal = (kb + 32 * hf + crow(r, hi)) < tq;
                        const float spv = softplus_(z); lz[hf * 16 + r] = causal ? (z - spv) : -1e30f; const float spm = causal ? spv : 0.f;
                        if (hf) p1[r] = spm; else p0[r] = spm; s += spm; }
                    gs[hf * 4 + g] = s; }
#pragma unroll
            for (int i = 0; i < 8; ++i) pg[i] = __shfl_xor(gs[i], 32);
            float suf = 0.f;
            float aft[8];
#pragma unroll
            for (int i = 7; i >= 0; --i) { aft[i] = Rc + suf + (hi == 0 ? pg[i] : 0.f); suf += gs[i] + pg[i]; }
            Rc += suf;
#pragma unroll
            for (int hf = 0; hf < 2; ++hf)
#pragma unroll
                for (int g = 0; g < 4; ++g) { float a = aft[hf * 4 + g];
#pragma unroll
                    for (int i = 3; i >= 0; --i) { const int r = 4 * g + i; const float spm = hf ? p1[r] : p0[r]; const float wv = __expf(lz[hf * 16 + r] - a); a += spm;
                        if (hf) p1[r] = wv; else p0[r] = wv; } }
            bf16x8 pa0, pa1, pa2, pa3;
#define PK4(Pv, BASE, OUT) do { unsigned a0 = cvt_pk_bf16(Pv[BASE + 0], Pv[BASE + 1]), a1 = cvt_pk_bf16(Pv[BASE + 2], Pv[BASE + 3]);   \
    unsigned b0 = cvt_pk_bf16(Pv[BASE + 4], Pv[BASE + 5]), b1 = cvt_pk_bf16(Pv[BASE + 6], Pv[BASE + 7]);                              \
    auto r0 = __builtin_amdgcn_permlane32_swap(a0, b0, false, false); auto r1 = __builtin_amdgcn_permlane32_swap(a1, b1, false, false); \
    u32x4 w = {r0[0], r1[0], r0[1], r1[1]}; OUT = *reinterpret_cast<bf16x8*>(&w); } while (0)
            PK4(p0, 0, pa0); PK4(p0, 8, pa1); PK4(p1, 0, pa2); PK4(p1, 8, pa3);
#undef PK4
            SBAR();
            pv_one<0>(o[0], vb0, pa0, pa1, pa2, pa3); pv_one<1>(o[1], vb0, pa0, pa1, pa2, pa3); pv_one<2>(o[2], vb0, pa0, pa1, pa2, pa3); pv_one<3>(o[3], vb0, pa0, pa1, pa2, pa3);
            done = __all(Rc > 110.0f);
            if (done && lane == 0) flags[wid] = 1;
        }
        __syncthreads();
        int nd = 0;
#pragma unroll
        for (int w = 0; w < 8; ++w) nd += flags[w];
        if (nd == 8) break;
    }
    bf16_t* ob = P.mix + (tokbase + q0 + wid * 32) * 2048 + h * HD;
#pragma unroll
    for (int r = 0; r < 16; ++r) { const int orow = crow(r, hi);
#pragma unroll
        for (int d0 = 0; d0 < 4; ++d0) ob[(size_t)orow * 2048 + d0 * 32 + r32] = (bf16_t)(cvt_pk_bf16(o[d0][r], 0.f) & 0xffffu); }
    __syncthreads();
}

__device__ __forceinline__ float xhalf(float x, int hi) { const auto r = __builtin_amdgcn_permlane32_swap(__float_as_uint(x), __float_as_uint(x), false, false); return __uint_as_float(hi ? r[0] : r[1]); }
__device__ __forceinline__ float2 cmul(float2 a, float2 b) { return make_float2(a.x * b.x - a.y * b.y, a.x * b.y + a.y * b.x); }
__device__ __forceinline__ float2 cfma(float2 a, float2 x, float2 c) { return make_float2(a.x * x.x - a.y * x.y + c.x, a.x * x.y + a.y * x.x + c.y); }
template <bool OUT>
__device__ __forceinline__ void ssm_item(const Params& P, int item, LAS unsigned char* lds) {
    const int tid = threadIdx.x, wid = tid >> 6, lane = tid & 63, r32 = lane & 31, hi = lane >> 5, hh = lane & 15, kq = lane >> 4;
    const int g = item % NG, sc = (item / NG) % NSC, b = item / (NSC * NG);
    LAS unsigned* xs = (LAS unsigned*)(lds + wid * 8192);
    float2 a1[2], a2[2], a3[2], a4[2], cst[2]; bf16x8 bre[2], bim[2];
#pragma unroll
    for (int pb = 0; pb < 2; ++pb) { const int gp = g * NP + pb * 32 + r32;
        a1[pb] = P.abar[gp]; a2[pb] = cmul(a1[pb], a1[pb]); a3[pb] = cmul(a2[pb], a1[pb]); a4[pb] = cmul(a2[pb], a2[pb]);
        const float* bp = (const float*)(P.bbar + (size_t)gp * GH + 8 * hi); const f32x4 v0 = *(const f32x4*)bp, v1 = *(const f32x4*)(bp + 4), v2 = *(const f32x4*)(bp + 8), v3 = *(const f32x4*)(bp + 12);
        u32x4 wr_, wi_; wr_.x = cvt_pk_bf16(v0[0], v0[2]); wr_.y = cvt_pk_bf16(v1[0], v1[2]); wr_.z = cvt_pk_bf16(v2[0], v2[2]); wr_.w = cvt_pk_bf16(v3[0], v3[2]);
        wi_.x = cvt_pk_bf16(v0[1], v0[3]); wi_.y = cvt_pk_bf16(v1[1], v1[3]); wi_.z = cvt_pk_bf16(v2[1], v2[3]); wi_.w = cvt_pk_bf16(v3[1], v3[3]);
        bre[pb] = *(bf16x8*)&wr_; bim[pb] = *(bf16x8*)&wi_;
        cst[pb] = make_float2(0.f, 0.f);
        if (OUT) { const float2 aL = P.aL[gp]; const float2* ep = P.Est + ((size_t)(b * NG + g) * NSC) * NP + pb * 32 + r32; float2 e[NSC - 1];
#pragma unroll
            for (int cc = 0; cc < NSC - 1; ++cc) e[cc] = ep[(size_t)cc * NP];
#pragma unroll
            for (int cc = 0; cc < NSC - 1; ++cc) if (cc < sc) cst[pb] = cfma(aL, cst[pb], e[cc]); } }
    bf16x8 cf[4], dfr; float dsk = 0.f;
    if (OUT) {
#pragma unroll
        for (int s_ = 0; s_ < 4; ++s_) { const size_t ci = ((size_t)g * GH + hh) * NP + 16 * s_ + 4 * kq; const f32x4 cr = *(const f32x4*)(P.c_re + ci), cim = *(const f32x4*)(P.c_im + ci);
            u32x4 w; w.x = cvt_pk_bf16(cr[0], -cim[0]); w.y = cvt_pk_bf16(cr[1], -cim[1]); w.z = cvt_pk_bf16(cr[2], -cim[2]); w.w = cvt_pk_bf16(cr[3], -cim[3]); cf[s_] = *(bf16x8*)&w; }
        dsk = P.ssm_d[g * GH + hh];
        float dv[8];
#pragma unroll
        for (int j = 0; j < 8; ++j) dv[j] = (8 * kq + j == hh) ? dsk : 0.f;
        u32x4 w; w.x = cvt_pk_bf16(dv[0], dv[1]); w.y = cvt_pk_bf16(dv[2], dv[3]); w.z = cvt_pk_bf16(dv[4], dv[5]); w.w = cvt_pk_bf16(dv[6], dv[7]); dfr = *(bf16x8*)&w;
    }
    const float* ubase = P.u + ((size_t)b * SEQ + sc * SCH) * 1024 + g * GH;
    f32x4 un0 = *(const f32x4*)(ubase + (size_t)r32 * 1024 + 8 * hi), un1 = *(const f32x4*)(ubase + (size_t)r32 * 1024 + 8 * hi + 4);
    for (int blk = 0; blk < SCH / 32; ++blk) {
        u32x4 aw; aw.x = cvt_pk_bf16(un0[0], un0[1]); aw.y = cvt_pk_bf16(un0[2], un0[3]); aw.z = cvt_pk_bf16(un1[0], un1[1]); aw.w = cvt_pk_bf16(un1[2], un1[3]);
        const bf16x8 Au = *(bf16x8*)&aw;
        if (blk + 1 < SCH / 32) { const float* up = ubase + (size_t)((blk + 1) * 32 + r32) * 1024 + 8 * hi; un0 = *(const f32x4*)up; un1 = *(const f32x4*)(up + 4); }
#pragma unroll
        for (int pb = 0; pb < 2; ++pb) {
            f32x16 dre = __builtin_amdgcn_mfma_f32_32x32x16_bf16(Au, bre[pb], f32x16{}, 0, 0, 0);
            f32x16 dim = __builtin_amdgcn_mfma_f32_32x32x16_bf16(Au, bim[pb], f32x16{}, 0, 0, 0);
#pragma unroll
            for (int q = 0; q < 4; ++q)
#pragma unroll
                for (int i = 1; i < 4; ++i) { const float2 x = cfma(a1[pb], make_float2(dre[4 * q + i - 1], dim[4 * q + i - 1]), make_float2(dre[4 * q + i], dim[4 * q + i])); dre[4 * q + i] = x.x; dim[4 * q + i] = x.y; }
            float2 cin[4]; float2 cc = cst[pb];
#pragma unroll
            for (int q = 0; q < 4; ++q) { const float2 le = make_float2(dre[4 * q + 3], dim[4 * q + 3]);
                const float2 e0 = cfma(a4[pb], cc, le);
                const float2 pe0 = make_float2(xhalf(e0.x, hi), xhalf(e0.y, hi));
                const float2 e1 = cfma(a4[pb], pe0, le);
                const float2 pe1 = make_float2(xhalf(e1.x, hi), xhalf(e1.y, hi));
                cin[q] = hi ? pe0 : cc; cc = hi ? e1 : pe1; }
            cst[pb] = cc;
            if (OUT) {
#pragma unroll
                for (int q = 0; q < 4; ++q) { const float2 f1 = cmul(a1[pb], cin[q]), f2 = cmul(a2[pb], cin[q]), f3 = cmul(a3[pb], cin[q]), f4 = cmul(a4[pb], cin[q]);
                    const float2 x0 = make_float2(dre[4 * q + 0] + f1.x, dim[4 * q + 0] + f1.y), x1 = make_float2(dre[4 * q + 1] + f2.x, dim[4 * q + 1] + f2.y);
                    const float2 x2 = make_float2(dre[4 * q + 2] + f3.x, dim[4 * q + 2] + f3.y), x3 = make_float2(dre[4 * q + 3] + f4.x, dim[4 * q + 3] + f4.y);
                    LAS unsigned* xp = xs + (8 * q + 4 * hi) * 64 + pb * 32 + r32;
                    xp[0] = cvt_pk_bf16(x0.x, x0.y); xp[64] = cvt_pk_bf16(x1.x, x1.y); xp[128] = cvt_pk_bf16(x2.x, x2.y); xp[192] = cvt_pk_bf16(x3.x, x3.y); }
            }
        }
        if (OUT) {
            asm volatile("s_waitcnt lgkmcnt(0)" ::: "memory");
#pragma unroll
            for (int th = 0; th < 2; ++th) {
                f32x4 yacc = (f32x4){0.f, 0.f, 0.f, 0.f};
#pragma unroll
                for (int s_ = 0; s_ < 4; ++s_) { const bf16x8 af = *(const LAS bf16x8*)((const LAS unsigned char*)xs + (th * 16 + hh) * 256 + s_ * 64 + kq * 16);
                    yacc = __builtin_amdgcn_mfma_f32_16x16x32_bf16(af, cf[s_], yacc, 0, 0, 0); }
                u32x4 uw;
                { const float* up = ubase + (size_t)(blk * 32 + th * 16 + hh) * 1024 + 8 * (kq & 1); const f32x4 y0 = *(const f32x4*)up, y1 = *(const f32x4*)(up + 4);
                    uw.x = cvt_pk_bf16(y0[0], y0[1]); uw.y = cvt_pk_bf16(y0[2], y0[3]); uw.z = cvt_pk_bf16(y1[0], y1[1]); uw.w = cvt_pk_bf16(y1[2], y1[3]); }
                yacc = __builtin_amdgcn_mfma_f32_16x16x32_bf16(*(bf16x8*)&uw, dfr, yacc, 0, 0, 0);
#pragma unroll
                for (int j = 0; j < 4; ++j) { const int t = blk * 32 + th * 16 + 4 * kq + j; const float yv = gelu_tanh(yacc[j]);
                    P.ybuf[((size_t)b * SEQ + sc * SCH + t) * 1024 + g * GH + hh] = (bf16_t)(cvt_pk_bf16(yv, 0.f) & 0xffffu); }
            }
            asm volatile("s_waitcnt lgkmcnt(0)" ::: "memory");
        }
    }
    if (!OUT) { if (hi == 0) {
#pragma unroll
        for (int pb = 0; pb < 2; ++pb) P.Est[((size_t)(b * NG + g) * NSC + sc) * NP + pb * 32 + r32] = cst[pb]; } }
}

__device__ void phase_mixnorm(const Params& P) {
    const int tid = threadIdx.x, wid = tid >> 6, lane = tid & 63, G = gridDim.x;
    for (int row = blockIdx.x * 8 + wid; row < T_; row += G * 8) {
        const bf16_t* mp = P.mix + (size_t)row * 2048; u32x4 v[4]; float ssa = 0.f, ssb = 0.f;
#pragma unroll
        for (int i = 0; i < 4; ++i) { v[i] = *(const u32x4*)(mp + lane * 8 + 512 * i);
            const float s = bf_lo(v[i].x) * bf_lo(v[i].x) + bf_hi(v[i].x) * bf_hi(v[i].x) + bf_lo(v[i].y) * bf_lo(v[i].y) + bf_hi(v[i].y) * bf_hi(v[i].y) + bf_lo(v[i].z) * bf_lo(v[i].z) + bf_hi(v[i].z) * bf_hi(v[i].z) + bf_lo(v[i].w) * bf_lo(v[i].w) + bf_hi(v[i].w) * bf_hi(v[i].w);
            if (i < 2) ssa += s; else ssb += s; }
        ssa = wave_sum(ssa); ssb = wave_sum(ssb);
        const float ra = rsqrtf(ssa * (1.0f / 1024) + EPS), rb = rsqrtf(ssb * (1.0f / 1024) + EPS);
#pragma unroll
        for (int i = 0; i < 4; ++i) { const float r = i < 2 ? ra : rb; u32x4 w;
            w.x = cvt_pk_bf16(bf_lo(v[i].x) * r, bf_hi(v[i].x) * r); w.y = cvt_pk_bf16(bf_lo(v[i].y) * r, bf_hi(v[i].y) * r);
            w.z = cvt_pk_bf16(bf_lo(v[i].z) * r, bf_hi(v[i].z) * r); w.w = cvt_pk_bf16(bf_lo(v[i].w) * r, bf_hi(v[i].w) * r);
            *(u32x4*)(P.R1 + (size_t)row * 2048 + lane * 8 + 512 * i) = w; }
    }
}

__device__ void phase_router(const Params& P, LAS unsigned char* lds) {
    const int tid = threadIdx.x, wid = tid >> 6, lane = tid & 63, r32 = lane & 31, kh = lane >> 5, G = gridDim.x;
    LAS float* part = (LAS float*)lds;
    LAS float* ssq = (LAS float*)(lds + 65536);
    LAS float* rinv = (LAS float*)(lds + 65536 + 1024);
    LAS int* lsel = (LAS int*)(lds + 65536 + 2048); LAS int* lrank = lsel + 32 * TOPK;
    for (int unit = blockIdx.x; unit < T_ / 32; unit += G) {
        const int tok0 = unit * 32;
        f32x16 acc0 = f32x16{}, acc1 = f32x16{}; float ss = 0.f;
        const float* ap = P.h1 + (size_t)(tok0 + r32) * DM + 256 * wid + 8 * kh;
        const bf16_t* bh = P.Wr_hi + (size_t)r32 * DM + 256 * wid + 8 * kh; const bf16_t* bl = P.Wr_lo + (size_t)r32 * DM + 256 * wid + 8 * kh;
#pragma unroll 4
        for (int s_ = 0; s_ < 16; ++s_) {
            const f32x4 x0 = *(const f32x4*)(ap + 16 * s_), x1 = *(const f32x4*)(ap + 16 * s_ + 4);
            ss += x0[0] * x0[0] + x0[1] * x0[1] + x0[2] * x0[2] + x0[3] * x0[3] + x1[0] * x1[0] + x1[1] * x1[1] + x1[2] * x1[2] + x1[3] * x1[3];
            u32x4 hw, lw;
            hw.x = cvt_pk_bf16(x0[0], x0[1]); hw.y = cvt_pk_bf16(x0[2], x0[3]); hw.z = cvt_pk_bf16(x1[0], x1[1]); hw.w = cvt_pk_bf16(x1[2], x1[3]);
            lw.x = cvt_pk_bf16(x0[0] - bf_lo(hw.x), x0[1] - bf_hi(hw.x)); lw.y = cvt_pk_bf16(x0[2] - bf_lo(hw.y), x0[3] - bf_hi(hw.y));
            lw.z = cvt_pk_bf16(x1[0] - bf_lo(hw.z), x1[1] - bf_hi(hw.z)); lw.w = cvt_pk_bf16(x1[2] - bf_lo(hw.w), x1[3] - bf_hi(hw.w));
            const bf16x8 Ah = *(bf16x8*)&hw, Al = *(bf16x8*)&lw;
            const bf16x8 Bh0 = *(const bf16x8*)(bh + 16 * s_), Bh1 = *(const bf16x8*)(bh + (size_t)32 * DM + 16 * s_);
            const bf16x8 Bl0 = *(const bf16x8*)(bl + 16 * s_), Bl1 = *(const bf16x8*)(bl + (size_t)32 * DM + 16 * s_);
            acc0 = __builtin_amdgcn_mfma_f32_32x32x16_bf16(Ah, Bh0, acc0, 0, 0, 0); acc1 = __builtin_amdgcn_mfma_f32_32x32x16_bf16(Ah, Bh1, acc1, 0, 0, 0);
            acc0 = __builtin_amdgcn_mfma_f32_32x32x16_bf16(Ah, Bl0, acc0, 0, 0, 0); acc1 = __builtin_amdgcn_mfma_f32_32x32x16_bf16(Ah, Bl1, acc1, 0, 0, 0);
            acc0 = __builtin_amdgcn_mfma_f32_32x32x16_bf16(Al, Bh0, acc0, 0, 0, 0); acc1 = __builtin_amdgcn_mfma_f32_32x32x16_bf16(Al, Bh1, acc1, 0, 0, 0);
        }
#pragma unroll
        for (int r = 0; r < 16; ++r) { const int tl = crow(r, kh); part[(wid * 32 + tl) * 64 + r32] = acc0[r]; part[(wid * 32 + tl) * 64 + 32 + r32] = acc1[r]; }
        ss += __shfl_xor(ss, 32); if (kh == 0) ssq[wid * 32 + r32] = ss;
        __syncthreads();
        if (tid < 32) { float sq = 0.f;
#pragma unroll
            for (int w = 0; w < 8; ++w) sq += ssq[w * 32 + tid];
            rinv[tid] = rsqrtf(sq * (1.0f / DM) + EPS); }
        __syncthreads();
        int selE[4]; float selG[4];
#pragma unroll
        for (int tt = 0; tt < 4; ++tt) { const int tl = 4 * wid + tt; float lg = 0.f;
#pragma unroll
            for (int w = 0; w < 8; ++w) lg += part[(w * 32 + tl) * 64 + lane];
            lg *= rinv[tl];
            const float score = 1.0f / (1.0f + expf(-lg)); float selv = score + P.router_bias[lane];
            int myE = 0; float myG = 0.f, gsum = 0.f;
#pragma unroll
            for (int j = 0; j < TOPK; ++j) { const float mx = wave_max(selv); const unsigned long long bal = __ballot(selv == mx); const int first = __builtin_amdgcn_readfirstlane((int)__builtin_ctzll(bal));
                const float gsel = __shfl(score, first); gsum += gsel; if (lane == j) { myE = first; myG = gsel; } if (lane == first) selv = -3.0e38f; }
            selE[tt] = myE; selG[tt] = myG / gsum * 2.5f;
            if (lane < TOPK) lsel[tl * TOPK + lane] = myE; }
        __syncthreads();
        if (wid == 0) { int cn = 0;
            for (int i = 0; i < 32 * TOPK; ++i) { const int se = lsel[i]; if (se == lane) { lrank[i] = cn; ++cn; } }
            P.cntw[unit * NE + lane] = cn; }
        __syncthreads();
        if (lane < TOPK) {
#pragma unroll
            for (int tt = 0; tt < 4; ++tt) { const int tl = 4 * wid + tt, tok = tok0 + tl;
                P.sel_e[tok * TOPK + lane] = selE[tt]; P.sel_pos[tok * TOPK + lane] = lrank[tl * TOPK + lane]; P.sel_gate[tok * TOPK + lane] = selG[tt]; } }
#pragma unroll
        for (int tt = 0; tt < 4; ++tt) { const int tl = 4 * wid + tt; const float r = rinv[tl]; const float* hp = P.h1 + (size_t)(tok0 + tl) * DM;
#pragma unroll
            for (int i = 0; i < 8; ++i) { const f32x4 v = *(const f32x4*)(hp + 4 * lane + 256 * i); const f32x4 gn = *(const f32x4*)(P.norm_ffn + 4 * lane + 256 * i); const f32x4 mv = v * r * gn;
                u32x2 w; w.x = cvt_pk_bf16(mv[0], mv[1]); w.y = cvt_pk_bf16(mv[2], mv[3]); *(u32x2*)(P.R1 + (size_t)(tok0 + tl) * DM + 4 * lane + 256 * i) = w; } }
        __syncthreads();
    }
}

constexpr int NU = T_ / 32;
__device__ __forceinline__ void moe_sum_units(const Params& P, LAS int* tmp, LAS int* out, int ulim) {
    const int e = threadIdx.x & 63, part = threadIdx.x >> 6; int sacc = 0;
#pragma unroll 8
    for (int i = 0; i < NU / 8; ++i) { const int v = part * (NU / 8) + i; const int cv = P.cntw[v * NE + e]; sacc += (v < ulim) ? cv : 0; }
    tmp[part * 64 + e] = sacc;
    __syncthreads();
    if (threadIdx.x < NE) { int tot = 0;
#pragma unroll
        for (int p = 0; p < 8; ++p) tot += tmp[p * 64 + threadIdx.x];
        out[threadIdx.x] = tot; }
    __syncthreads();
}
__device__ __forceinline__ void moe_sum_serial(const Params& P, LAS int* out, int ulim) {
    if (threadIdx.x < NE) { int sacc = 0;
        for (int v = 0; v < ulim; ++v) sacc += P.cntw[v * NE + threadIdx.x];
        out[threadIdx.x] = sacc; }
    __syncthreads();
}
__device__ int build_moe_tables(const Params& P, LAS unsigned char* lds) {
    LAS int* rt_e = (LAS int*)(lds + LDS_TAB); LAS int* rt_j = rt_e + 256; volatile LAS int* nrt = (volatile LAS int*)(rt_e + 512); LAS int* rt_n = rt_e + 640; LAS int* cnt_l = rt_e + 900;
    __syncthreads();
    moe_sum_serial(P, cnt_l, NU);
    if (threadIdx.x == 0) { int rt = 0;
        for (int e = 0; e < NE; ++e) { const int n = cnt_l[e]; const int ntile = (n + 255) >> 8; for (int j = 0; j < ntile && rt < 256; ++j) { rt_e[rt] = e; rt_j[rt] = j; rt_n[rt] = (n - j * 256) < 256 ? (n - j * 256) : 256; ++rt; } }
        *nrt = rt; }
    __syncthreads();
    return *nrt;
}
__device__ void moe_scatter(const Params& P, LAS unsigned char* lds) {
    LAS int* bs = (LAS int*)(lds + LDS_TAB + 2100);
    const int tid = threadIdx.x, G = gridDim.x;
    for (int u = blockIdx.x; u < NU; u += G) {
        __syncthreads();
        moe_sum_units(P, (LAS int*)lds, bs, u);
        if (tid < NE) P.basew[u * NE + tid] = bs[tid];
        if (tid < 32 * TOPK) { const int tok = u * 32 + tid / TOPK, k = tid % TOPK; const int e = P.sel_e[tok * TOPK + k], loc = P.sel_pos[tok * TOPK + k];
            __hip_atomic_store(&P.tok_of_row[(size_t)e * CAP + bs[e] + loc], tok, __ATOMIC_RELAXED, __HIP_MEMORY_SCOPE_AGENT); }
    }
}

__device__ void phase_combine(const Params& P, LAS unsigned char* lds) {
    const int tid = threadIdx.x, wid = tid >> 6, lane = tid & 63, G = gridDim.x;
    LAS int* rt0 = (LAS int*)(lds + LDS_TAB);
    LAS int* cnt_l = rt0 + 64;
    __syncthreads();
    moe_sum_serial(P, cnt_l, NU);
    if (tid == 0) { int rt = 0; for (int e = 0; e < NE; ++e) { rt0[e] = rt; rt += (cnt_l[e] + 255) >> 8; } }
    __syncthreads();
    for (int row = blockIdx.x * 8 + wid; row < T_; row += G * 8) {
        int crw = 0; float gte = 0.f;
        if (lane < TOPK) { const int e = P.sel_e[row * TOPK + lane]; crw = rt0[e] * 256 + P.basew[(row >> 5) * NE + e] + P.sel_pos[row * TOPK + lane]; gte = P.sel_gate[row * TOPK + lane]; }
        float hv[4][8]; float ss = 0.f;
#pragma unroll
        for (int i = 0; i < 4; ++i) { const size_t o = (size_t)row * DM + lane * 8 + 512 * i; const f32x4 a = *(const f32x4*)(P.h1 + o), b2 = *(const f32x4*)(P.h1 + o + 4);
            hv[i][0] = a[0]; hv[i][1] = a[1]; hv[i][2] = a[2]; hv[i][3] = a[3]; hv[i][4] = b2[0]; hv[i][5] = b2[1]; hv[i][6] = b2[2]; hv[i][7] = b2[3];
            const u32x4 sv = *(const u32x4*)(P.Ysh + o);
            hv[i][0] += bf_lo(sv.x); hv[i][1] += bf_hi(sv.x); hv[i][2] += bf_lo(sv.y); hv[i][3] += bf_hi(sv.y); hv[i][4] += bf_lo(sv.z); hv[i][5] += bf_hi(sv.z); hv[i][6] += bf_lo(sv.w); hv[i][7] += bf_hi(sv.w); }
#pragma unroll
        for (int k = 0; k < TOPK; ++k) { const int cr = __builtin_amdgcn_readlane(crw, k); const float gt = __uint_as_float((unsigned)__builtin_amdgcn_readlane((int)__float_as_uint(gte), k)); const bf16_t* yp = P.Y + (size_t)cr * DM + lane * 8;
#pragma unroll
            for (int i = 0; i < 4; ++i) { const u32x4 y = *(const u32x4*)(yp + 512 * i);
                hv[i][0] += gt * bf_lo(y.x); hv[i][1] += gt * bf_hi(y.x); hv[i][2] += gt * bf_lo(y.y); hv[i][3] += gt * bf_hi(y.y); hv[i][4] += gt * bf_lo(y.z); hv[i][5] += gt * bf_hi(y.z); hv[i][6] += gt * bf_lo(y.w); hv[i][7] += gt * bf_hi(y.w); } }
#pragma unroll
        for (int i = 0; i < 4; ++i)
#pragma unroll
            for (int j = 0; j < 8; ++j) ss += hv[i][j] * hv[i][j];
        ss = wave_sum(ss); const float r = rsqrtf(ss * (1.0f / DM) + EPS);
#pragma unroll
        for (int i = 0; i < 4; ++i) { const size_t o = (size_t)row * DM + lane * 8 + 512 * i;
            *(f32x4*)(P.h1 + o) = (f32x4){hv[i][0], hv[i][1], hv[i][2], hv[i][3]}; *(f32x4*)(P.h1 + o + 4) = (f32x4){hv[i][4], hv[i][5], hv[i][6], hv[i][7]};
            u32x4 w; w.x = cvt_pk_bf16(hv[i][0] * r, hv[i][1] * r); w.y = cvt_pk_bf16(hv[i][2] * r, hv[i][3] * r); w.z = cvt_pk_bf16(hv[i][4] * r, hv[i][5] * r); w.w = cvt_pk_bf16(hv[i][6] * r, hv[i][7] * r);
            *(u32x4*)(P.R1 + o) = w; }
    }
}

constexpr int NPHASE = 13;
__global__ void __launch_bounds__(512, 2) fwd(Params P) {
    extern __shared__ __attribute__((aligned(16))) unsigned char shm_raw[];
    LAS unsigned char* lds = (LAS unsigned char*)shm_raw;
    const int G = gridDim.x, c = blockIdx.x;
    for (int i = threadIdx.x; i < LDS_BYTES / 16; i += 512) ((LAS u32x4*)lds)[i] = (u32x4){0u, 0u, 0u, 0u};
    __syncthreads();
    XcdBarrier bar; bar.bar = P.bar; bar.x = 0; bar.st = (volatile LAS unsigned*)(lds + LDS_BARW);
    const int lo = (int)P.ph_lo, hi = (int)P.ph_hi;
    if (hi - lo > 1) bar = xcd_barrier_post(P.bar, (volatile LAS unsigned*)(lds + LDS_BARW));
#define RUN(k) (lo <= (k) && (k) < hi)
#define SEAM(k) do { if (lo <= (k) && (k) + 1 < hi) xcd_barrier(bar); } while (0)
    auto phase_fn_0 = [&]() {
    if (RUN(0)) phase_prologue(P, lds);
    };
    phase_fn_0();
#if REP_PHASE == 0
    xcd_barrier(bar); phase_fn_0();
#endif
    SEAM(0);
    auto phase_fn_1 = [&]() {
    if (RUN(1)) { pg8::StaticOrder S; S.init(T_, NZ, DM, G, c); pg8::Gemm g{P.R1, P.Wt_in, DM, nullptr}; EpiQKVU E{P.zq, P.u}; pg8::gemm_phase<EpiQKVU, pg8::StaticOrder, false>(lds, g, S, E); }
    };
    phase_fn_1();
#if REP_PHASE == 1
    xcd_barrier(bar); phase_fn_1();
#endif
    SEAM(1);
    auto phase_fn_2 = [&]() {
    if (RUN(2)) {
        for (int u = c; u < NB * NHEAD * 8; u += G) attn_unit(P, u, lds);
        for (int it = c * 8 + (threadIdx.x >> 6); it < NB * NG * NSC; it += G * 8) ssm_item<false>(P, it, lds);
    }
    };
    phase_fn_2();
#if REP_PHASE == 2
    xcd_barrier(bar); phase_fn_2();
#endif
    SEAM(2);
    auto phase_fn_3 = [&]() {
    if (RUN(3)) { for (int it = c * 8 + (threadIdx.x >> 6); it < NB * NG * NSC; it += G * 8) ssm_item<true>(P, it, lds); }
    };
    phase_fn_3();
#if REP_PHASE == 3
    xcd_barrier(bar); phase_fn_3();
#endif
    SEAM(3);
    auto phase_fn_4 = [&]() {
    if (RUN(4)) { pg8::StaticOrder S; S.init(T_, 1024, 1024, G, c); pg8::Gemm g{P.ybuf, P.Wt_glu, 1024, nullptr}; EpiGLU E{P.ybuf, P.mix}; pg8::gemm_phase<EpiGLU, pg8::StaticOrder, false>(lds, g, S, E); }
    };
    phase_fn_4();
#if REP_PHASE == 4
    xcd_barrier(bar); phase_fn_4();
#endif
    SEAM(4);
#if REP_PHASE == 100
    xcd_barrier(bar); xcd_barrier(bar); xcd_barrier(bar); xcd_barrier(bar);
#endif
    auto phase_fn_5 = [&]() {
    if (RUN(5)) phase_mixnorm(P);
    };
    phase_fn_5();
#if REP_PHASE == 5
    xcd_barrier(bar); phase_fn_5();
#endif
    SEAM(5);
    auto phase_fn_6 = [&]() {
    if (RUN(6)) { pg8::StaticOrder S; S.init(T_, DM, DM, G, c); pg8::Gemm g{P.R1, P.Wt_out, DM, nullptr}; EpiRes E{P.x, P.h1}; pg8::gemm_phase<EpiRes, pg8::StaticOrder, false>(lds, g, S, E); }
    };
    phase_fn_6();
#if REP_PHASE == 6
    xcd_barrier(bar); phase_fn_6();
#endif
    SEAM(6);
    auto phase_fn_7 = [&]() {
    if (RUN(7)) phase_router(P, lds);
    };
    phase_fn_7();
#if REP_PHASE == 7
    xcd_barrier(bar); if (blockIdx.x == 0 && threadIdx.x < NE) P.cnt[threadIdx.x * 64] = 0u; xcd_barrier(bar); phase_fn_7();
#endif
    SEAM(7);
    auto phase_fn_8 = [&]() {
    if (RUN(8)) { moe_scatter(P, lds); if (hi - lo > 1) xcd_barrier(bar);
        const int n_rt = build_moe_tables(P, lds);
        MoeSched S; S.G = G; S.c = c; S.n_rt = n_rt; S.NPN = 4; S.K = DM; S.down = false; S.rt_e = (const LAS int*)(lds + LDS_TAB); S.rt_j = S.rt_e + 256; S.rt_n = S.rt_e + 640;
        pg8::Gemm g{P.R1, P.Wt_egu, DM, P.tok_of_row}; EpiSwiGLU E{P.H, P.Hs};
        pg8::gemm_phase<EpiSwiGLU, MoeSched, true>(lds, g, S, E); }
    };
    phase_fn_8();
#if REP_PHASE == 8
    xcd_barrier(bar); phase_fn_8();
#endif
    SEAM(8);
    auto phase_fn_9 = [&]() {
    if (RUN(9)) { const int n_rt = build_moe_tables(P, lds);
        MoeSched S; S.G = G; S.c = c; S.n_rt = n_rt; S.NPN = 8; S.K = DE; S.down = true; S.rt_e = (const LAS int*)(lds + LDS_TAB); S.rt_j = S.rt_e + 256; S.rt_n = S.rt_e + 640;
        pg8::Gemm g{P.H, P.Wt_ed, DE, nullptr}; EpiDown E{P.Y, P.Ysh};
        pg8::gemm_phase<EpiDown, MoeSched, false>(lds, g, S, E); }
    };
    phase_fn_9();
#if REP_PHASE == 9
    xcd_barrier(bar); phase_fn_9();
#endif
    SEAM(9);
    auto phase_fn_10 = [&]() {
    if (RUN(10)) phase_combine(P, lds);
    };
    phase_fn_10();
#if REP_PHASE == 10
    xcd_barrier(bar); phase_fn_10();
#endif
    SEAM(10);
    auto phase_fn_11 = [&]() {
    if (RUN(11)) { pg8::StaticOrder S; S.init(T_, DM, DPLE, G, c); pg8::Gemm g{P.pb, P.Wt_pp, DPLE, nullptr}; EpiBf16 E{P.proj, DM}; pg8::gemm_phase<EpiBf16, pg8::StaticOrder, false>(lds, g, S, E); }
    };
    phase_fn_11();
#if REP_PHASE == 11
    xcd_barrier(bar); phase_fn_11();
#endif
    SEAM(11);
    auto phase_fn_12 = [&]() {
    if (RUN(12)) { pg8::StaticOrder S; S.init(T_, DM, DM, G, c); pg8::Gemm g{P.R1, P.Wt_pg, DM, nullptr}; EpiPle E{P.out, P.proj, P.h1}; pg8::gemm_phase<EpiPle, pg8::StaticOrder, false>(lds, g, S, E); }
    };
    phase_fn_12();
#if REP_PHASE == 12
    xcd_barrier(bar); phase_fn_12();
#endif
#undef RUN
#undef SEAM
}

extern "C" void kernel_launch(void* const* d_in, const int* in_sizes, int n_in, void* d_out, int out_size, void* d_ws, size_t ws_size, hipStream_t stream) {
    static int grid = 0;
    size_t off = 0;
    auto take = [&](size_t bytes) { const size_t o = off; off += (bytes + 255) & ~(size_t)255; return o; };
    const size_t o_ctl = take(32768);
    const size_t o_Wt_in = take((size_t)4096 * 2048 * 2), o_Wt_glu = take((size_t)1024 * 1024 * 2), o_Wt_out = take((size_t)2048 * 2048 * 2), o_Wt_pg = take((size_t)2048 * 2048 * 2),
                 o_Wt_pp = take((size_t)2048 * 256 * 2), o_Wt_egu = take((size_t)(NE + 1) * 1024 * 2048 * 2), o_Wt_ed = take((size_t)(NE + 1) * 2048 * 512 * 2);
    const size_t o_R1 = take((size_t)(T_ + 1) * DM * 2), o_h1 = take((size_t)T_ * DM * 4), o_tok = take((size_t)NE * CAP * 4), o_sele = take((size_t)T_ * TOPK * 4), o_selp = take((size_t)T_ * TOPK * 4),
                 o_selg = take((size_t)T_ * TOPK * 4), o_cntw = take((size_t)(T_ / 32) * NE * 4), o_basew = take((size_t)(T_ / 32) * NE * 4), o_H = take((size_t)(65536 + T_) * DE * 2), o_Ysh = take((size_t)T_ * DM * 2), o_proj = take((size_t)T_ * DM * 2), o_pb = take((size_t)T_ * DPLE * 2),
                 o_abar = take((size_t)NG * NP * 8), o_aL = take((size_t)NG * NP * 8), o_bbar = take((size_t)NG * NP * GH * 8), o_wrh = take((size_t)NE * DM * 2), o_wrl = take((size_t)NE * DM * 2);
    const size_t o_Y = take((size_t)65536 * DM * 2);
    size_t off2 = o_Y; auto take2 = [&](size_t bytes) { const size_t o = off2; off2 += (bytes + 255) & ~(size_t)255; return o; };
    const size_t o_zq = take2((size_t)T_ * 3072 * 2), o_u = take2((size_t)T_ * 1024 * 4), o_mix = take2((size_t)T_ * 2048 * 2), o_y = take2((size_t)T_ * 1024 * 2), o_E = take2((size_t)NB * NG * NSC * NP * 8);
    const size_t ws_need = off > off2 ? off : off2;
    if (grid == 0) {
        if (n_in != 30 || in_sizes[0] != T_ * DM || out_size != T_ * DM || ws_size < ws_need) {
            fprintf(stderr, "kernel_launch: unexpected shapes: n_in %d in0 %d out %d ws %zu (need %zu); nothing launched\n", n_in, n_in > 0 ? in_sizes[0] : -1, out_size, ws_size, ws_need); grid = -1; return; }
        int dev = 0, cus = 0, per_cu = 0;
        if (hipGetDevice(&dev) != hipSuccess || hipDeviceGetAttribute(&cus, hipDeviceAttributeMultiprocessorCount, dev) != hipSuccess) { fprintf(stderr, "kernel_launch: device query failed\n"); grid = -1; return; }
        if (hipFuncSetAttribute((const void*)fwd, hipFuncAttributeMaxDynamicSharedMemorySize, LDS_BYTES) != hipSuccess) { fprintf(stderr, "kernel_launch: hipFuncSetAttribute failed\n"); grid = -1; return; }
        if (hipOccupancyMaxActiveBlocksPerMultiprocessor(&per_cu, (const void*)fwd, 512, LDS_BYTES) != hipSuccess || per_cu < 1) fprintf(stderr, "kernel_launch: note: occupancy query reports %d\n", per_cu);
        (void)hipGetLastError();
        grid = cus;
    }
    if (grid < 0) return;
    char* ws = (char*)d_ws;
    if (hipMemsetAsync(ws + o_ctl, 0, 32768, stream) != hipSuccess) { fprintf(stderr, "kernel_launch: memset failed\n"); return; }
    Params P; memset(&P, 0, sizeof(P));
    const float** inp = &P.x;
    for (int i = 0; i < 30; ++i) inp[i] = (const float*)d_in[i];
    P.out = (float*)d_out;
    P.bar = (unsigned*)(ws + o_ctl); P.cnt = (unsigned*)(ws + o_ctl + 16384);
    P.Wt_in = (bf16_t*)(ws + o_Wt_in); P.Wt_glu = (bf16_t*)(ws + o_Wt_glu); P.Wt_out = (bf16_t*)(ws + o_Wt_out); P.Wt_pg = (bf16_t*)(ws + o_Wt_pg); P.Wt_pp = (bf16_t*)(ws + o_Wt_pp);
    P.Wt_egu = (bf16_t*)(ws + o_Wt_egu); P.Wt_ed = (bf16_t*)(ws + o_Wt_ed);
    P.R1 = (bf16_t*)(ws + o_R1); P.zq = (bf16_t*)(ws + o_zq); P.mix = (bf16_t*)(ws + o_mix); P.ybuf = (bf16_t*)(ws + o_y);
    P.H = (bf16_t*)(ws + o_H); P.Hs = P.H + (size_t)65536 * DE; P.Y = (bf16_t*)(ws + o_Y); P.Ysh = (bf16_t*)(ws + o_Ysh); P.proj = (bf16_t*)(ws + o_proj); P.pb = (bf16_t*)(ws + o_pb);
    P.u = (float*)(ws + o_u); P.h1 = (float*)(ws + o_h1); P.sel_gate = (float*)(ws + o_selg);
    P.Est = (float2*)(ws + o_E); P.abar = (float2*)(ws + o_abar); P.aL = (float2*)(ws + o_aL); P.bbar = (float2*)(ws + o_bbar);
    P.tok_of_row = (int*)(ws + o_tok); P.sel_e = (int*)(ws + o_sele); P.sel_pos = (int*)(ws + o_selp); P.cntw = (int*)(ws + o_cntw); P.basew = (int*)(ws + o_basew); P.Wr_hi = (bf16_t*)(ws + o_wrh); P.Wr_lo = (bf16_t*)(ws + o_wrl);
#if MK_LAUNCHES == 1
    P.ph_lo = 0; P.ph_hi = NPHASE;
    hipLaunchKernelGGL(fwd, dim3(grid), dim3(512), LDS_BYTES, stream, P);
#else
    for (int k = 0; k < NPHASE; ++k) { P.ph_lo = k; P.ph_hi = k + 1; hipLaunchKernelGGL(fwd, dim3(grid), dim3(512), LDS_BYTES, stream, P); }
#endif
    const hipError_t le = hipPeekAtLastError();
    if (le != hipSuccess) fprintf(stderr, "kernel_launch: launch failed: %s\n", hipGetErrorName(le));
}
```

```cpp
#include <hip/hip_runtime.h>
#include <cstdio>
#include <cstdint>
#include <cstring>

#ifndef MK_LAUNCHES
#define MK_LAUNCHES 1
#endif

#ifndef REP_PHASE
#define REP_PHASE -1
#endif
#define LAS __attribute__((address_space(3)))
typedef unsigned short bf16_t;
typedef short bf16x8 __attribute__((ext_vector_type(8)));
typedef short s16x4 __attribute__((ext_vector_type(4)));
typedef float f32x4 __attribute__((ext_vector_type(4)));
typedef float f32x16 __attribute__((ext_vector_type(16)));
typedef unsigned u32x4 __attribute__((ext_vector_type(4)));
typedef unsigned u32x2 __attribute__((ext_vector_type(2)));

#define XB_TMO      128
#define XB_XCNT(j)  (256  + 64 * (j))
#define XB_XSUB(j)  (1280 + 64 * (j))
#define XB_XGEN(j)  (2304 + 64 * (j))
#define XB_TOP      3328
#define XB_TOPGEN   3392
#define XCD_BAR_WORDS 3456
#define XB_SPIN_CAP (1u << 18)

__device__ __forceinline__ unsigned xb_ld(unsigned* p)              { return __hip_atomic_load(p, __ATOMIC_RELAXED, __HIP_MEMORY_SCOPE_AGENT); }
__device__ __forceinline__ unsigned xb_add(unsigned* p, unsigned v) { return __hip_atomic_fetch_add(p, v, __ATOMIC_RELAXED, __HIP_MEMORY_SCOPE_AGENT); }
__device__ __forceinline__ unsigned xb_xcc_id() { return (unsigned)__builtin_amdgcn_s_getreg((3 << 11) | 20) & 0xFu; }
#define XB_SPIN(cond, bar) do { unsigned _sp = 0; while (cond) { __builtin_amdgcn_s_sleep(1); \
    if ((++_sp & 255u) == 0u) { if (xb_ld(&(bar)[XB_TMO])) break; if (_sp > XB_SPIN_CAP) { atomicAdd(&(bar)[XB_TMO], 1u); break; } } } } while (0)

struct XcdBarrier { unsigned* bar; unsigned x; volatile LAS unsigned* st; };

__device__ __forceinline__ XcdBarrier xcd_barrier_post(unsigned* bar, volatile LAS unsigned* st) {
    XcdBarrier b; b.bar = bar; b.x = xb_xcc_id(); b.st = st;
    if (threadIdx.x == 0) (void)xb_add(&bar[XB_XCNT(b.x)], 1u);
    return b;
}
__device__ __forceinline__ void xcd_barrier_complete(unsigned* bar, unsigned x, unsigned& nloc, unsigned& nx) {
    const unsigned G = gridDim.x * gridDim.y * gridDim.z;
    unsigned sum, cnt, mine, sp = 0u;
    for (;;) {
        sum = 0u; cnt = 0u; mine = 0u;
#pragma unroll
        for (unsigned j = 0; j < 16; ++j) { const unsigned c = xb_ld(&bar[XB_XCNT(j)]); sum += c; cnt += (c > 0u) ? 1u : 0u; mine = (j == x) ? c : mine; }
        if (sum == G) break;
        __builtin_amdgcn_s_sleep(1);
        if ((++sp & 255u) == 0u) { if (xb_ld(&bar[XB_TMO])) break; if (sp > XB_SPIN_CAP) { atomicAdd(&bar[XB_TMO], 1u); break; } }
    }
    nloc = mine > 0u ? mine : 1u; nx = cnt > 0u ? cnt : 1u;
}
__device__ __forceinline__ void xcd_barrier(const XcdBarrier& b) {
    asm volatile("s_waitcnt vmcnt(0)" ::: "memory");
    __syncthreads();
    if (threadIdx.x == 0) {
        unsigned* bar = b.bar;
        __builtin_amdgcn_s_waitcnt(0);
        unsigned nloc = b.st[0], nx = b.st[1];
        if (nloc == 0u) { xcd_barrier_complete(bar, b.x, nloc, nx); b.st[0] = nloc; b.st[1] = nx; }
        const unsigned old = xb_add(&bar[XB_XSUB(b.x)], 1u);
        const unsigned gen = old / nloc;
        if (old + 1u == (gen + 1u) * nloc) {
            __builtin_amdgcn_fence(__ATOMIC_RELEASE, "agent");
            asm volatile("s_waitcnt vmcnt(0)" ::: "memory");
            const unsigned og = xb_add(&bar[XB_TOP], 1u);
            const unsigned tg = og / nx;
            if (og + 1u == (tg + 1u) * nx) xb_add(&bar[XB_TOPGEN], 1u);
            else XB_SPIN(xb_ld(&bar[XB_TOPGEN]) == tg, bar);
            __builtin_amdgcn_fence(__ATOMIC_ACQUIRE, "agent");
            xb_add(&bar[XB_XGEN(b.x)], 1u);
            asm volatile("s_waitcnt vmcnt(0)" ::: "memory");
        } else {
            XB_SPIN(xb_ld(&bar[XB_XGEN(b.x)]) == gen, bar);
            __builtin_amdgcn_fence(__ATOMIC_ACQUIRE, "agent");
            asm volatile("s_waitcnt vmcnt(0)" ::: "memory");
        }
    }
    __syncthreads();
}

constexpr int T_ = 8192, DM = 2048, NZ = 4096, SEQ = 2048, NB = 4, NHEAD = 8, HD = 128;
constexpr int NG = 64, GH = 16, NP = 64, SCH = 256, NSC = SEQ / SCH;
constexpr int NE = 64, TOPK = 6, DE = 512, DPLE = 256, CAP = 8192;
constexpr int ZROW = T_;
constexpr float EPS = 1e-6f;

constexpr int LDS_STAGE = 131072;
constexpr int LDS_TAB = LDS_STAGE;
constexpr int LDS_BARW = LDS_STAGE + 4096;
constexpr int LDS_FLAGS = LDS_BARW + 16;
constexpr int LDS_BYTES = LDS_STAGE + 4096 + 256;

struct Params {
    const float *x, *p, *norm_mix, *w_in, *q_norm, *k_norm, *lam_re, *lam_im, *log_dt, *b_re, *b_im, *c_re, *c_im, *ssm_d, *w_glu,
                *attn_out_norm, *ssm_out_norm, *w_out, *norm_ffn, *w_router, *router_bias, *w_eg, *w_eu, *w_ed, *w_sg, *w_su, *w_sd,
                *norm_ple, *w_pg, *w_pp;
    float* out;
    unsigned* bar; unsigned* cnt;
    bf16_t *Wt_in, *Wt_glu, *Wt_out, *Wt_pg, *Wt_pp, *Wt_egu, *Wt_ed, *Wr_hi, *Wr_lo;
    bf16_t *R1, *zq, *mix, *ybuf, *H, *Hs, *Y, *Ysh, *proj, *pb;
    float *u, *h1, *sel_gate;
    float2 *Est, *abar, *aL, *bbar;
    int *tok_of_row, *sel_e, *sel_pos, *cntw, *basew;
    long long ph_lo, ph_hi;
};

typedef __bf16 bf16x2_t __attribute__((ext_vector_type(2)));
typedef float f32x2_t __attribute__((ext_vector_type(2)));
__device__ __forceinline__ unsigned cvt_pk_bf16(float lo, float hi) { const f32x2_t v = {lo, hi}; const bf16x2_t b = __builtin_convertvector(v, bf16x2_t); return __builtin_bit_cast(unsigned, b); }
__device__ __forceinline__ float bf_lo(unsigned w) { return __uint_as_float(w << 16); }
__device__ __forceinline__ float bf_hi(unsigned w) { return __uint_as_float(w & 0xffff0000u); }
__device__ __forceinline__ float sigmoidf_(float v) { return 1.0f / (1.0f + __expf(-v)); }
__device__ __forceinline__ float wave_sum(float v) {
#pragma unroll
    for (int o = 32; o >= 1; o >>= 1) v += __shfl_xor(v, o);
    return v;
}
__device__ __forceinline__ float wave_max(float v) {
#pragma unroll
    for (int o = 32; o >= 1; o >>= 1) v = fmaxf(v, __shfl_xor(v, o));
    return v;
}
__device__ __forceinline__ float gelu_tanh(float v) {
    const float c = 0.7978845608028654f;
    const float in = c * (v + 0.044715f * v * v * v);
    const float e = __expf(2.0f * in);
    const float th = 1.0f - 2.0f / (1.0f + e);
    return 0.5f * v * (1.0f + th);
}

namespace pg8 {
constexpr int BM = 256, BK = 64, HALF = 128, HTB = HALF * BK * 2, STAGE_BYTES = 8 * HTB, NXCD = 8, WGM = 8;
__host__ __device__ __forceinline__ int lds_byte(int r, int c) { const int st = (r >> 4) * 2 + (c >> 5), rr = r & 15, cc = c & 31, ob = rr * 64 + cc * 2; return st * 1024 + (ob ^ (((ob >> 9) & 1) << 5)); }
__host__ __device__ __forceinline__ void stage_rc(int b, int& R, int& C) { const int st = b / 1024, sb = b % 1024, swz = sb ^ (((sb >> 9) & 1) << 5); R = (st >> 1) * 16 + swz / 64; C = (st & 1) * 32 + (swz % 64) / 2; }
__host__ __device__ __forceinline__ int perm32(int rho) { const int n = rho >> 4, i = rho & 15; return 8 * (i >> 2) + 4 * n + (i & 3); }

struct Unit { int pm, pn, kind, nrows, arow, brow, orow0, gofs; };
struct Gemm { const bf16_t* A; const bf16_t* Bt; int K; const int* gtab; };

struct StaticOrder {
    int nM, nN, nwg, G, c, K;
    __device__ void init(int M, int N, int K_, int G_, int c_) { nM = M / BM; nN = N / BM; nwg = nM * nN; G = G_; c = c_; K = K_; }
    __device__ __forceinline__ Unit next(int i) const {
        Unit u; const long L = (long)i * G + c; const bool valid = L < nwg;
        int wgid = valid ? (int)L : 0; { const int q = nwg / NXCD, r = nwg % NXCD, xcd = wgid % NXCD, off = wgid / NXCD; wgid = (xcd < r ? xcd * (q + 1) : r * (q + 1) + (xcd - r) * q) + off; }
        const int nig = WGM * nN, gid = wgid / nig, fm = gid * WGM, gsz = (nM - fm) < WGM ? (nM - fm) : WGM;
        u.pm = fm + ((wgid % nig) % gsz); u.pn = (wgid % nig) / gsz;
        u.arow = u.pm * BM; u.brow = u.pn * BM; u.gofs = -1; u.nrows = BM; u.kind = 0; u.orow0 = u.pm * BM;
        if (!valid) u.pm = -1;
        return u;
    }
};

template <class Epi, class Sched, bool GATHER>
__device__ __forceinline__ void gemm_phase(LAS unsigned char* lds, const Gemm g, const Sched& S, const Epi& E) {
    const int tid = threadIdx.x, wid = __builtin_amdgcn_readfirstlane(tid >> 6), lane = tid & 63, wr = wid >> 2, wc = wid & 3, fr = lane & 15, fq = lane >> 4;
    const int K = g.K, nt = K / BK;
    unsigned voffA[2], voffB[2];
#pragma unroll
    for (int i = 0; i < 2; ++i) { int R, C; stage_rc(tid * 16 + i * 8192, R, C); const int Rb = Epi::PERM ? ((R & ~31) + perm32(R & 31)) : R;
        voffA[i] = (unsigned)(R * K + C) * 2u; voffB[i] = (unsigned)(Rb * K + C) * 2u; }
    const size_t kstep = (size_t)(BK * 2);
    const size_t hstep = (size_t)HALF * K * 2;
    const unsigned ldsw = (unsigned)wid * 1024u;
    const int aoff = lds_byte(wr * 64 + fr, fq * 8), boff = lds_byte(wc * 32 + fr, fq * 8);
#define PG8_SA(b, h) (((b) * 2 + (h)) * HTB)
#define PG8_SB(b, h) ((4 + (b) * 2 + (h)) * HTB)
#define PG8_STAGE(bufoff, gbase, voff) do { _Pragma("unroll") for (int _i = 0; _i < 2; ++_i) \
        __builtin_amdgcn_global_load_lds((const unsigned*)((const char*)(gbase) + (voff)[_i]), (LAS unsigned*)(lds + (bufoff) + ldsw + _i * 8192), 16, 0, 0); } while (0)
#define PG8_LDA(dst, b, h) do { _Pragma("unroll") for (int m = 0; m < 4; ++m) _Pragma("unroll") for (int k = 0; k < 2; ++k) dst[m][k] = *(const LAS bf16x8*)(lds + PG8_SA(b, h) + aoff + m * 2048 + k * 1024); } while (0)
#define PG8_LDB(dst, b, h) do { _Pragma("unroll") for (int n = 0; n < 2; ++n) _Pragma("unroll") for (int k = 0; k < 2; ++k) dst[n][k] = *(const LAS bf16x8*)(lds + PG8_SB(b, h) + boff + n * 2048 + k * 1024); } while (0)
#define PG8_MMA(ai, bj, At, Bt) do { __builtin_amdgcn_s_setprio(1); _Pragma("unroll") for (int m = 0; m < 4; ++m) _Pragma("unroll") for (int n = 0; n < 2; ++n) _Pragma("unroll") for (int k = 0; k < 2; ++k) \
        acc[ai][bj][m][n] = __builtin_amdgcn_mfma_f32_16x16x32_bf16(Bt[n][k], At[m][k], acc[ai][bj][m][n], 0, 0, 0); __builtin_amdgcn_s_setprio(0); } while (0)
#define PG8_WAIT_V(n) asm volatile("s_waitcnt vmcnt(" #n ")" ::: "memory")
#define PG8_WAIT_L(n) asm volatile("s_waitcnt lgkmcnt(" #n ")" ::: "memory")
#define PG8_BAR __builtin_amdgcn_s_barrier()
#define PG8_SCHED __builtin_amdgcn_sched_barrier(0)
    Unit cur = S.next(0), nxt; int ui = 0;
    if (cur.pm < 0) return;
    f32x4 acc[2][2][4][2];
#pragma unroll
    for (int a = 0; a < 2; ++a)
#pragma unroll
        for (int b = 0; b < 2; ++b)
#pragma unroll
            for (int m = 0; m < 4; ++m)
#pragma unroll
                for (int n = 0; n < 2; ++n) acc[a][b][m][n] = (f32x4){0.f, 0.f, 0.f, 0.f};
    bf16x8 At[4][2], B0[2][2], B1[2][2];
    unsigned cvo0[2] = {0u, 0u}, cvo1[2] = {0u, 0u}, nvo0[2] = {0u, 0u}, nvo1[2] = {0u, 0u};
    auto load_vo = [&](const Unit& u, unsigned (&v0)[2], unsigned (&v1)[2]) {
#pragma unroll
        for (int i = 0; i < 2; ++i) { int R, C; stage_rc(tid * 16 + i * 8192, R, C);
            int r0 = R, r1 = HALF + R;
            int t0, t1;
            if (u.gofs >= 0) { t0 = (r0 < u.nrows) ? g.gtab[u.gofs + r0] : ZROW; t1 = (r1 < u.nrows) ? g.gtab[u.gofs + r1] : ZROW; }
            else { t0 = u.orow0 + r0; t1 = u.orow0 + r1; }
            v0[i] = (unsigned)t0 * (unsigned)(K * 2) + (unsigned)(C * 2); v1[i] = (unsigned)t1 * (unsigned)(K * 2) + (unsigned)(C * 2); }
    };
    const size_t rowb = (size_t)K * 2;
    const char* cA = (const char*)g.A + (GATHER ? 0 : (size_t)cur.arow * rowb); const char* cB = (const char*)g.Bt + (size_t)cur.brow * rowb;
    if (GATHER) load_vo(cur, cvo0, cvo1);
    if (GATHER) {
        PG8_STAGE(PG8_SB(0, 0), cB, voffB); PG8_STAGE(PG8_SA(0, 0), cA, cvo0); PG8_STAGE(PG8_SB(0, 1), cB + hstep, voffB); PG8_STAGE(PG8_SA(0, 1), cA, cvo1);
    } else {
        PG8_STAGE(PG8_SB(0, 0), cB, voffB); PG8_STAGE(PG8_SA(0, 0), cA, voffA); PG8_STAGE(PG8_SB(0, 1), cB + hstep, voffB); PG8_STAGE(PG8_SA(0, 1), cA + hstep, voffA);
    }
    if (wr == 1) PG8_BAR;
    PG8_WAIT_V(4); PG8_BAR;
    if (GATHER) {
        PG8_STAGE(PG8_SB(1, 0), cB + kstep, voffB); PG8_STAGE(PG8_SA(1, 0), cA + kstep, cvo0); PG8_STAGE(PG8_SB(1, 1), cB + hstep + kstep, voffB);
    } else {
        PG8_STAGE(PG8_SB(1, 0), cB + kstep, voffB); PG8_STAGE(PG8_SA(1, 0), cA + kstep, voffA); PG8_STAGE(PG8_SB(1, 1), cB + hstep + kstep, voffB);
    }
    PG8_WAIT_V(6); PG8_BAR;
    for (;;) {
        nxt = S.next(ui + 1); const bool has_next = nxt.pm >= 0;
        const char* nA = GATHER ? cA : (has_next ? (const char*)g.A + (size_t)nxt.arow * rowb : cA); const char* nB = has_next ? (const char*)g.Bt + (size_t)nxt.brow * rowb : cB;
        if (GATHER) { if (has_next) load_vo(nxt, nvo0, nvo1); else { nvo0[0] = cvo0[0]; nvo0[1] = cvo0[1]; nvo1[0] = cvo1[0]; nvo1[1] = cvo1[1]; } }
        for (int t = 0; t < nt; t += 2) {
            const bool last = (t == nt - 2);
            const char* a1 = cA + (size_t)(t + 1) * kstep;
            const char* a2 = last ? nA : cA + (size_t)(t + 2) * kstep; const char* b2 = last ? nB : cB + (size_t)(t + 2) * kstep;
            const char* a3 = a2 + kstep; const char* b3 = b2 + kstep;
            unsigned s0[2], s1[2];
            if (GATHER) { s0[0] = last ? nvo0[0] : cvo0[0]; s0[1] = last ? nvo0[1] : cvo0[1]; s1[0] = last ? nvo1[0] : cvo1[0]; s1[1] = last ? nvo1[1] : cvo1[1]; }
            PG8_LDB(B0, 0, 0); PG8_SCHED; PG8_LDA(At, 0, 0);
            if (GATHER) PG8_STAGE(PG8_SA(1, 1), a1, cvo1); else PG8_STAGE(PG8_SA(1, 1), a1 + hstep, voffA);
            PG8_WAIT_L(8); PG8_BAR; PG8_WAIT_L(0); PG8_MMA(0, 0, At, B0); PG8_BAR; PG8_SCHED;
            PG8_LDB(B1, 0, 1); PG8_STAGE(PG8_SB(0, 0), b2, voffB);
            PG8_BAR; PG8_WAIT_L(0); PG8_MMA(0, 1, At, B1); PG8_BAR;
            PG8_LDA(At, 0, 1);
            if (GATHER) PG8_STAGE(PG8_SA(0, 0), a2, s0); else PG8_STAGE(PG8_SA(0, 0), a2, voffA);
            PG8_BAR; PG8_WAIT_L(0); PG8_MMA(1, 0, At, B0); PG8_BAR; PG8_SCHED;
            PG8_STAGE(PG8_SB(0, 1), b2 + hstep, voffB);
            PG8_WAIT_V(6); PG8_BAR; PG8_MMA(1, 1, At, B1); PG8_BAR;
            PG8_LDB(B0, 1, 0); PG8_SCHED; PG8_LDA(At, 1, 0);
            if (GATHER) PG8_STAGE(PG8_SA(0, 1), a2, s1); else PG8_STAGE(PG8_SA(0, 1), a2 + hstep, voffA);
            PG8_WAIT_L(8); PG8_BAR; PG8_WAIT_L(0); PG8_MMA(0, 0, At, B0); PG8_BAR; PG8_SCHED;
            PG8_LDB(B1, 1, 1); PG8_STAGE(PG8_SB(1, 0), b3, voffB);
            PG8_BAR; PG8_WAIT_L(0); PG8_MMA(0, 1, At, B1); PG8_BAR;
            PG8_LDA(At, 1, 1);
            if (GATHER) PG8_STAGE(PG8_SA(1, 0), a3, s0); else PG8_STAGE(PG8_SA(1, 0), a3, voffA);
            PG8_BAR; PG8_WAIT_L(0); PG8_MMA(1, 0, At, B0); PG8_BAR; PG8_SCHED;
            PG8_STAGE(PG8_SB(1, 1), b3 + hstep, voffB);
            PG8_WAIT_V(6); PG8_BAR; PG8_MMA(1, 1, At, B1); PG8_BAR;
        }
        E(acc, cur, wr, wc, fr, fq);
        if (!has_next) break;
#pragma unroll
        for (int a = 0; a < 2; ++a)
#pragma unroll
            for (int b = 0; b < 2; ++b)
#pragma unroll
                for (int m = 0; m < 4; ++m)
#pragma unroll
                    for (int n = 0; n < 2; ++n) acc[a][b][m][n] = (f32x4){0.f, 0.f, 0.f, 0.f};
        cur = nxt; cA = nA; cB = nB; ++ui;
        if (GATHER) { cvo0[0] = nvo0[0]; cvo0[1] = nvo0[1]; cvo1[0] = nvo1[0]; cvo1[1] = nvo1[1]; }
    }
    PG8_WAIT_V(0);
    if (wr == 0) PG8_BAR;
    PG8_BAR;
#undef PG8_SA
#undef PG8_SB
#undef PG8_STAGE
#undef PG8_LDA
#undef PG8_LDB
#undef PG8_MMA
#undef PG8_WAIT_V
#undef PG8_WAIT_L
#undef PG8_BAR
#undef PG8_SCHED
}
}
using pg8::Unit;

typedef f32x4 Acc[2][2][4][2];

template <int O0, int O1, int O2, int O3>
__device__ __forceinline__ void ld4x16(const void* p, f32x4& a, f32x4& b, f32x4& c, f32x4& d) {
    asm volatile("global_load_dwordx4 %0, %4, off offset:%5\n\tglobal_load_dwordx4 %1, %4, off offset:%6\n\tglobal_load_dwordx4 %2, %4, off offset:%7\n\tglobal_load_dwordx4 %3, %4, off offset:%8\n\ts_waitcnt vmcnt(0)"
                 : "=&v"(a), "=&v"(b), "=&v"(c), "=&v"(d) : "v"(p), "i"(O0), "i"(O1), "i"(O2), "i"(O3) : "memory");
}
template <int O0, int O1, int O2, int O3>
__device__ __forceinline__ void ld4x16_4x8(const void* p, f32x4& a, f32x4& b, f32x4& c, f32x4& d, const void* q, u32x2& e, u32x2& f, u32x2& g, u32x2& h) {
    asm volatile("global_load_dwordx4 %0, %8, off offset:%10\n\tglobal_load_dwordx4 %1, %8, off offset:%11\n\tglobal_load_dwordx4 %2, %8, off offset:%12\n\tglobal_load_dwordx4 %3, %8, off offset:%13\n\t"
                 "global_load_dwordx2 %4, %9, off offset:%14\n\tglobal_load_dwordx2 %5, %9, off offset:%15\n\tglobal_load_dwordx2 %6, %9, off offset:%16\n\tglobal_load_dwordx2 %7, %9, off offset:%17\n\ts_waitcnt vmcnt(0)"
                 : "=&v"(a), "=&v"(b), "=&v"(c), "=&v"(d), "=&v"(e), "=&v"(f), "=&v"(g), "=&v"(h)
                 : "v"(p), "v"(q), "i"(O0), "i"(O1), "i"(O2), "i"(O3), "i"(O0 / 2), "i"(O1 / 2), "i"(O2 / 2), "i"(O3 / 2) : "memory");
}
struct EpiQKVU {
    static constexpr bool PERM = true;
    bf16_t* zq; float* u;
    __device__ __forceinline__ void operator()(const Acc& acc, const Unit& un, int wr, int wc, int fr, int fq) const {
        const int row0 = un.pm * 256 + wr * 64 + fr, col0 = un.pn * 256 + wc * 32 + 8 * fq;
        if (un.pn < 12) {
#pragma unroll
            for (int ai = 0; ai < 2; ++ai)
#pragma unroll
                for (int m = 0; m < 4; ++m) { bf16_t* rowp = zq + (size_t)(row0 + ai * 128 + m * 16) * 3072 + col0;
#pragma unroll
                    for (int bj = 0; bj < 2; ++bj) { const f32x4 v0 = acc[ai][bj][m][0], v1 = acc[ai][bj][m][1];
                        u32x4 w; w.x = cvt_pk_bf16(v0[0], v0[1]); w.y = cvt_pk_bf16(v0[2], v0[3]); w.z = cvt_pk_bf16(v1[0], v1[1]); w.w = cvt_pk_bf16(v1[2], v1[3]);
                        *(u32x4*)(rowp + bj * 128) = w; } }
        } else {
#pragma unroll
            for (int ai = 0; ai < 2; ++ai)
#pragma unroll
                for (int m = 0; m < 4; ++m) { float* rowp = u + (size_t)(row0 + ai * 128 + m * 16) * 1024 + (col0 - 3072);
#pragma unroll
                    for (int bj = 0; bj < 2; ++bj) { *(f32x4*)(rowp + bj * 128) = acc[ai][bj][m][0]; *(f32x4*)(rowp + bj * 128 + 4) = acc[ai][bj][m][1]; } }
        }
    }
};
struct EpiGLU {
    static constexpr bool PERM = true;
    const bf16_t* __restrict__ y; bf16_t* __restrict__ mix;
    __device__ __forceinline__ void operator()(const Acc& acc, const Unit& un, int wr, int wc, int fr, int fq) const {
        const int row0 = un.pm * 256 + wr * 64 + fr, col0 = un.pn * 256 + wc * 32 + 8 * fq;
#pragma unroll
        for (int ai = 0; ai < 2; ++ai)
#pragma unroll
            for (int m = 0; m < 4; ++m) { const size_t row = (size_t)(row0 + ai * 128 + m * 16);
#pragma unroll
                for (int bj = 0; bj < 2; ++bj) { const f32x4 v0 = acc[ai][bj][m][0], v1 = acc[ai][bj][m][1];
                    const u32x4 yv = *(const u32x4*)(y + row * 1024 + col0 + bj * 128);
                    u32x4 w;
                    w.x = cvt_pk_bf16(bf_lo(yv.x) * sigmoidf_(v0[0]), bf_hi(yv.x) * sigmoidf_(v0[1]));
                    w.y = cvt_pk_bf16(bf_lo(yv.y) * sigmoidf_(v0[2]), bf_hi(yv.y) * sigmoidf_(v0[3]));
                    w.z = cvt_pk_bf16(bf_lo(yv.z) * sigmoidf_(v1[0]), bf_hi(yv.z) * sigmoidf_(v1[1]));
                    w.w = cvt_pk_bf16(bf_lo(yv.w) * sigmoidf_(v1[2]), bf_hi(yv.w) * sigmoidf_(v1[3]));
                    *(u32x4*)(mix + row * 2048 + 1024 + col0 + bj * 128) = w; } }
    }
};
struct EpiRes {
    static constexpr bool PERM = false;
    const float* x; float* h1;
    __device__ __forceinline__ void operator()(const Acc& acc, const Unit& un, int wr, int wc, int fr, int fq) const {
        const int row0 = un.pm * 256 + wr * 64 + fr, col0 = un.pn * 256 + wc * 32 + 4 * fq;
#pragma unroll
        for (int ai = 0; ai < 2; ++ai)
#pragma unroll
            for (int m = 0; m < 4; ++m) { const size_t ro = (size_t)(row0 + ai * 128 + m * 16) * 2048 + col0;
                f32x4 x00, x01, x10, x11; ld4x16<0, 64, 512, 576>(x + ro, x00, x01, x10, x11);
                *(f32x4*)(h1 + ro) = x00 + acc[ai][0][m][0]; *(f32x4*)(h1 + ro + 16) = x01 + acc[ai][0][m][1];
                *(f32x4*)(h1 + ro + 128) = x10 + acc[ai][1][m][0]; *(f32x4*)(h1 + ro + 144) = x11 + acc[ai][1][m][1]; }
    }
};
struct EpiSwiGLU {
    static constexpr bool PERM = true;
    bf16_t* H; bf16_t* Hs;
    __device__ __forceinline__ void operator()(const Acc& acc, const Unit& un, int wr, int wc, int fr, int fq) const {
        bf16_t* base = un.kind ? Hs : H;
        const size_t row0 = (size_t)un.orow0 + wr * 64 + fr; const int col0 = un.pn * 128 + wc * 32 + 8 * fq;
#pragma unroll
        for (int ai = 0; ai < 2; ++ai)
#pragma unroll
            for (int m = 0; m < 4; ++m) { const f32x4 g0 = acc[ai][0][m][0], g1 = acc[ai][0][m][1], u0 = acc[ai][1][m][0], u1 = acc[ai][1][m][1];
                u32x4 w;
                w.x = cvt_pk_bf16(g0[0] * sigmoidf_(g0[0]) * u0[0], g0[1] * sigmoidf_(g0[1]) * u0[1]);
                w.y = cvt_pk_bf16(g0[2] * sigmoidf_(g0[2]) * u0[2], g0[3] * sigmoidf_(g0[3]) * u0[3]);
                w.z = cvt_pk_bf16(g1[0] * sigmoidf_(g1[0]) * u1[0], g1[1] * sigmoidf_(g1[1]) * u1[1]);
                w.w = cvt_pk_bf16(g1[2] * sigmoidf_(g1[2]) * u1[2], g1[3] * sigmoidf_(g1[3]) * u1[3]);
                *(u32x4*)(base + (row0 + ai * 128 + m * 16) * 512 + col0) = w; }
    }
};
struct EpiDown {
    static constexpr bool PERM = true;
    bf16_t* Y; bf16_t* Ysh;
    __device__ __forceinline__ void operator()(const Acc& acc, const Unit& un, int wr, int wc, int fr, int fq) const {
        const int col0 = un.pn * 256 + wc * 32 + 8 * fq; bf16_t* base = (un.kind ? Ysh : Y) + (size_t)un.orow0 * 2048 + col0;
#pragma unroll
        for (int ai = 0; ai < 2; ++ai)
#pragma unroll
            for (int m = 0; m < 4; ++m) { const int r = ai * 128 + wr * 64 + m * 16 + fr;
                if (r < un.nrows) { bf16_t* rowp = base + (size_t)r * 2048;
#pragma unroll
                    for (int bj = 0; bj < 2; ++bj) { const f32x4 v0 = acc[ai][bj][m][0], v1 = acc[ai][bj][m][1];
                        u32x4 w; w.x = cvt_pk_bf16(v0[0], v0[1]); w.y = cvt_pk_bf16(v0[2], v0[3]); w.z = cvt_pk_bf16(v1[0], v1[1]); w.w = cvt_pk_bf16(v1[2], v1[3]);
                        *(u32x4*)(rowp + bj * 128) = w; } } }
    }
};
struct EpiBf16 {
    static constexpr bool PERM = true;
    bf16_t* O; int ldo;
    __device__ __forceinline__ void operator()(const Acc& acc, const Unit& un, int wr, int wc, int fr, int fq) const {
        const int row0 = un.pm * 256 + wr * 64 + fr, col0 = un.pn * 256 + wc * 32 + 8 * fq;
#pragma unroll
        for (int ai = 0; ai < 2; ++ai)
#pragma unroll
            for (int m = 0; m < 4; ++m) { bf16_t* rowp = O + (size_t)(row0 + ai * 128 + m * 16) * ldo + col0;
#pragma unroll
                for (int bj = 0; bj < 2; ++bj) { const f32x4 v0 = acc[ai][bj][m][0], v1 = acc[ai][bj][m][1];
                    u32x4 w; w.x = cvt_pk_bf16(v0[0], v0[1]); w.y = cvt_pk_bf16(v0[2], v0[3]); w.z = cvt_pk_bf16(v1[0], v1[1]); w.w = cvt_pk_bf16(v1[2], v1[3]);
                    *(u32x4*)(rowp + bj * 128) = w; } }
    }
};
struct EpiPle {
    static constexpr bool PERM = false;
    float* out; const bf16_t* proj; const float* h2;
    __device__ __forceinline__ void operator()(const Acc& acc, const Unit& un, int wr, int wc, int fr, int fq) const {
        const int row0 = un.pm * 256 + wr * 64 + fr, col0 = un.pn * 256 + wc * 32 + 4 * fq;
#pragma unroll
        for (int ai = 0; ai < 2; ++ai)
#pragma unroll
            for (int m = 0; m < 4; ++m) { const size_t ro = (size_t)(row0 + ai * 128 + m * 16) * 2048 + col0;
                f32x4 hv[4]; u32x2 pv[4]; ld4x16_4x8<0, 64, 512, 576>(h2 + ro, hv[0], hv[1], hv[2], hv[3], proj + ro, pv[0], pv[1], pv[2], pv[3]);
#pragma unroll
                for (int q = 0; q < 4; ++q) { const int bj = q >> 1, n = q & 1; const f32x4 a = acc[ai][bj][m][n]; f32x4 r;
                    r[0] = hv[q][0] + sigmoidf_(a[0]) * bf_lo(pv[q].x); r[1] = hv[q][1] + sigmoidf_(a[1]) * bf_hi(pv[q].x);
                    r[2] = hv[q][2] + sigmoidf_(a[2]) * bf_lo(pv[q].y); r[3] = hv[q][3] + sigmoidf_(a[3]) * bf_hi(pv[q].y);
                    *(f32x4*)(out + ro + bj * 128 + n * 16) = r; } }
    }
};

struct MoeSched {
    int G, c, n_rt, NPN, K; bool down;
    const LAS int* rt_e; const LAS int* rt_j; const LAS int* rt_n;
    __device__ __forceinline__ Unit next(int i) const {
        Unit u; const int NRT = n_rt + 32, per = (NRT + 7) >> 3, SL = G >> 3, x = c & 7, s = c >> 3;
        const int q = i * SL + s, rl = q / NPN, rtg = x * per + rl;
        const bool valid = s < SL && rl < per && rtg < NRT, routed = valid && rtg < n_rt;
        const int rt = routed ? rtg : 0, spm = (valid && !routed) ? rtg - n_rt : 0;
        const int e = __builtin_amdgcn_readfirstlane(rt_e[rt]), j = __builtin_amdgcn_readfirstlane(rt_j[rt]);
        const int rem = __builtin_amdgcn_readfirstlane(rt_n[rt]);
        const int Lr = q % NPN;
        u.kind = routed ? 0 : 1;
        u.pn = Lr;
        u.pm = routed ? rt : spm;
        u.nrows = routed ? rem : 256;
        const int ee = routed ? e : NE;
        if (!down) {
            u.arow = 0; u.gofs = routed ? (e * CAP + j * 256) : -1;
            u.brow = ee * 1024 + u.pn * 256;
            u.orow0 = routed ? rt * 256 : spm * 256;
        } else {
            u.gofs = -1;
            u.arow = routed ? rt * 256 : 65536 + spm * 256;
            u.brow = ee * 2048 + u.pn * 256;
            u.orow0 = routed ? rt * 256 : spm * 256;
        }
        if (!valid) u.pm = -1;
        return u;
    }
};

__device__ __forceinline__ void cvt_tile(const float* __restrict__ src, int ldw, int k0, int n0, const float* __restrict__ gain, bf16_t* __restrict__ dst, int ldd, int dk0,
                                         int inter, int roff, LAS float* lt) {
    const int tid = threadIdx.x, c4 = tid & 63, r8 = tid >> 6;
    f32x4 v[8];
#pragma unroll
    for (int i = 0; i < 8; ++i) v[i] = *(const f32x4*)(src + (size_t)(k0 + r8 + 8 * i) * ldw + n0 + 4 * c4);
#pragma unroll
    for (int i = 0; i < 8; ++i) { const int k = r8 + 8 * i; const float gsc = gain ? gain[k0 + k] : 1.0f; LAS float* q = lt + k * 257 + 4 * c4;
        q[0] = v[i][0] * gsc; q[1] = v[i][1] * gsc; q[2] = v[i][2] * gsc; q[3] = v[i][3] * gsc; }
    __syncthreads();
#pragma unroll
    for (int i = 0; i < 4; ++i) { const int q = tid + 512 * i, kg = q & 7, n = q >> 3; const LAS float* s = lt + (8 * kg) * 257 + n;
        u32x4 w; w.x = cvt_pk_bf16(s[0], s[257]); w.y = cvt_pk_bf16(s[2 * 257], s[3 * 257]); w.z = cvt_pk_bf16(s[4 * 257], s[5 * 257]); w.w = cvt_pk_bf16(s[6 * 257], s[7 * 257]);
        const int ng = n0 + n; const int drow = inter ? ((ng >> 7) * 256 + roff + (ng & 127)) : ng;
        *(u32x4*)(dst + (size_t)drow * ldd + dk0 + k0 + 8 * kg) = w; }
    __syncthreads();
}
__device__ __forceinline__ void cvt_job(long& base, const float* src, int K, int N, const float* gain, bf16_t* dst, int ldd, int dk0, int inter, int roff, LAS float* lt) {
    const int nk = K / 64, nn = N / 256, ntl = nk * nn, G = gridDim.x;
    int t = (int)(((long)blockIdx.x - base % G + G) % G);
    for (; t < ntl; t += G) { const int kt = t % nk, ntile = t / nk; cvt_tile(src, N, kt * 64, ntile * 256, gain, dst, ldd, dk0, inter, roff, lt); }
    base += ntl;
}
__device__ void phase_prologue(const Params& P, LAS unsigned char* lds) {
    LAS float* lt = (LAS float*)lds;
    const int tid = threadIdx.x, wid = tid >> 6, lane = tid & 63, G = gridDim.x;
    for (int row = blockIdx.x * 8 + wid; row < T_; row += G * 8) {
        const float* xr = P.x + (size_t)row * DM; f32x4 v[8]; float ss = 0.f;
#pragma unroll
        for (int i = 0; i < 8; ++i) { v[i] = *(const f32x4*)(xr + 4 * lane + 256 * i); ss += v[i][0] * v[i][0] + v[i][1] * v[i][1] + v[i][2] * v[i][2] + v[i][3] * v[i][3]; }
        ss = wave_sum(ss); const float r = rsqrtf(ss * (1.0f / DM) + EPS);
#pragma unroll
        for (int i = 0; i < 8; ++i) { u32x2 w; w.x = cvt_pk_bf16(v[i][0] * r, v[i][1] * r); w.y = cvt_pk_bf16(v[i][2] * r, v[i][3] * r); *(u32x2*)(P.R1 + (size_t)row * DM + 4 * lane + 256 * i) = w; }
    }
    if (blockIdx.x == 0) { for (int i = tid; i < DM / 2; i += 512) ((unsigned*)(P.R1 + (size_t)ZROW * DM))[i] = 0u; }
    for (size_t i = (size_t)blockIdx.x * 512 + tid; i < (size_t)T_ * DPLE / 8; i += (size_t)G * 512) { const f32x4 a = *(const f32x4*)(P.p + i * 8), b2 = *(const f32x4*)(P.p + i * 8 + 4);
        u32x4 w; w.x = cvt_pk_bf16(a[0], a[1]); w.y = cvt_pk_bf16(a[2], a[3]); w.z = cvt_pk_bf16(b2[0], b2[1]); w.w = cvt_pk_bf16(b2[2], b2[3]); *(u32x4*)(P.pb + i * 8) = w; }
    for (int i = blockIdx.x * 512 + tid; i < NG * NP; i += G * 512) {
        const int g = i / NP;
        const float lr = P.lam_re[i], li = P.lam_im[i]; const float dt = expf(P.log_dt[g]);
        const double mag = exp((double)lr * (double)dt), ang = (double)li * (double)dt;
        const float ar = (float)(mag * cos(ang)), ai = (float)(mag * sin(ang));
        const double magL = exp((double)lr * (double)dt * SCH), angL = ang * SCH;
        P.abar[i] = make_float2(ar, ai); P.aL[i] = make_float2((float)(magL * cos(angL)), (float)(magL * sin(angL)));
        const float nr = ar - 1.0f, ni = ai, den = lr * lr + li * li;
        const float cr = (nr * lr + ni * li) / den, ci = (ni * lr - nr * li) / den;
#pragma unroll
        for (int h = 0; h < GH; ++h) { const float br = P.b_re[(size_t)i * GH + h], bi = P.b_im[(size_t)i * GH + h];
            P.bbar[(size_t)i * GH + h] = make_float2(cr * br - ci * bi, cr * bi + ci * br); }
    }
    for (int i = blockIdx.x * 512 + tid; i < NE * DM; i += G * 512) { const int e = i / DM, k = i % DM; const float w = P.w_router[(size_t)k * NE + e] * P.norm_ffn[k];
        const unsigned hw = cvt_pk_bf16(w, 0.f); const float hf = bf_lo(hw); P.Wr_hi[i] = (bf16_t)(hw & 0xffffu); P.Wr_lo[i] = (bf16_t)(cvt_pk_bf16(w - hf, 0.f) & 0xffffu); }
    long base = 0;
    cvt_job(base, P.w_in, 2048, 4096, P.norm_mix, P.Wt_in, 2048, 0, 0, 0, lt);
    cvt_job(base, P.w_glu, 1024, 1024, nullptr, P.Wt_glu, 1024, 0, 0, 0, lt);
    cvt_job(base, P.w_out, 1024, 2048, P.attn_out_norm, P.Wt_out, 2048, 0, 0, 0, lt);
    cvt_job(base, P.w_out + (size_t)1024 * 2048, 1024, 2048, P.ssm_out_norm, P.Wt_out, 2048, 1024, 0, 0, lt);
    cvt_job(base, P.w_sg, 2048, 512, nullptr, P.Wt_egu + (size_t)NE * 1024 * 2048, 2048, 0, 1, 0, lt);
    cvt_job(base, P.w_su, 2048, 512, nullptr, P.Wt_egu + (size_t)NE * 1024 * 2048, 2048, 0, 1, 128, lt);
    cvt_job(base, P.w_sd, 512, 2048, nullptr, P.Wt_ed + (size_t)NE * 2048 * 512, 512, 0, 0, 0, lt);
    cvt_job(base, P.w_pg, 2048, 2048, P.norm_ple, P.Wt_pg, 2048, 0, 0, 0, lt);
    cvt_job(base, P.w_pp, 256, 2048, nullptr, P.Wt_pp, 256, 0, 0, 0, lt);
    {
        const int ntl = NE * 192; int t = (int)(((long)blockIdx.x - base % G + G) % G);
        for (; t < ntl; t += G) { const int e = t / 192, r = t % 192;
            if (r < 128) { const int up = r >> 6, q = r & 63, kt = q & 31, ntile = q >> 5;
                cvt_tile((up ? P.w_eu : P.w_eg) + (size_t)e * 2048 * 512, 512, kt * 64, ntile * 256, nullptr, P.Wt_egu + (size_t)e * 1024 * 2048, 2048, 0, 1, up ? 128 : 0, lt); }
            else { const int q = r - 128, kt = q & 7, ntile = q >> 3;
                cvt_tile(P.w_ed + (size_t)e * 512 * 2048, 2048, kt * 64, ntile * 256, nullptr, P.Wt_ed + (size_t)e * 2048 * 512, 512, 0, 0, 0, lt); } }
    }
}

#define KSWZ(row, colB) ((row) * 256 + ((colB) ^ (((row) & 7) << 4)))
#define SBAR() __builtin_amdgcn_sched_barrier(0)
__device__ __forceinline__ int crow(int r, int hi) { return (r & 3) + 8 * (r >> 2) + 4 * hi; }
__device__ __forceinline__ void qkt(f32x16& p0, f32x16& p1, const LAS unsigned char* Ks, const bf16x8* qr, int r32, int hi) {
    p0 = f32x16{}; p1 = f32x16{};
#pragma unroll
    for (int d0 = 0; d0 < 8; ++d0) { const int cb = (d0 * 16 + hi * 8) * 2;
        const bf16x8 b0 = *(const LAS bf16x8*)(Ks + KSWZ(r32, cb));
        const bf16x8 b1 = *(const LAS bf16x8*)(Ks + KSWZ(32 + r32, cb));
        p0 = __builtin_amdgcn_mfma_f32_32x32x16_bf16(b0, qr[d0], p0, 0, 0, 0);
        p1 = __builtin_amdgcn_mfma_f32_32x32x16_bf16(b1, qr[d0], p1, 0, 0, 0); }
}
__device__ __forceinline__ int v_st(int k, int c) { const int kk = (k & ~0xC) | ((k & 4) << 1) | ((k & 8) >> 1); return ((kk >> 3) * 4 + (c >> 5)) * 512 + ((kk & 7) * 32 + (c & 31)) * 2; }
__device__ __forceinline__ int v_rd_base(int lane) { return ((lane & 3) << 3) | (((lane >> 2) & 3) << 6) | (((lane >> 4) & 1) << 5) | (((lane >> 5) & 1) << 8); }
constexpr int v_rd_off(int d0, int ks, int half) { return d0 * 512 + ks * 4096 + half * 2048; }
template <int D0> __device__ __forceinline__ void pv_one(f32x16& od, int vb, bf16x8 pa0, bf16x8 pa1, bf16x8 pa2, bf16x8 pa3) {
    s16x4 l0, h0, l1, h1, l2, h2, l3, h3;
    asm volatile("ds_read_b64_tr_b16 %0, %8 offset:%9\n\t"
                 "ds_read_b64_tr_b16 %1, %8 offset:%10\n\t"
                 "ds_read_b64_tr_b16 %2, %8 offset:%11\n\t"
                 "ds_read_b64_tr_b16 %3, %8 offset:%12\n\t"
                 "ds_read_b64_tr_b16 %4, %8 offset:%13\n\t"
                 "ds_read_b64_tr_b16 %5, %8 offset:%14\n\t"
                 "ds_read_b64_tr_b16 %6, %8 offset:%15\n\t"
                 "ds_read_b64_tr_b16 %7, %8 offset:%16\n\t"
                 "s_waitcnt lgkmcnt(0)"
                 : "=&v"(l0), "=&v"(h0), "=&v"(l1), "=&v"(h1), "=&v"(l2), "=&v"(h2), "=&v"(l3), "=&v"(h3)
                 : "v"(vb), "i"(v_rd_off(D0, 0, 0)), "i"(v_rd_off(D0, 0, 1)), "i"(v_rd_off(D0, 1, 0)), "i"(v_rd_off(D0, 1, 1)),
                   "i"(v_rd_off(D0, 2, 0)), "i"(v_rd_off(D0, 2, 1)), "i"(v_rd_off(D0, 3, 0)), "i"(v_rd_off(D0, 3, 1))
                 : "memory");
    SBAR();
#define PK(L, H) (bf16x8){L[0], L[1], L[2], L[3], H[0], H[1], H[2], H[3]}
    od = __builtin_amdgcn_mfma_f32_32x32x16_bf16(pa0, PK(l0, h0), od, 0, 0, 0);
    od = __builtin_amdgcn_mfma_f32_32x32x16_bf16(pa1, PK(l1, h1), od, 0, 0, 0);
    od = __builtin_amdgcn_mfma_f32_32x32x16_bf16(pa2, PK(l2, h2), od, 0, 0, 0);
    od = __builtin_amdgcn_mfma_f32_32x32x16_bf16(pa3, PK(l3, h3), od, 0, 0, 0);
#undef PK
}
__device__ __forceinline__ float softplus_(float z) { return fmaxf(z, 0.f) + __logf(1.0f + __expf(-fabsf(z))); }

__device__ void attn_unit(const Params& P, int unit, LAS unsigned char* lds) {
    const int qb = unit & 7, h = (unit >> 3) & 7, b = unit >> 6;
    const int tid = threadIdx.x, wid = tid >> 6, lane = tid & 63, r32 = lane & 31, hi = lane >> 5;
    const int q0 = qb * 256; const size_t tokbase = (size_t)b * SEQ;
    LAS unsigned char* K_lds = lds; LAS unsigned char* V_lds = lds + 16384; volatile LAS int* flags = (volatile LAS int*)(lds + LDS_FLAGS);
    const int tq = q0 + wid * 32 + r32;
    bf16x8 qr[8];
    {
        const bf16_t* qp = P.zq + (tokbase + tq) * 3072 + h * HD + hi * 8;
        u32x4 raw[8]; float ss = 0.f;
#pragma unroll
        for (int d0 = 0; d0 < 8; ++d0) { raw[d0] = *(const u32x4*)(qp + d0 * 16);
            const float a0 = bf_lo(raw[d0].x), a1 = bf_hi(raw[d0].x), a2 = bf_lo(raw[d0].y), a3 = bf_hi(raw[d0].y), a4 = bf_lo(raw[d0].z), a5 = bf_hi(raw[d0].z), a6 = bf_lo(raw[d0].w), a7 = bf_hi(raw[d0].w);
            ss += a0 * a0 + a1 * a1 + a2 * a2 + a3 * a3 + a4 * a4 + a5 * a5 + a6 * a6 + a7 * a7; }
        ss += __shfl_xor(ss, 32);
        const float rq = rsqrtf(ss * (1.0f / HD) + EPS) * 0.088388347648318440f;
#pragma unroll
        for (int d0 = 0; d0 < 8; ++d0) { const float* gq = P.q_norm + d0 * 16 + hi * 8; const f32x4 g0 = *(const f32x4*)gq, g1 = *(const f32x4*)(gq + 4);
            u32x4 w;
            w.x = cvt_pk_bf16(bf_lo(raw[d0].x) * rq * g0[0], bf_hi(raw[d0].x) * rq * g0[1]); w.y = cvt_pk_bf16(bf_lo(raw[d0].y) * rq * g0[2], bf_hi(raw[d0].y) * rq * g0[3]);
            w.z = cvt_pk_bf16(bf_lo(raw[d0].z) * rq * g1[0], bf_hi(raw[d0].z) * rq * g1[1]); w.w = cvt_pk_bf16(bf_lo(raw[d0].w) * rq * g1[2], bf_hi(raw[d0].w) * rq * g1[3]);
            qr[d0] = *(bf16x8*)&w; }
    }
    const int sr = tid >> 4, sc = (tid & 15) * 8, vst0 = v_st(sr, sc), vst1 = v_st(32 + sr, sc);
    const int vb0 = (int)(unsigned)(uintptr_t)V_lds + v_rd_base(lane);
    const f32x4 gk0 = *(const f32x4*)(P.k_norm + sc), gk1 = *(const f32x4*)(P.k_norm + sc + 4);
    f32x16 o[4]; o[0] = f32x16{}; o[1] = f32x16{}; o[2] = f32x16{}; o[3] = f32x16{};
    float Rc = 0.f; bool done = false;
    const int tw_max = q0 + wid * 32 + 31;
    if (tid < 8) flags[tid] = 0;
    for (int kt = (q0 >> 6) + 3; kt >= 0; --kt) {
        {
            const bf16_t* kp0 = P.zq + (tokbase + kt * 64 + sr) * 3072 + 1024 + h * HD + sc; const bf16_t* kp1 = kp0 + (size_t)32 * 3072;
            const u32x4 k0 = *(const u32x4*)kp0, k1 = *(const u32x4*)kp1, v0 = *(const u32x4*)(kp0 + 1024), v1 = *(const u32x4*)(kp1 + 1024);
            float s0 = bf_lo(k0.x) * bf_lo(k0.x) + bf_hi(k0.x) * bf_hi(k0.x) + bf_lo(k0.y) * bf_lo(k0.y) + bf_hi(k0.y) * bf_hi(k0.y) + bf_lo(k0.z) * bf_lo(k0.z) + bf_hi(k0.z) * bf_hi(k0.z) + bf_lo(k0.w) * bf_lo(k0.w) + bf_hi(k0.w) * bf_hi(k0.w);
            float s1 = bf_lo(k1.x) * bf_lo(k1.x) + bf_hi(k1.x) * bf_hi(k1.x) + bf_lo(k1.y) * bf_lo(k1.y) + bf_hi(k1.y) * bf_hi(k1.y) + bf_lo(k1.z) * bf_lo(k1.z) + bf_hi(k1.z) * bf_hi(k1.z) + bf_lo(k1.w) * bf_lo(k1.w) + bf_hi(k1.w) * bf_hi(k1.w);
#pragma unroll
            for (int o_ = 8; o_ >= 1; o_ >>= 1) { s0 += __shfl_xor(s0, o_); s1 += __shfl_xor(s1, o_); }
            const float r0 = rsqrtf(s0 * (1.0f / HD) + EPS), r1 = rsqrtf(s1 * (1.0f / HD) + EPS);
            u32x4 w0, w1;
            w0.x = cvt_pk_bf16(bf_lo(k0.x) * r0 * gk0[0], bf_hi(k0.x) * r0 * gk0[1]); w0.y = cvt_pk_bf16(bf_lo(k0.y) * r0 * gk0[2], bf_hi(k0.y) * r0 * gk0[3]);
            w0.z = cvt_pk_bf16(bf_lo(k0.z) * r0 * gk1[0], bf_hi(k0.z) * r0 * gk1[1]); w0.w = cvt_pk_bf16(bf_lo(k0.w) * r0 * gk1[2], bf_hi(k0.w) * r0 * gk1[3]);
            w1.x = cvt_pk_bf16(bf_lo(k1.x) * r1 * gk0[0], bf_hi(k1.x) * r1 * gk0[1]); w1.y = cvt_pk_bf16(bf_lo(k1.y) * r1 * gk0[2], bf_hi(k1.y) * r1 * gk0[3]);
            w1.z = cvt_pk_bf16(bf_lo(k1.z) * r1 * gk1[0], bf_hi(k1.z) * r1 * gk1[1]); w1.w = cvt_pk_bf16(bf_lo(k1.w) * r1 * gk1[2], bf_hi(k1.w) * r1 * gk1[3]);
            *(LAS u32x4*)(K_lds + KSWZ(sr, sc * 2)) = w0; *(LAS u32x4*)(K_lds + KSWZ(32 + sr, sc * 2)) = w1;
            *(LAS u32x4*)(V_lds + vst0) = v0; *(LAS u32x4*)(V_lds + vst1) = v1;
        }
        __syncthreads();
        if (!done && kt * 64 < tw_max) {
            f32x16 p0, p1; qkt(p0, p1, K_lds, qr, r32, hi);
            const int kb = kt * 64;
            float gs[8], pg[8], lz[32];
#pragma unroll
            for (int hf = 0; hf < 2; ++hf)
#pragma unroll
                for (int g = 0; g < 4; ++g) { float s = 0.f;
#pragma unroll
                    for (int i = 0; i < 4; ++i) { const int r = 4 * g + i; const float z = hf ? p1[r] : p0[r]; const bool causal = (kb + 32 * hf + crow(r, hi)) < tq;
                        const float spv = softplus_(z); lz[hf * 16 + r] = causal ? (z - spv) : -1e30f; const float spm = causal ? spv : 0.f;
                        if (hf) p1[r] = spm; else p0[r] = spm; s += spm; }
                    gs[hf * 4 + g] = s; }
#pragma unroll
            for (int i = 0; i < 8; ++i) pg[i] = __shfl_xor(gs[i], 32);
            float suf = 0.f;
            float aft[8];
#pragma unroll
            for (int i = 7; i >= 0; --i) { aft[i] = Rc + suf + (hi == 0 ? pg[i] : 0.f); suf += gs[i] + pg[i]; }
            Rc += suf;
#pragma unroll
            for (int hf = 0; hf < 2; ++hf)
#pragma unroll
                for (int g = 0; g < 4; ++g) { float a = aft[hf * 4 + g];
#pragma unroll
                    for (int i = 3; i >= 0; --i) { const int r = 4 * g + i; const float spm = hf ? p1[r] : p0[r]; const float wv = __expf(lz[hf * 16 + r] - a); a += spm;
                        if (hf) p1[r] = wv; else p0[r] = wv; } }
            bf16x8 pa0, pa1, pa2, pa3;
#define PK4(Pv, BASE, OUT) do { unsigned a0 = cvt_pk_bf16(Pv[BASE + 0], Pv[BASE + 1]), a1 = cvt_pk_bf16(Pv[BASE + 2], Pv[BASE + 3]);   \
    unsigned b0 = cvt_pk_bf16(Pv[BASE + 4], Pv[BASE + 5]), b1 = cvt_pk_bf16(Pv[BASE + 6], Pv[BASE + 7]);                              \
    auto r0 = __builtin_amdgcn_permlane32_swap(a0, b0, false, false); auto r1 = __builtin_amdgcn_permlane32_swap(a1, b1, false, false); \
    u32x4 w = {r0[0], r1[0], r0[1], r1[1]}; OUT = *reinterpret_cast<bf16x8*>(&w); } while (0)
            PK4(p0, 0, pa0); PK4(p0, 8, pa1); PK4(p1, 0, pa2); PK4(p1, 8, pa3);
#undef PK4
            SBAR();
            pv_one<0>(o[0], vb0, pa0, pa1, pa2, pa3); pv_one<1>(o[1], vb0, pa0, pa1, pa2, pa3); pv_one<2>(o[2], vb0, pa0, pa1, pa2, pa3); pv_one<3>(o[3], vb0, pa0, pa1, pa2, pa3);
            done = __all(Rc > 110.0f);
            if (done && lane == 0) flags[wid] = 1;
        }
        __syncthreads();
        int nd = 0;
#pragma unroll
        for (int w = 0; w < 8; ++w) nd += flags[w];
        if (nd == 8) break;
    }
    bf16_t* ob = P.mix + (tokbase + q0 + wid * 32) * 2048 + h * HD;
#pragma unroll
    for (int r = 0; r < 16; ++r) { const int orow = crow(r, hi);
#pragma unroll
        for (int d0 = 0; d0 < 4; ++d0) ob[(size_t)orow * 2048 + d0 * 32 + r32] = (bf16_t)(cvt_pk_bf16(o[d0][r], 0.f) & 0xffffu); }
    __syncthreads();
}

__device__ __forceinline__ float xhalf(float x, int hi) { const auto r = __builtin_amdgcn_permlane32_swap(__float_as_uint(x), __float_as_uint(x), false, false); return __uint_as_float(hi ? r[0] : r[1]); }
__device__ __forceinline__ float2 cmul(float2 a, float2 b) { return make_float2(a.x * b.x - a.y * b.y, a.x * b.y + a.y * b.x); }
__device__ __forceinline__ float2 cfma(float2 a, float2 x, float2 c) { return make_float2(a.x * x.x - a.y * x.y + c.x, a.x * x.y + a.y * x.x + c.y); }
template <bool OUT>
__device__ __forceinline__ void ssm_item(const Params& P, int item, LAS unsigned char* lds) {
    const int tid = threadIdx.x, wid = tid >> 6, lane = tid & 63, r32 = lane & 31, hi = lane >> 5, hh = lane & 15, kq = lane >> 4;
    const int g = item % NG, sc = (item / NG) % NSC, b = item / (NSC * NG);
    LAS unsigned* xs = (LAS unsigned*)(lds + wid * 8192);
    float2 a1[2], a2[2], a3[2], a4[2], cst[2]; bf16x8 bre[2], bim[2];
#pragma unroll
    for (int pb = 0; pb < 2; ++pb) { const int gp = g * NP + pb * 32 + r32;
        a1[pb] = P.abar[gp]; a2[pb] = cmul(a1[pb], a1[pb]); a3[pb] = cmul(a2[pb], a1[pb]); a4[pb] = cmul(a2[pb], a2[pb]);
        const float* bp = (const float*)(P.bbar + (size_t)gp * GH + 8 * hi); const f32x4 v0 = *(const f32x4*)bp, v1 = *(const f32x4*)(bp + 4), v2 = *(const f32x4*)(bp + 8), v3 = *(const f32x4*)(bp + 12);
        u32x4 wr_, wi_; wr_.x = cvt_pk_bf16(v0[0], v0[2]); wr_.y = cvt_pk_bf16(v1[0], v1[2]); wr_.z = cvt_pk_bf16(v2[0], v2[2]); wr_.w = cvt_pk_bf16(v3[0], v3[2]);
        wi_.x = cvt_pk_bf16(v0[1], v0[3]); wi_.y = cvt_pk_bf16(v1[1], v1[3]); wi_.z = cvt_pk_bf16(v2[1], v2[3]); wi_.w = cvt_pk_bf16(v3[1], v3[3]);
        bre[pb] = *(bf16x8*)&wr_; bim[pb] = *(bf16x8*)&wi_;
        cst[pb] = make_float2(0.f, 0.f);
        if (OUT) { const float2 aL = P.aL[gp]; const float2* ep = P.Est + ((size_t)(b * NG + g) * NSC) * NP + pb * 32 + r32; float2 e[NSC - 1];
#pragma unroll
            for (int cc = 0; cc < NSC - 1; ++cc) e[cc] = ep[(size_t)cc * NP];
#pragma unroll
            for (int cc = 0; cc < NSC - 1; ++cc) if (cc < sc) cst[pb] = cfma(aL, cst[pb], e[cc]); } }
    bf16x8 cf[4], dfr; float dsk = 0.f;
    if (OUT) {
#pragma unroll
        for (int s_ = 0; s_ < 4; ++s_) { const size_t ci = ((size_t)g * GH + hh) * NP + 16 * s_ + 4 * kq; const f32x4 cr = *(const f32x4*)(P.c_re + ci), cim = *(const f32x4*)(P.c_im + ci);
            u32x4 w; w.x = cvt_pk_bf16(cr[0], -cim[0]); w.y = cvt_pk_bf16(cr[1], -cim[1]); w.z = cvt_pk_bf16(cr[2], -cim[2]); w.w = cvt_pk_bf16(cr[3], -cim[3]); cf[s_] = *(bf16x8*)&w; }
        dsk = P.ssm_d[g * GH + hh];
        float dv[8];
#pragma unroll
        for (int j = 0; j < 8; ++j) dv[j] = (8 * kq + j == hh) ? dsk : 0.f;
        u32x4 w; w.x = cvt_pk_bf16(dv[0], dv[1]); w.y = cvt_pk_bf16(dv[2], dv[3]); w.z = cvt_pk_bf16(dv[4], dv[5]); w.w = cvt_pk_bf16(dv[6], dv[7]); dfr = *(bf16x8*)&w;
    }
    const float* ubase = P.u + ((size_t)b * SEQ + sc * SCH) * 1024 + g * GH;
    f32x4 un0 = *(const f32x4*)(ubase + (size_t)r32 * 1024 + 8 * hi), un1 = *(const f32x4*)(ubase + (size_t)r32 * 1024 + 8 * hi + 4);
    for (int blk = 0; blk < SCH / 32; ++blk) {
        u32x4 aw; aw.x = cvt_pk_bf16(un0[0], un0[1]); aw.y = cvt_pk_bf16(un0[2], un0[3]); aw.z = cvt_pk_bf16(un1[0], un1[1]); aw.w = cvt_pk_bf16(un1[2], un1[3]);
        const bf16x8 Au = *(bf16x8*)&aw;
        if (blk + 1 < SCH / 32) { const float* up = ubase + (size_t)((blk + 1) * 32 + r32) * 1024 + 8 * hi; un0 = *(const f32x4*)up; un1 = *(const f32x4*)(up + 4); }
#pragma unroll
        for (int pb = 0; pb < 2; ++pb) {
            f32x16 dre = __builtin_amdgcn_mfma_f32_32x32x16_bf16(Au, bre[pb], f32x16{}, 0, 0, 0);
            f32x16 dim = __builtin_amdgcn_mfma_f32_32x32x16_bf16(Au, bim[pb], f32x16{}, 0, 0, 0);
#pragma unroll
            for (int q = 0; q < 4; ++q)
#pragma unroll
                for (int i = 1; i < 4; ++i) { const float2 x = cfma(a1[pb], make_float2(dre[4 * q + i - 1], dim[4 * q + i - 1]), make_float2(dre[4 * q + i], dim[4 * q + i])); dre[4 * q + i] = x.x; dim[4 * q + i] = x.y; }
            float2 cin[4]; float2 cc = cst[pb];
#pragma unroll
            for (int q = 0; q < 4; ++q) { const float2 le = make_float2(dre[4 * q + 3], dim[4 * q + 3]);
                const float2 e0 = cfma(a4[pb], cc, le);
                const float2 pe0 = make_float2(xhalf(e0.x, hi), xhalf(e0.y, hi));
                const float2 e1 = cfma(a4[pb], pe0, le);
                const float2 pe1 = make_float2(xhalf(e1.x, hi), xhalf(e1.y, hi));
                cin[q] = hi ? pe0 : cc; cc = hi ? e1 : pe1; }
            cst[pb] = cc;
            if (OUT) {
#pragma unroll
                for (int q = 0; q < 4; ++q) { const float2 f1 = cmul(a1[pb], cin[q]), f2 = cmul(a2[pb], cin[q]), f3 = cmul(a3[pb], cin[q]), f4 = cmul(a4[pb], cin[q]);
                    const float2 x0 = make_float2(dre[4 * q + 0] + f1.x, dim[4 * q + 0] + f1.y), x1 = make_float2(dre[4 * q + 1] + f2.x, dim[4 * q + 1] + f2.y);
                    const float2 x2 = make_float2(dre[4 * q + 2] + f3.x, dim[4 * q + 2] + f3.y), x3 = make_float2(dre[4 * q + 3] + f4.x, dim[4 * q + 3] + f4.y);
                    LAS unsigned* xp = xs + (8 * q + 4 * hi) * 64 + pb * 32 + r32;
                    xp[0] = cvt_pk_bf16(x0.x, x0.y); xp[64] = cvt_pk_bf16(x1.x, x1.y); xp[128] = cvt_pk_bf16(x2.x, x2.y); xp[192] = cvt_pk_bf16(x3.x, x3.y); }
            }
        }
        if (OUT) {
            asm volatile("s_waitcnt lgkmcnt(0)" ::: "memory");
#pragma unroll
            for (int th = 0; th < 2; ++th) {
                f32x4 yacc = (f32x4){0.f, 0.f, 0.f, 0.f};
#pragma unroll
                for (int s_ = 0; s_ < 4; ++s_) { const bf16x8 af = *(const LAS bf16x8*)((const LAS unsigned char*)xs + (th * 16 + hh) * 256 + s_ * 64 + kq * 16);
                    yacc = __builtin_amdgcn_mfma_f32_16x16x32_bf16(af, cf[s_], yacc, 0, 0, 0); }
                u32x4 uw;
                { const float* up = ubase + (size_t)(blk * 32 + th * 16 + hh) * 1024 + 8 * (kq & 1); const f32x4 y0 = *(const f32x4*)up, y1 = *(const f32x4*)(up + 4);
                    uw.x = cvt_pk_bf16(y0[0], y0[1]); uw.y = cvt_pk_bf16(y0[2], y0[3]); uw.z = cvt_pk_bf16(y1[0], y1[1]); uw.w = cvt_pk_bf16(y1[2], y1[3]); }
                yacc = __builtin_amdgcn_mfma_f32_16x16x32_bf16(*(bf16x8*)&uw, dfr, yacc, 0, 0, 0);
#pragma unroll
                for (int j = 0; j < 4; ++j) { const int t = blk * 32 + th * 16 + 4 * kq + j; const float yv = gelu_tanh(yacc[j]);
                    P.ybuf[((size_t)b * SEQ + sc * SCH + t) * 1024 + g * GH + hh] = (bf16_t)(cvt_pk_bf16(yv, 0.f) & 0xffffu); }
            }
            asm volatile("s_waitcnt lgkmcnt(0)" ::: "memory");
        }
    }
    if (!OUT) { if (hi == 0) {
#pragma unroll
        for (int pb = 0; pb < 2; ++pb) P.Est[((size_t)(b * NG + g) * NSC + sc) * NP + pb * 32 + r32] = cst[pb]; } }
}

__device__ void phase_mixnorm(const Params& P) {
    const int tid = threadIdx.x, wid = tid >> 6, lane = tid & 63, G = gridDim.x;
    for (int row = blockIdx.x * 8 + wid; row < T_; row += G * 8) {
        const bf16_t* mp = P.mix + (size_t)row * 2048; u32x4 v[4]; float ssa = 0.f, ssb = 0.f;
#pragma unroll
        for (int i = 0; i < 4; ++i) { v[i] = *(const u32x4*)(mp + lane * 8 + 512 * i);
            const float s = bf_lo(v[i].x) * bf_lo(v[i].x) + bf_hi(v[i].x) * bf_hi(v[i].x) + bf_lo(v[i].y) * bf_lo(v[i].y) + bf_hi(v[i].y) * bf_hi(v[i].y) + bf_lo(v[i].z) * bf_lo(v[i].z) + bf_hi(v[i].z) * bf_hi(v[i].z) + bf_lo(v[i].w) * bf_lo(v[i].w) + bf_hi(v[i].w) * bf_hi(v[i].w);
            if (i < 2) ssa += s; else ssb += s; }
        ssa = wave_sum(ssa); ssb = wave_sum(ssb);
        const float ra = rsqrtf(ssa * (1.0f / 1024) + EPS), rb = rsqrtf(ssb * (1.0f / 1024) + EPS);
#pragma unroll
        for (int i = 0; i < 4; ++i) { const float r = i < 2 ? ra : rb; u32x4 w;
            w.x = cvt_pk_bf16(bf_lo(v[i].x) * r, bf_hi(v[i].x) * r); w.y = cvt_pk_bf16(bf_lo(v[i].y) * r, bf_hi(v[i].y) * r);
            w.z = cvt_pk_bf16(bf_lo(v[i].z) * r, bf_hi(v[i].z) * r); w.w = cvt_pk_bf16(bf_lo(v[i].w) * r, bf_hi(v[i].w) * r);
            *(u32x4*)(P.R1 + (size_t)row * 2048 + lane * 8 + 512 * i) = w; }
    }
}

__device__ void phase_router(const Params& P, LAS unsigned char* lds) {
    const int tid = threadIdx.x, wid = tid >> 6, lane = tid & 63, r32 = lane & 31, kh = lane >> 5, G = gridDim.x;
    LAS float* part = (LAS float*)lds;
    LAS float* ssq = (LAS float*)(lds + 65536);
    LAS float* rinv = (LAS float*)(lds + 65536 + 1024);
    LAS int* lsel = (LAS int*)(lds + 65536 + 2048); LAS int* lrank = lsel + 32 * TOPK;
    for (int unit = blockIdx.x; unit < T_ / 32; unit += G) {
        const int tok0 = unit * 32;
        f32x16 acc0 = f32x16{}, acc1 = f32x16{}; float ss = 0.f;
        const float* ap = P.h1 + (size_t)(tok0 + r32) * DM + 256 * wid + 8 * kh;
        const bf16_t* bh = P.Wr_hi + (size_t)r32 * DM + 256 * wid + 8 * kh; const bf16_t* bl = P.Wr_lo + (size_t)r32 * DM + 256 * wid + 8 * kh;
#pragma unroll 4
        for (int s_ = 0; s_ < 16; ++s_) {
            const f32x4 x0 = *(const f32x4*)(ap + 16 * s_), x1 = *(const f32x4*)(ap + 16 * s_ + 4);
            ss += x0[0] * x0[0] + x0[1] * x0[1] + x0[2] * x0[2] + x0[3] * x0[3] + x1[0] * x1[0] + x1[1] * x1[1] + x1[2] * x1[2] + x1[3] * x1[3];
            u32x4 hw, lw;
            hw.x = cvt_pk_bf16(x0[0], x0[1]); hw.y = cvt_pk_bf16(x0[2], x0[3]); hw.z = cvt_pk_bf16(x1[0], x1[1]); hw.w = cvt_pk_bf16(x1[2], x1[3]);
            lw.x = cvt_pk_bf16(x0[0] - bf_lo(hw.x), x0[1] - bf_hi(hw.x)); lw.y = cvt_pk_bf16(x0[2] - bf_lo(hw.y), x0[3] - bf_hi(hw.y));
            lw.z = cvt_pk_bf16(x1[0] - bf_lo(hw.z), x1[1] - bf_hi(hw.z)); lw.w = cvt_pk_bf16(x1[2] - bf_lo(hw.w), x1[3] - bf_hi(hw.w));
            const bf16x8 Ah = *(bf16x8*)&hw, Al = *(bf16x8*)&lw;
            const bf16x8 Bh0 = *(const bf16x8*)(bh + 16 * s_), Bh1 = *(const bf16x8*)(bh + (size_t)32 * DM + 16 * s_);
            const bf16x8 Bl0 = *(const bf16x8*)(bl + 16 * s_), Bl1 = *(const bf16x8*)(bl + (size_t)32 * DM + 16 * s_);
            acc0 = __builtin_amdgcn_mfma_f32_32x32x16_bf16(Ah, Bh0, acc0, 0, 0, 0); acc1 = __builtin_amdgcn_mfma_f32_32x32x16_bf16(Ah, Bh1, acc1, 0, 0, 0);
            acc0 = __builtin_amdgcn_mfma_f32_32x32x16_bf16(Ah, Bl0, acc0, 0, 0, 0); acc1 = __builtin_amdgcn_mfma_f32_32x32x16_bf16(Ah, Bl1, acc1, 0, 0, 0);
            acc0 = __builtin_amdgcn_mfma_f32_32x32x16_bf16(Al, Bh0, acc0, 0, 0, 0); acc1 = __builtin_amdgcn_mfma_f32_32x32x16_bf16(Al, Bh1, acc1, 0, 0, 0);
        }
#pragma unroll
        for (int r = 0; r < 16; ++r) { const int tl = crow(r, kh); part[(wid * 32 + tl) * 64 + r32] = acc0[r]; part[(wid * 32 + tl) * 64 + 32 + r32] = acc1[r]; }
        ss += __shfl_xor(ss, 32); if (kh == 0) ssq[wid * 32 + r32] = ss;
        __syncthreads();
        if (tid < 32) { float sq = 0.f;
#pragma unroll
            for (int w = 0; w < 8; ++w) sq += ssq[w * 32 + tid];
            rinv[tid] = rsqrtf(sq * (1.0f / DM) + EPS); }
        __syncthreads();
        int selE[4]; float selG[4];
#pragma unroll
        for (int tt = 0; tt < 4; ++tt) { const int tl = 4 * wid + tt; float lg = 0.f;
#pragma unroll
            for (int w = 0; w < 8; ++w) lg += part[(w * 32 + tl) * 64 + lane];
            lg *= rinv[tl];
            const float score = 1.0f / (1.0f + expf(-lg)); float selv = score + P.router_bias[lane];
            int myE = 0; float myG = 0.f, gsum = 0.f;
#pragma unroll
            for (int j = 0; j < TOPK; ++j) { const float mx = wave_max(selv); const unsigned long long bal = __ballot(selv == mx); const int first = __builtin_amdgcn_readfirstlane((int)__builtin_ctzll(bal));
                const float gsel = __shfl(score, first); gsum += gsel; if (lane == j) { myE = first; myG = gsel; } if (lane == first) selv = -3.0e38f; }
            selE[tt] = myE; selG[tt] = myG / gsum * 2.5f;
            if (lane < TOPK) lsel[tl * TOPK + lane] = myE; }
        __syncthreads();
        if (wid == 0) { int cn = 0;
            for (int i = 0; i < 32 * TOPK; ++i) { const int se = lsel[i]; if (se == lane) { lrank[i] = cn; ++cn; } }
            P.cntw[unit * NE + lane] = cn; }
        __syncthreads();
        if (lane < TOPK) {
#pragma unroll
            for (int tt = 0; tt < 4; ++tt) { const int tl = 4 * wid + tt, tok = tok0 + tl;
                P.sel_e[tok * TOPK + lane] = selE[tt]; P.sel_pos[tok * TOPK + lane] = lrank[tl * TOPK + lane]; P.sel_gate[tok * TOPK + lane] = selG[tt]; } }
#pragma unroll
        for (int tt = 0; tt < 4; ++tt) { const int tl = 4 * wid + tt; const float r = rinv[tl]; const float* hp = P.h1 + (size_t)(tok0 + tl) * DM;
#pragma unroll
            for (int i = 0; i < 8; ++i) { const f32x4 v = *(const f32x4*)(hp + 4 * lane + 256 * i); const f32x4 gn = *(const f32x4*)(P.norm_ffn + 4 * lane + 256 * i); const f32x4 mv = v * r * gn;
                u32x2 w; w.x = cvt_pk_bf16(mv[0], mv[1]); w.y = cvt_pk_bf16(mv[2], mv[3]); *(u32x2*)(P.R1 + (size_t)(tok0 + tl) * DM + 4 * lane + 256 * i) = w; } }
        __syncthreads();
    }
}

constexpr int NU = T_ / 32;
__device__ __forceinline__ void moe_sum_units(const Params& P, LAS int* tmp, LAS int* out, int ulim) {
    const int e = threadIdx.x & 63, part = threadIdx.x >> 6; int sacc = 0;
#pragma unroll 8
    for (int i = 0; i < NU / 8; ++i) { const int v = part * (NU / 8) + i; const int cv = P.cntw[v * NE + e]; sacc += (v < ulim) ? cv : 0; }
    tmp[part * 64 + e] = sacc;
    __syncthreads();
    if (threadIdx.x < NE) { int tot = 0;
#pragma unroll
        for (int p = 0; p < 8; ++p) tot += tmp[p * 64 + threadIdx.x];
        out[threadIdx.x] = tot; }
    __syncthreads();
}
__device__ __forceinline__ void moe_sum_serial(const Params& P, LAS int* out, int ulim) {
    if (threadIdx.x < NE) { int sacc = 0;
        for (int v = 0; v < ulim; ++v) sacc += P.cntw[v * NE + threadIdx.x];
        out[threadIdx.x] = sacc; }
    __syncthreads();
}
__device__ int build_moe_tables(const Params& P, LAS unsigned char* lds) {
    LAS int* rt_e = (LAS int*)(lds + LDS_TAB); LAS int* rt_j = rt_e + 256; volatile LAS int* nrt = (volatile LAS int*)(rt_e + 512); LAS int* rt_n = rt_e + 640; LAS int* cnt_l = rt_e + 900;
    __syncthreads();
    moe_sum_serial(P, cnt_l, NU);
    if (threadIdx.x == 0) { int rt = 0;
        for (int e = 0; e < NE; ++e) { const int n = cnt_l[e]; const int ntile = (n + 255) >> 8; for (int j = 0; j < ntile && rt < 256; ++j) { rt_e[rt] = e; rt_j[rt] = j; rt_n[rt] = (n - j * 256) < 256 ? (n - j * 256) : 256; ++rt; } }
        *nrt = rt; }
    __syncthreads();
    return *nrt;
}
__device__ void moe_scatter(const Params& P, LAS unsigned char* lds) {
    LAS int* bs = (LAS int*)(lds + LDS_TAB + 2100);
    const int tid = threadIdx.x, G = gridDim.x;
    for (int u = blockIdx.x; u < NU; u += G) {
        __syncthreads();
        moe_sum_units(P, (LAS int*)lds, bs, u);
        if (tid < NE) P.basew[u * NE + tid] = bs[tid];
        if (tid < 32 * TOPK) { const int tok = u * 32 + tid / TOPK, k = tid % TOPK; const int e = P.sel_e[tok * TOPK + k], loc = P.sel_pos[tok * TOPK + k];
            __hip_atomic_store(&P.tok_of_row[(size_t)e * CAP + bs[e] + loc], tok, __ATOMIC_RELAXED, __HIP_MEMORY_SCOPE_AGENT); }
    }
}

__device__ void phase_combine(const Params& P, LAS unsigned char* lds) {
    const int tid = threadIdx.x, wid = tid >> 6, lane = tid & 63, G = gridDim.x;
    LAS int* rt0 = (LAS int*)(lds + LDS_TAB);
    LAS int* cnt_l = rt0 + 64;
    __syncthreads();
    moe_sum_serial(P, cnt_l, NU);
    if (tid == 0) { int rt = 0; for (int e = 0; e < NE; ++e) { rt0[e] = rt; rt += (cnt_l[e] + 255) >> 8; } }
    __syncthreads();
    for (int row = blockIdx.x * 8 + wid; row < T_; row += G * 8) {
        int crw = 0; float gte = 0.f;
        if (lane < TOPK) { const int e = P.sel_e[row * TOPK + lane]; crw = rt0[e] * 256 + P.basew[(row >> 5) * NE + e] + P.sel_pos[row * TOPK + lane]; gte = P.sel_gate[row * TOPK + lane]; }
        float hv[4][8]; float ss = 0.f;
#pragma unroll
        for (int i = 0; i < 4; ++i) { const size_t o = (size_t)row * DM + lane * 8 + 512 * i; const f32x4 a = *(const f32x4*)(P.h1 + o), b2 = *(const f32x4*)(P.h1 + o + 4);
            hv[i][0] = a[0]; hv[i][1] = a[1]; hv[i][2] = a[2]; hv[i][3] = a[3]; hv[i][4] = b2[0]; hv[i][5] = b2[1]; hv[i][6] = b2[2]; hv[i][7] = b2[3];
            const u32x4 sv = *(const u32x4*)(P.Ysh + o);
            hv[i][0] += bf_lo(sv.x); hv[i][1] += bf_hi(sv.x); hv[i][2] += bf_lo(sv.y); hv[i][3] += bf_hi(sv.y); hv[i][4] += bf_lo(sv.z); hv[i][5] += bf_hi(sv.z); hv[i][6] += bf_lo(sv.w); hv[i][7] += bf_hi(sv.w); }
#pragma unroll
        for (int k = 0; k < TOPK; ++k) { const int cr = __builtin_amdgcn_readlane(crw, k); const float gt = __uint_as_float((unsigned)__builtin_amdgcn_readlane((int)__float_as_uint(gte), k)); const bf16_t* yp = P.Y + (size_t)cr * DM + lane * 8;
#pragma unroll
            for (int i = 0; i < 4; ++i) { const u32x4 y = *(const u32x4*)(yp + 512 * i);
                hv[i][0] += gt * bf_lo(y.x); hv[i][1] += gt * bf_hi(y.x); hv[i][2] += gt * bf_lo(y.y); hv[i][3] += gt * bf_hi(y.y); hv[i][4] += gt * bf_lo(y.z); hv[i][5] += gt * bf_hi(y.z); hv[i][6] += gt * bf_lo(y.w); hv[i][7] += gt * bf_hi(y.w); } }
#pragma unroll
        for (int i = 0; i < 4; ++i)
#pragma unroll
            for (int j = 0; j < 8; ++j) ss += hv[i][j] * hv[i][j];
        ss = wave_sum(ss); const float r = rsqrtf(ss * (1.0f / DM) + EPS);
#pragma unroll
        for (int i = 0; i < 4; ++i) { const size_t o = (size_t)row * DM + lane * 8 + 512 * i;
            *(f32x4*)(P.h1 + o) = (f32x4){hv[i][0], hv[i][1], hv[i][2], hv[i][3]}; *(f32x4*)(P.h1 + o + 4) = (f32x4){hv[i][4], hv[i][5], hv[i][6], hv[i][7]};
            u32x4 w; w.x = cvt_pk_bf16(hv[i][0] * r, hv[i][1] * r); w.y = cvt_pk_bf16(hv[i][2] * r, hv[i][3] * r); w.z = cvt_pk_bf16(hv[i][4] * r, hv[i][5] * r); w.w = cvt_pk_bf16(hv[i][6] * r, hv[i][7] * r);
            *(u32x4*)(P.R1 + o) = w; }
    }
}

constexpr int NPHASE = 13;
__global__ void __launch_bounds__(512, 2) fwd(Params P) {
    extern __shared__ __attribute__((aligned(16))) unsigned char shm_raw[];
    LAS unsigned char* lds = (LAS unsigned char*)shm_raw;
    asm volatile("s_nop 0\n\ts_nop 0" ::: "memory");
    const int G = gridDim.x, c = blockIdx.x;
    for (int i = threadIdx.x; i < LDS_BYTES / 16; i += 512) ((LAS u32x4*)lds)[i] = (u32x4){0u, 0u, 0u, 0u};
    __syncthreads();
    XcdBarrier bar; bar.bar = P.bar; bar.x = 0; bar.st = (volatile LAS unsigned*)(lds + LDS_BARW);
    const int lo = (int)P.ph_lo, hi = (int)P.ph_hi;
    if (hi - lo > 1) bar = xcd_barrier_post(P.bar, (volatile LAS unsigned*)(lds + LDS_BARW));
#define RUN(k) (lo <= (k) && (k) < hi)
#define SEAM(k) do { if (lo <= (k) && (k) + 1 < hi) xcd_barrier(bar); } while (0)
    auto phase_fn_0 = [&]() {
    if (RUN(0)) phase_prologue(P, lds);
    };
    phase_fn_0();
#if REP_PHASE == 0
    xcd_barrier(bar); phase_fn_0();
#endif
    SEAM(0);
    auto phase_fn_1 = [&]() {
    if (RUN(1)) { pg8::StaticOrder S; S.init(T_, NZ, DM, G, c); pg8::Gemm g{P.R1, P.Wt_in, DM, nullptr}; EpiQKVU E{P.zq, P.u}; pg8::gemm_phase<EpiQKVU, pg8::StaticOrder, false>(lds, g, S, E); }
    };
    phase_fn_1();
#if REP_PHASE == 1
    xcd_barrier(bar); phase_fn_1();
#endif
    SEAM(1);
    auto phase_fn_2 = [&]() {
    if (RUN(2)) {
        for (int u = c; u < NB * NHEAD * 8; u += G) attn_unit(P, u, lds);
        for (int it = c * 8 + (threadIdx.x >> 6); it < NB * NG * NSC; it += G * 8) ssm_item<false>(P, it, lds);
    }
    };
    phase_fn_2();
#if REP_PHASE == 2
    xcd_barrier(bar); phase_fn_2();
#endif
    SEAM(2);
    auto phase_fn_3 = [&]() {
    if (RUN(3)) { for (int it = c * 8 + (threadIdx.x >> 6); it < NB * NG * NSC; it += G * 8) ssm_item<true>(P, it, lds); }
    };
    phase_fn_3();
#if REP_PHASE == 3
    xcd_barrier(bar); phase_fn_3();
#endif
    SEAM(3);
    auto phase_fn_4 = [&]() {
    if (RUN(4)) { pg8::StaticOrder S; S.init(T_, 1024, 1024, G, c); pg8::Gemm g{P.ybuf, P.Wt_glu, 1024, nullptr}; EpiGLU E{P.ybuf, P.mix}; pg8::gemm_phase<EpiGLU, pg8::StaticOrder, false>(lds, g, S, E); }
    };
    phase_fn_4();
#if REP_PHASE == 4
    xcd_barrier(bar); phase_fn_4();
#endif
    SEAM(4);
#if REP_PHASE == 100
    xcd_barrier(bar); xcd_barrier(bar); xcd_barrier(bar); xcd_barrier(bar);
#endif
    auto phase_fn_5 = [&]() {
    if (RUN(5)) phase_mixnorm(P);
    };
    phase_fn_5();
#if REP_PHASE == 5
    xcd_barrier(bar); phase_fn_5();
#endif
    SEAM(5);
    auto phase_fn_6 = [&]() {
    if (RUN(6)) { pg8::StaticOrder S; S.init(T_, DM, DM, G, c); pg8::Gemm g{P.R1, P.Wt_out, DM, nullptr}; EpiRes E{P.x, P.h1}; pg8::gemm_phase<EpiRes, pg8::StaticOrder, false>(lds, g, S, E); }
    };
    phase_fn_6();
#if REP_PHASE == 6
    xcd_barrier(bar); phase_fn_6();
#endif
    SEAM(6);
    auto phase_fn_7 = [&]() {
    if (RUN(7)) phase_router(P, lds);
    };
    phase_fn_7();
#if REP_PHASE == 7
    xcd_barrier(bar); if (blockIdx.x == 0 && threadIdx.x < NE) P.cnt[threadIdx.x * 64] = 0u; xcd_barrier(bar); phase_fn_7();
#endif
    SEAM(7);
    auto phase_fn_8 = [&]() {
    if (RUN(8)) { moe_scatter(P, lds); if (hi - lo > 1) xcd_barrier(bar);
        const int n_rt = build_moe_tables(P, lds);
        MoeSched S; S.G = G; S.c = c; S.n_rt = n_rt; S.NPN = 4; S.K = DM; S.down = false; S.rt_e = (const LAS int*)(lds + LDS_TAB); S.rt_j = S.rt_e + 256; S.rt_n = S.rt_e + 640;
        pg8::Gemm g{P.R1, P.Wt_egu, DM, P.tok_of_row}; EpiSwiGLU E{P.H, P.Hs};
        pg8::gemm_phase<EpiSwiGLU, MoeSched, true>(lds, g, S, E); }
    };
    phase_fn_8();
#if REP_PHASE == 8
    xcd_barrier(bar); phase_fn_8();
#endif
    SEAM(8);
    auto phase_fn_9 = [&]() {
    if (RUN(9)) { const int n_rt = build_moe_tables(P, lds);
        for (int j = (c >> 3) & 7; j > 0; --j) __builtin_amdgcn_s_sleep(37);
        MoeSched S; S.G = G; S.c = c; S.n_rt = n_rt; S.NPN = 8; S.K = DE; S.down = true; S.rt_e = (const LAS int*)(lds + LDS_TAB); S.rt_j = S.rt_e + 256; S.rt_n = S.rt_e + 640;
        pg8::Gemm g{P.H, P.Wt_ed, DE, nullptr}; EpiDown E{P.Y, P.Ysh};
        pg8::gemm_phase<EpiDown, MoeSched, false>(lds, g, S, E); }
    };
    phase_fn_9();
#if REP_PHASE == 9
    xcd_barrier(bar); phase_fn_9();
#endif
    SEAM(9);
    auto phase_fn_10 = [&]() {
    if (RUN(10)) phase_combine(P, lds);
    };
    phase_fn_10();
#if REP_PHASE == 10
    xcd_barrier(bar); phase_fn_10();
#endif
    SEAM(10);
    auto phase_fn_11 = [&]() {
    if (RUN(11)) { pg8::StaticOrder S; S.init(T_, DM, DPLE, G, c); pg8::Gemm g{P.pb, P.Wt_pp, DPLE, nullptr}; EpiBf16 E{P.proj, DM}; pg8::gemm_phase<EpiBf16, pg8::StaticOrder, false>(lds, g, S, E); }
    };
    phase_fn_11();
#if REP_PHASE == 11
    xcd_barrier(bar); phase_fn_11();
#endif
    SEAM(11);
    auto phase_fn_12 = [&]() {
    if (RUN(12)) { pg8::StaticOrder S; S.init(T_, DM, DM, G, c); pg8::Gemm g{P.R1, P.Wt_pg, DM, nullptr}; EpiPle E{P.out, P.proj, P.h1}; pg8::gemm_phase<EpiPle, pg8::StaticOrder, false>(lds, g, S, E); }
    };
    phase_fn_12();
#if REP_PHASE == 12
    xcd_barrier(bar); phase_fn_12();
#endif
#undef RUN
#undef SEAM
}

extern "C" void kernel_launch(void* const* d_in, const int* in_sizes, int n_in, void* d_out, int out_size, void* d_ws, size_t ws_size, hipStream_t stream) {
    static int grid = 0;
    size_t off = 0;
    auto take = [&](size_t bytes) { const size_t o = off; off += (bytes + 255) & ~(size_t)255; return o; };
    const size_t o_ctl = take(32768);
    const size_t o_Wt_in = take((size_t)4096 * 2048 * 2), o_Wt_glu = take((size_t)1024 * 1024 * 2), o_Wt_out = take((size_t)2048 * 2048 * 2), o_Wt_pg = take((size_t)2048 * 2048 * 2),
                 o_Wt_pp = take((size_t)2048 * 256 * 2), o_Wt_egu = take((size_t)(NE + 1) * 1024 * 2048 * 2), o_Wt_ed = take((size_t)(NE + 1) * 2048 * 512 * 2);
    const size_t o_R1 = take((size_t)(T_ + 1) * DM * 2), o_h1 = take((size_t)T_ * DM * 4), o_tok = take((size_t)NE * CAP * 4), o_sele = take((size_t)T_ * TOPK * 4), o_selp = take((size_t)T_ * TOPK * 4),
                 o_selg = take((size_t)T_ * TOPK * 4), o_cntw = take((size_t)(T_ / 32) * NE * 4), o_basew = take((size_t)(T_ / 32) * NE * 4), o_H = take((size_t)(65536 + T_) * DE * 2), o_Ysh = take((size_t)T_ * DM * 2), o_proj = take((size_t)T_ * DM * 2), o_pb = take((size_t)T_ * DPLE * 2),
                 o_abar = take((size_t)NG * NP * 8), o_aL = take((size_t)NG * NP * 8), o_bbar = take((size_t)NG * NP * GH * 8), o_wrh = take((size_t)NE * DM * 2), o_wrl = take((size_t)NE * DM * 2);
    const size_t o_Y = take((size_t)65536 * DM * 2);
    size_t off2 = o_Y; auto take2 = [&](size_t bytes) { const size_t o = off2; off2 += (bytes + 255) & ~(size_t)255; return o; };
    const size_t o_zq = take2((size_t)T_ * 3072 * 2), o_u = take2((size_t)T_ * 1024 * 4), o_mix = take2((size_t)T_ * 2048 * 2), o_y = take2((size_t)T_ * 1024 * 2), o_E = take2((size_t)NB * NG * NSC * NP * 8);
    const size_t ws_need = off > off2 ? off : off2;
    if (grid == 0) {
        if (n_in != 30 || in_sizes[0] != T_ * DM || out_size != T_ * DM || ws_size < ws_need) {
            fprintf(stderr, "kernel_launch: unexpected shapes: n_in %d in0 %d out %d ws %zu (need %zu); nothing launched\n", n_in, n_in > 0 ? in_sizes[0] : -1, out_size, ws_size, ws_need); grid = -1; return; }
        int dev = 0, cus = 0, per_cu = 0;
        if (hipGetDevice(&dev) != hipSuccess || hipDeviceGetAttribute(&cus, hipDeviceAttributeMultiprocessorCount, dev) != hipSuccess) { fprintf(stderr, "kernel_launch: device query failed\n"); grid = -1; return; }
        if (hipFuncSetAttribute((const void*)fwd, hipFuncAttributeMaxDynamicSharedMemorySize, LDS_BYTES) != hipSuccess) { fprintf(stderr, "kernel_launch: hipFuncSetAttribute failed\n"); grid = -1; return; }
        if (hipOccupancyMaxActiveBlocksPerMultiprocessor(&per_cu, (const void*)fwd, 512, LDS_BYTES) != hipSuccess || per_cu < 1) fprintf(stderr, "kernel_launch: note: occupancy query reports %d\n", per_cu);
        (void)hipGetLastError();
        grid = cus;
    }
    if (grid < 0) return;
    char* ws = (char*)d_ws;
    if (hipMemsetAsync(ws + o_ctl, 0, 32768, stream) != hipSuccess) { fprintf(stderr, "kernel_launch: memset failed\n"); return; }
    Params P; memset(&P, 0, sizeof(P));
    const float** inp = &P.x;
    for (int i = 0; i < 30; ++i) inp[i] = (const float*)d_in[i];
    P.out = (float*)d_out;
    P.bar = (unsigned*)(ws + o_ctl); P.cnt = (unsigned*)(ws + o_ctl + 16384);
    P.Wt_in = (bf16_t*)(ws + o_Wt_in); P.Wt_glu = (bf16_t*)(ws + o_Wt_glu); P.Wt_out = (bf16_t*)(ws + o_Wt_out); P.Wt_pg = (bf16_t*)(ws + o_Wt_pg); P.Wt_pp = (bf16_t*)(ws + o_Wt_pp);
    P.Wt_egu = (bf16_t*)(ws + o_Wt_egu); P.Wt_ed = (bf16_t*)(ws + o_Wt_ed);
    P.R1 = (bf16_t*)(ws + o_R1); P.zq = (bf16_t*)(ws + o_zq); P.mix = (bf16_t*)(ws + o_mix); P.ybuf = (bf16_t*)(ws + o_y);
    P.H = (bf16_t*)(ws + o_H); P.Hs = P.H + (size_t)65536 * DE; P.Y = (bf16_t*)(ws + o_Y); P.Ysh = (bf16_t*)(ws + o_Ysh); P.proj = (bf16_t*)(ws + o_proj); P.pb = (bf16_t*)(ws + o_pb);
    P.u = (float*)(ws + o_u); P.h1 = (float*)(ws + o_h1); P.sel_gate = (float*)(ws + o_selg);
    P.Est = (float2*)(ws + o_E); P.abar = (float2*)(ws + o_abar); P.aL = (float2*)(ws + o_aL); P.bbar = (float2*)(ws + o_bbar);
    P.tok_of_row = (int*)(ws + o_tok); P.sel_e = (int*)(ws + o_sele); P.sel_pos = (int*)(ws + o_selp); P.cntw = (int*)(ws + o_cntw); P.basew = (int*)(ws + o_basew); P.Wr_hi = (bf16_t*)(ws + o_wrh); P.Wr_lo = (bf16_t*)(ws + o_wrl);
#if MK_LAUNCHES == 1
    P.ph_lo = 0; P.ph_hi = NPHASE;
    hipLaunchKernelGGL(fwd, dim3(grid), dim3(512), LDS_BYTES, stream, P);
#else
    for (int k = 0; k < NPHASE; ++k) { P.ph_lo = k; P.ph_hi = k + 1; hipLaunchKernelGGL(fwd, dim3(grid), dim3(512), LDS_BYTES, stream, P); }
#endif
    const hipError_t le = hipPeekAtLastError();
    if (le != hipSuccess) fprintf(stderr, "kernel_launch: launch failed: %s\n", hipGetErrorName(le));
}
```

```cpp
#include <hip/hip_runtime.h>
#include <cstdio>
#include <cstdint>
#include <cstring>

#ifndef MK_LAUNCHES
#define MK_LAUNCHES 1
#endif

#ifndef REP_PHASE
#define REP_PHASE -1
#endif
#define LAS __attribute__((address_space(3)))
typedef unsigned short bf16_t;
typedef short bf16x8 __attribute__((ext_vector_type(8)));
typedef short s16x4 __attribute__((ext_vector_type(4)));
typedef float f32x4 __attribute__((ext_vector_type(4)));
typedef float f32x16 __attribute__((ext_vector_type(16)));
typedef unsigned u32x4 __attribute__((ext_vector_type(4)));
typedef unsigned u32x2 __attribute__((ext_vector_type(2)));

#define XB_TMO      128
#define XB_XCNT(j)  (256  + 64 * (j))
#define XB_XSUB(j)  (1280 + 64 * (j))
#define XB_XGEN(j)  (2304 + 64 * (j))
#define XB_TOP      3328
#define XB_TOPGEN   3392
#define XCD_BAR_WORDS 3456
#define XB_SPIN_CAP (1u << 18)

__device__ __forceinline__ unsigned xb_ld(unsigned* p)              { return __hip_atomic_load(p, __ATOMIC_RELAXED, __HIP_MEMORY_SCOPE_AGENT); }
__device__ __forceinline__ unsigned xb_add(unsigned* p, unsigned v) { return __hip_atomic_fetch_add(p, v, __ATOMIC_RELAXED, __HIP_MEMORY_SCOPE_AGENT); }
__device__ __forceinline__ unsigned xb_xcc_id() { return (unsigned)__builtin_amdgcn_s_getreg((3 << 11) | 20) & 0xFu; }
#define XB_SPIN(cond, bar) do { unsigned _sp = 0; while (cond) { __builtin_amdgcn_s_sleep(1); \
    if ((++_sp & 255u) == 0u) { if (xb_ld(&(bar)[XB_TMO])) break; if (_sp > XB_SPIN_CAP) { atomicAdd(&(bar)[XB_TMO], 1u); break; } } } } while (0)

struct XcdBarrier { unsigned* bar; unsigned x; volatile LAS unsigned* st; };

__device__ __forceinline__ XcdBarrier xcd_barrier_post(unsigned* bar, volatile LAS unsigned* st) {
    XcdBarrier b; b.bar = bar; b.x = xb_xcc_id(); b.st = st;
    if (threadIdx.x == 0) (void)xb_add(&bar[XB_XCNT(b.x)], 1u);
    return b;
}
__device__ __forceinline__ void xcd_barrier_complete(unsigned* bar, unsigned x, unsigned& nloc, unsigned& nx) {
    const unsigned G = gridDim.x * gridDim.y * gridDim.z;
    unsigned sum, cnt, mine, sp = 0u;
    for (;;) {
        sum = 0u; cnt = 0u; mine = 0u;
#pragma unroll
        for (unsigned j = 0; j < 16; ++j) { const unsigned c = xb_ld(&bar[XB_XCNT(j)]); sum += c; cnt += (c > 0u) ? 1u : 0u; mine = (j == x) ? c : mine; }
        if (sum == G) break;
        __builtin_amdgcn_s_sleep(1);
        if ((++sp & 255u) == 0u) { if (xb_ld(&bar[XB_TMO])) break; if (sp > XB_SPIN_CAP) { atomicAdd(&bar[XB_TMO], 1u); break; } }
    }
    nloc = mine > 0u ? mine : 1u; nx = cnt > 0u ? cnt : 1u;
}
__device__ __forceinline__ void xcd_barrier(const XcdBarrier& b) {
    asm volatile("s_waitcnt vmcnt(0)" ::: "memory");
    __syncthreads();
    if (threadIdx.x == 0) {
        unsigned* bar = b.bar;
        __builtin_amdgcn_s_waitcnt(0);
        unsigned nloc = b.st[0], nx = b.st[1];
        if (nloc == 0u) { xcd_barrier_complete(bar, b.x, nloc, nx); b.st[0] = nloc; b.st[1] = nx; }
        const unsigned old = xb_add(&bar[XB_XSUB(b.x)], 1u);
        const unsigned gen = old / nloc;
        if (old + 1u == (gen + 1u) * nloc) {
            __builtin_amdgcn_fence(__ATOMIC_RELEASE, "agent");
            asm volatile("s_waitcnt vmcnt(0)" ::: "memory");
            const unsigned og = xb_add(&bar[XB_TOP], 1u);
            const unsigned tg = og / nx;
            if (og + 1u == (tg + 1u) * nx) xb_add(&bar[XB_TOPGEN], 1u);
            else XB_SPIN(xb_ld(&bar[XB_TOPGEN]) == tg, bar);
            __builtin_amdgcn_fence(__ATOMIC_ACQUIRE, "agent");
            xb_add(&bar[XB_XGEN(b.x)], 1u);
            asm volatile("s_waitcnt vmcnt(0)" ::: "memory");
        } else {
            XB_SPIN(xb_ld(&bar[XB_XGEN(b.x)]) == gen, bar);
            __builtin_amdgcn_fence(__ATOMIC_ACQUIRE, "agent");
            asm volatile("s_waitcnt vmcnt(0)" ::: "memory");
        }
    }
    __syncthreads();
}

constexpr int T_ = 8192, DM = 2048, NZ = 4096, SEQ = 2048, NB = 4, NHEAD = 8, HD = 128;
constexpr int NG = 64, GH = 16, NP = 64, SCH = 256, NSC = SEQ / SCH;
constexpr int NE = 64, TOPK = 6, DE = 512, DPLE = 256, CAP = 8192;
constexpr int ZROW = T_;
constexpr float EPS = 1e-6f;

constexpr int LDS_STAGE = 131072;
constexpr int LDS_TAB = LDS_STAGE;
constexpr int LDS_BARW = LDS_STAGE + 4096;
constexpr int LDS_FLAGS = LDS_BARW + 16;
constexpr int LDS_BYTES = LDS_STAGE + 4096 + 256;

struct Params {
    const float *x, *p, *norm_mix, *w_in, *q_norm, *k_norm, *lam_re, *lam_im, *log_dt, *b_re, *b_im, *c_re, *c_im, *ssm_d, *w_glu,
                *attn_out_norm, *ssm_out_norm, *w_out, *norm_ffn, *w_router, *router_bias, *w_eg, *w_eu, *w_ed, *w_sg, *w_su, *w_sd,
                *norm_ple, *w_pg, *w_pp;
    float* out;
    unsigned* bar; unsigned* cnt;
    bf16_t *Wt_in, *Wt_glu, *Wt_out, *Wt_pg, *Wt_pp, *Wt_egu, *Wt_ed, *Wr_hi, *Wr_lo;
    bf16_t *R1, *zq, *mix, *ybuf, *H, *Hs, *Y, *Ysh, *proj, *pb;
    float *u, *h1, *sel_gate;
    float2 *Est, *abar, *aL, *bbar;
    int *tok_of_row, *sel_e, *sel_pos, *cntw, *basew;
    long long ph_lo, ph_hi;
};

typedef __bf16 bf16x2_t __attribute__((ext_vector_type(2)));
typedef float f32x2_t __attribute__((ext_vector_type(2)));
__device__ __forceinline__ unsigned cvt_pk_bf16(float lo, float hi) { const f32x2_t v = {lo, hi}; const bf16x2_t b = __builtin_convertvector(v, bf16x2_t); return __builtin_bit_cast(unsigned, b); }
__device__ __forceinline__ void mfma_operand_ready(bf16x8& a) { asm volatile("s_nop 7" : "+v"(a)); }
__device__ __forceinline__ void mfma_operand_ready(bf16x8& a, bf16x8& b) { asm volatile("s_nop 7" : "+v"(a), "+v"(b)); }
__device__ __forceinline__ float bf_lo(unsigned w) { return __uint_as_float(w << 16); }
__device__ __forceinline__ float bf_hi(unsigned w) { return __uint_as_float(w & 0xffff0000u); }
__device__ __forceinline__ float sigmoidf_(float v) { return 1.0f / (1.0f + __expf(-v)); }
__device__ __forceinline__ float wave_sum(float v) {
#pragma unroll
    for (int o = 32; o >= 1; o >>= 1) v += __shfl_xor(v, o);
    return v;
}
__device__ __forceinline__ float wave_max(float v) {
#pragma unroll
    for (int o = 32; o >= 1; o >>= 1) v = fmaxf(v, __shfl_xor(v, o));
    return v;
}
__device__ __forceinline__ float gelu_tanh(float v) {
    const float c = 0.7978845608028654f;
    const float in = c * (v + 0.044715f * v * v * v);
    const float e = __expf(2.0f * in);
    const float th = 1.0f - 2.0f / (1.0f + e);
    return 0.5f * v * (1.0f + th);
}

namespace pg8 {
constexpr int BM = 256, BK = 64, HALF = 128, HTB = HALF * BK * 2, STAGE_BYTES = 8 * HTB, NXCD = 8, WGM = 8;
__host__ __device__ __forceinline__ int lds_byte(int r, int c) { const int st = (r >> 4) * 2 + (c >> 5), rr = r & 15, cc = c & 31, ob = rr * 64 + cc * 2; return st * 1024 + (ob ^ (((ob >> 9) & 1) << 5)); }
__host__ __device__ __forceinline__ void stage_rc(int b, int& R, int& C) { const int st = b / 1024, sb = b % 1024, swz = sb ^ (((sb >> 9) & 1) << 5); R = (st >> 1) * 16 + swz / 64; C = (st & 1) * 32 + (swz % 64) / 2; }
__host__ __device__ __forceinline__ int perm32(int rho) { const int n = rho >> 4, i = rho & 15; return 8 * (i >> 2) + 4 * n + (i & 3); }

struct Unit { int pm, pn, kind, nrows, arow, brow, orow0, gofs; };
struct Gemm { const bf16_t* A; const bf16_t* Bt; int K; const int* gtab; };

struct StaticOrder {
    int nM, nN, nwg, G, c, K;
    __device__ void init(int M, int N, int K_, int G_, int c_) { nM = M / BM; nN = N / BM; nwg = nM * nN; G = G_; c = c_; K = K_; }
    __device__ __forceinline__ Unit next(int i) const {
        Unit u; const long L = (long)i * G + c; const bool valid = L < nwg;
        int wgid = valid ? (int)L : 0; { const int q = nwg / NXCD, r = nwg % NXCD, xcd = wgid % NXCD, off = wgid / NXCD; wgid = (xcd < r ? xcd * (q + 1) : r * (q + 1) + (xcd - r) * q) + off; }
        const int nig = WGM * nN, gid = wgid / nig, fm = gid * WGM, gsz = (nM - fm) < WGM ? (nM - fm) : WGM;
        u.pm = fm + ((wgid % nig) % gsz); u.pn = (wgid % nig) / gsz;
        u.arow = u.pm * BM; u.brow = u.pn * BM; u.gofs = -1; u.nrows = BM; u.kind = 0; u.orow0 = u.pm * BM;
        if (!valid) u.pm = -1;
        return u;
    }
};

template <class Epi, class Sched, bool GATHER>
__device__ __forceinline__ void gemm_phase(LAS unsigned char* lds, const Gemm g, const Sched& S, const Epi& E) {
    const int tid = threadIdx.x, wid = __builtin_amdgcn_readfirstlane(tid >> 6), lane = tid & 63, wr = wid >> 2, wc = wid & 3, fr = lane & 15, fq = lane >> 4;
    const int K = g.K, nt = K / BK;
    unsigned voffA[2], voffB[2];
#pragma unroll
    for (int i = 0; i < 2; ++i) { int R, C; stage_rc(tid * 16 + i * 8192, R, C); const int Rb = Epi::PERM ? ((R & ~31) + perm32(R & 31)) : R;
        voffA[i] = (unsigned)(R * K + C) * 2u; voffB[i] = (unsigned)(Rb * K + C) * 2u; }
    const size_t kstep = (size_t)(BK * 2);
    const size_t hstep = (size_t)HALF * K * 2;
    const unsigned ldsw = (unsigned)wid * 1024u;
    const int aoff = lds_byte(wr * 64 + fr, fq * 8), boff = lds_byte(wc * 32 + fr, fq * 8);
#define PG8_SA(b, h) (((b) * 2 + (h)) * HTB)
#define PG8_SB(b, h) ((4 + (b) * 2 + (h)) * HTB)
#define PG8_STAGE(bufoff, gbase, voff) do { _Pragma("unroll") for (int _i = 0; _i < 2; ++_i) \
        __builtin_amdgcn_global_load_lds((const unsigned*)((const char*)(gbase) + (voff)[_i]), (LAS unsigned*)(lds + (bufoff) + ldsw + _i * 8192), 16, 0, 0); } while (0)
#define PG8_LDA(dst, b, h) do { _Pragma("unroll") for (int m = 0; m < 4; ++m) _Pragma("unroll") for (int k = 0; k < 2; ++k) dst[m][k] = *(const LAS bf16x8*)(lds + PG8_SA(b, h) + aoff + m * 2048 + k * 1024); } while (0)
#define PG8_LDB(dst, b, h) do { _Pragma("unroll") for (int n = 0; n < 2; ++n) _Pragma("unroll") for (int k = 0; k < 2; ++k) dst[n][k] = *(const LAS bf16x8*)(lds + PG8_SB(b, h) + boff + n * 2048 + k * 1024); } while (0)
#define PG8_MMA(ai, bj, At, Bt) do { __builtin_amdgcn_s_setprio(1); _Pragma("unroll") for (int m = 0; m < 4; ++m) _Pragma("unroll") for (int n = 0; n < 2; ++n) _Pragma("unroll") for (int k = 0; k < 2; ++k) \
        acc[ai][bj][m][n] = __builtin_amdgcn_mfma_f32_16x16x32_bf16(Bt[n][k], At[m][k], acc[ai][bj][m][n], 0, 0, 0); __builtin_amdgcn_s_setprio(0); } while (0)
#define PG8_WAIT_V(n) asm volatile("s_waitcnt vmcnt(" #n ")" ::: "memory")
#define PG8_WAIT_L(n) asm volatile("s_waitcnt lgkmcnt(" #n ")" ::: "memory")
#define PG8_BAR __builtin_amdgcn_s_barrier()
#define PG8_SCHED __builtin_amdgcn_sched_barrier(0)
    Unit cur = S.next(0), nxt; int ui = 0;
    if (cur.pm < 0) return;
    f32x4 acc[2][2][4][2];
#pragma unroll
    for (int a = 0; a < 2; ++a)
#pragma unroll
        for (int b = 0; b < 2; ++b)
#pragma unroll
            for (int m = 0; m < 4; ++m)
#pragma unroll
                for (int n = 0; n < 2; ++n) acc[a][b][m][n] = (f32x4){0.f, 0.f, 0.f, 0.f};
    bf16x8 At[4][2], B0[2][2], B1[2][2];
    unsigned cvo0[2] = {0u, 0u}, cvo1[2] = {0u, 0u}, nvo0[2] = {0u, 0u}, nvo1[2] = {0u, 0u};
    auto load_vo = [&](const Unit& u, unsigned (&v0)[2], unsigned (&v1)[2]) {
#pragma unroll
        for (int i = 0; i < 2; ++i) { int R, C; stage_rc(tid * 16 + i * 8192, R, C);
            int r0 = R, r1 = HALF + R;
            int t0, t1;
            if (u.gofs >= 0) { t0 = (r0 < u.nrows) ? g.gtab[u.gofs + r0] : ZROW; t1 = (r1 < u.nrows) ? g.gtab[u.gofs + r1] : ZROW; }
            else { t0 = u.orow0 + r0; t1 = u.orow0 + r1; }
            v0[i] = (unsigned)t0 * (unsigned)(K * 2) + (unsigned)(C * 2); v1[i] = (unsigned)t1 * (unsigned)(K * 2) + (unsigned)(C * 2); }
    };
    const size_t rowb = (size_t)K * 2;
    const char* cA = (const char*)g.A + (GATHER ? 0 : (size_t)cur.arow * rowb); const char* cB = (const char*)g.Bt + (size_t)cur.brow * rowb;
    if (GATHER) load_vo(cur, cvo0, cvo1);
    if (GATHER) {
        PG8_STAGE(PG8_SB(0, 0), cB, voffB); PG8_STAGE(PG8_SA(0, 0), cA, cvo0); PG8_STAGE(PG8_SB(0, 1), cB + hstep, voffB); PG8_STAGE(PG8_SA(0, 1), cA, cvo1);
    } else {
        PG8_STAGE(PG8_SB(0, 0), cB, voffB); PG8_STAGE(PG8_SA(0, 0), cA, voffA); PG8_STAGE(PG8_SB(0, 1), cB + hstep, voffB); PG8_STAGE(PG8_SA(0, 1), cA + hstep, voffA);
    }
    if (wr == 1) PG8_BAR;
    PG8_WAIT_V(4); PG8_BAR;
    if (GATHER) {
        PG8_STAGE(PG8_SB(1, 0), cB + kstep, voffB); PG8_STAGE(PG8_SA(1, 0), cA + kstep, cvo0); PG8_STAGE(PG8_SB(1, 1), cB + hstep + kstep, voffB);
    } else {
        PG8_STAGE(PG8_SB(1, 0), cB + kstep, voffB); PG8_STAGE(PG8_SA(1, 0), cA + kstep, voffA); PG8_STAGE(PG8_SB(1, 1), cB + hstep + kstep, voffB);
    }
    PG8_WAIT_V(6); PG8_BAR;
    for (;;) {
        nxt = S.next(ui + 1); const bool has_next = nxt.pm >= 0;
        const char* nA = GATHER ? cA : (has_next ? (const char*)g.A + (size_t)nxt.arow * rowb : cA); const char* nB = has_next ? (const char*)g.Bt + (size_t)nxt.brow * rowb : cB;
        if (GATHER) { if (has_next) load_vo(nxt, nvo0, nvo1); else { nvo0[0] = cvo0[0]; nvo0[1] = cvo0[1]; nvo1[0] = cvo1[0]; nvo1[1] = cvo1[1]; } }
        for (int t = 0; t < nt; t += 2) {
            const bool last = (t == nt - 2);
            const char* a1 = cA + (size_t)(t + 1) * kstep;
            const char* a2 = last ? nA : cA + (size_t)(t + 2) * kstep; const char* b2 = last ? nB : cB + (size_t)(t + 2) * kstep;
            const char* a3 = a2 + kstep; const char* b3 = b2 + kstep;
            unsigned s0[2], s1[2];
            if (GATHER) { s0[0] = last ? nvo0[0] : cvo0[0]; s0[1] = last ? nvo0[1] : cvo0[1]; s1[0] = last ? nvo1[0] : cvo1[0]; s1[1] = last ? nvo1[1] : cvo1[1]; }
            PG8_LDB(B0, 0, 0); PG8_SCHED; PG8_LDA(At, 0, 0);
            if (GATHER) PG8_STAGE(PG8_SA(1, 1), a1, cvo1); else PG8_STAGE(PG8_SA(1, 1), a1 + hstep, voffA);
            PG8_WAIT_L(8); PG8_BAR; PG8_WAIT_L(0); PG8_MMA(0, 0, At, B0); PG8_BAR; PG8_SCHED;
            PG8_LDB(B1, 0, 1); PG8_STAGE(PG8_SB(0, 0), b2, voffB);
            PG8_BAR; PG8_WAIT_L(0); PG8_MMA(0, 1, At, B1); PG8_BAR;
            PG8_LDA(At, 0, 1);
            if (GATHER) PG8_STAGE(PG8_SA(0, 0), a2, s0); else PG8_STAGE(PG8_SA(0, 0), a2, voffA);
            PG8_BAR; PG8_WAIT_L(0); PG8_MMA(1, 0, At, B0); PG8_BAR; PG8_SCHED;
            PG8_STAGE(PG8_SB(0, 1), b2 + hstep, voffB);
            PG8_WAIT_V(6); PG8_BAR; PG8_MMA(1, 1, At, B1); PG8_BAR;
            PG8_LDB(B0, 1, 0); PG8_SCHED; PG8_LDA(At, 1, 0);
            if (GATHER) PG8_STAGE(PG8_SA(0, 1), a2, s1); else PG8_STAGE(PG8_SA(0, 1), a2 + hstep, voffA);
            PG8_WAIT_L(8); PG8_BAR; PG8_WAIT_L(0); PG8_MMA(0, 0, At, B0); PG8_BAR; PG8_SCHED;
            PG8_LDB(B1, 1, 1); PG8_STAGE(PG8_SB(1, 0), b3, voffB);
            PG8_BAR; PG8_WAIT_L(0); PG8_MMA(0, 1, At, B1); PG8_BAR;
            PG8_LDA(At, 1, 1);
            if (GATHER) PG8_STAGE(PG8_SA(1, 0), a3, s0); else PG8_STAGE(PG8_SA(1, 0), a3, voffA);
            PG8_BAR; PG8_WAIT_L(0); PG8_MMA(1, 0, At, B0); PG8_BAR; PG8_SCHED;
            PG8_STAGE(PG8_SB(1, 1), b3 + hstep, voffB);
            PG8_WAIT_V(6); PG8_BAR; PG8_MMA(1, 1, At, B1); PG8_BAR;
        }
        E(acc, cur, wr, wc, fr, fq);
        if (!has_next) break;
#pragma unroll
        for (int a = 0; a < 2; ++a)
#pragma unroll
            for (int b = 0; b < 2; ++b)
#pragma unroll
                for (int m = 0; m < 4; ++m)
#pragma unroll
                    for (int n = 0; n < 2; ++n) acc[a][b][m][n] = (f32x4){0.f, 0.f, 0.f, 0.f};
        cur = nxt; cA = nA; cB = nB; ++ui;
        if (GATHER) { cvo0[0] = nvo0[0]; cvo0[1] = nvo0[1]; cvo1[0] = nvo1[0]; cvo1[1] = nvo1[1]; }
    }
    PG8_WAIT_V(0);
    if (wr == 0) PG8_BAR;
    PG8_BAR;
#undef PG8_SA
#undef PG8_SB
#undef PG8_STAGE
#undef PG8_LDA
#undef PG8_LDB
#undef PG8_MMA
#undef PG8_WAIT_V
#undef PG8_WAIT_L
#undef PG8_BAR
#undef PG8_SCHED
}
}
using pg8::Unit;

typedef f32x4 Acc[2][2][4][2];

template <int O0, int O1, int O2, int O3>
__device__ __forceinline__ void ld4x16(const void* p, f32x4& a, f32x4& b, f32x4& c, f32x4& d) {
    asm volatile("global_load_dwordx4 %0, %4, off offset:%5\n\tglobal_load_dwordx4 %1, %4, off offset:%6\n\tglobal_load_dwordx4 %2, %4, off offset:%7\n\tglobal_load_dwordx4 %3, %4, off offset:%8\n\ts_waitcnt vmcnt(0)"
                 : "=&v"(a), "=&v"(b), "=&v"(c), "=&v"(d) : "v"(p), "i"(O0), "i"(O1), "i"(O2), "i"(O3) : "memory");
}
template <int O0, int O1, int O2, int O3>
__device__ __forceinline__ void ld4x16_4x8(const void* p, f32x4& a, f32x4& b, f32x4& c, f32x4& d, const void* q, u32x2& e, u32x2& f, u32x2& g, u32x2& h) {
    asm volatile("global_load_dwordx4 %0, %8, off offset:%10\n\tglobal_load_dwordx4 %1, %8, off offset:%11\n\tglobal_load_dwordx4 %2, %8, off offset:%12\n\tglobal_load_dwordx4 %3, %8, off offset:%13\n\t"
                 "global_load_dwordx2 %4, %9, off offset:%14\n\tglobal_load_dwordx2 %5, %9, off offset:%15\n\tglobal_load_dwordx2 %6, %9, off offset:%16\n\tglobal_load_dwordx2 %7, %9, off offset:%17\n\ts_waitcnt vmcnt(0)"
                 : "=&v"(a), "=&v"(b), "=&v"(c), "=&v"(d), "=&v"(e), "=&v"(f), "=&v"(g), "=&v"(h)
                 : "v"(p), "v"(q), "i"(O0), "i"(O1), "i"(O2), "i"(O3), "i"(O0 / 2), "i"(O1 / 2), "i"(O2 / 2), "i"(O3 / 2) : "memory");
}
struct EpiQKVU {
    static constexpr bool PERM = true;
    bf16_t* zq; float* u;
    __device__ __forceinline__ void operator()(const Acc& acc, const Unit& un, int wr, int wc, int fr, int fq) const {
        const int row0 = un.pm * 256 + wr * 64 + fr, col0 = un.pn * 256 + wc * 32 + 8 * fq;
        if (un.pn < 12) {
#pragma unroll
            for (int ai = 0; ai < 2; ++ai)
#pragma unroll
                for (int m = 0; m < 4; ++m) { bf16_t* rowp = zq + (size_t)(row0 + ai * 128 + m * 16) * 3072 + col0;
#pragma unroll
                    for (int bj = 0; bj < 2; ++bj) { const f32x4 v0 = acc[ai][bj][m][0], v1 = acc[ai][bj][m][1];
                        u32x4 w; w.x = cvt_pk_bf16(v0[0], v0[1]); w.y = cvt_pk_bf16(v0[2], v0[3]); w.z = cvt_pk_bf16(v1[0], v1[1]); w.w = cvt_pk_bf16(v1[2], v1[3]);
                        *(u32x4*)(rowp + bj * 128) = w; } }
        } else {
#pragma unroll
            for (int ai = 0; ai < 2; ++ai)
#pragma unroll
                for (int m = 0; m < 4; ++m) { float* rowp = u + (size_t)(row0 + ai * 128 + m * 16) * 1024 + (col0 - 3072);
#pragma unroll
                    for (int bj = 0; bj < 2; ++bj) { *(f32x4*)(rowp + bj * 128) = acc[ai][bj][m][0]; *(f32x4*)(rowp + bj * 128 + 4) = acc[ai][bj][m][1]; } }
        }
    }
};
struct EpiGLU {
    static constexpr bool PERM = true;
    const bf16_t* __restrict__ y; bf16_t* __restrict__ mix;
    __device__ __forceinline__ void operator()(const Acc& acc, const Unit& un, int wr, int wc, int fr, int fq) const {
        const int row0 = un.pm * 256 + wr * 64 + fr, col0 = un.pn * 256 + wc * 32 + 8 * fq;
#pragma unroll
        for (int ai = 0; ai < 2; ++ai)
#pragma unroll
            for (int m = 0; m < 4; ++m) { const size_t row = (size_t)(row0 + ai * 128 + m * 16);
#pragma unroll
                for (int bj = 0; bj < 2; ++bj) { const f32x4 v0 = acc[ai][bj][m][0], v1 = acc[ai][bj][m][1];
                    const u32x4 yv = *(const u32x4*)(y + row * 1024 + col0 + bj * 128);
                    u32x4 w;
                    w.x = cvt_pk_bf16(bf_lo(yv.x) * sigmoidf_(v0[0]), bf_hi(yv.x) * sigmoidf_(v0[1]));
                    w.y = cvt_pk_bf16(bf_lo(yv.y) * sigmoidf_(v0[2]), bf_hi(yv.y) * sigmoidf_(v0[3]));
                    w.z = cvt_pk_bf16(bf_lo(yv.z) * sigmoidf_(v1[0]), bf_hi(yv.z) * sigmoidf_(v1[1]));
                    w.w = cvt_pk_bf16(bf_lo(yv.w) * sigmoidf_(v1[2]), bf_hi(yv.w) * sigmoidf_(v1[3]));
                    *(u32x4*)(mix + row * 2048 + 1024 + col0 + bj * 128) = w; } }
    }
};
struct EpiRes {
    static constexpr bool PERM = false;
    const float* x; float* h1;
    __device__ __forceinline__ void operator()(const Acc& acc, const Unit& un, int wr, int wc, int fr, int fq) const {
        const int row0 = un.pm * 256 + wr * 64 + fr, col0 = un.pn * 256 + wc * 32 + 4 * fq;
#pragma unroll
        for (int ai = 0; ai < 2; ++ai)
#pragma unroll
            for (int m = 0; m < 4; ++m) { const size_t ro = (size_t)(row0 + ai * 128 + m * 16) * 2048 + col0;
                f32x4 x00, x01, x10, x11; ld4x16<0, 64, 512, 576>(x + ro, x00, x01, x10, x11);
                *(f32x4*)(h1 + ro) = x00 + acc[ai][0][m][0]; *(f32x4*)(h1 + ro + 16) = x01 + acc[ai][0][m][1];
                *(f32x4*)(h1 + ro + 128) = x10 + acc[ai][1][m][0]; *(f32x4*)(h1 + ro + 144) = x11 + acc[ai][1][m][1]; }
    }
};
struct EpiSwiGLU {
    static constexpr bool PERM = true;
    bf16_t* H; bf16_t* Hs;
    __device__ __forceinline__ void operator()(const Acc& acc, const Unit& un, int wr, int wc, int fr, int fq) const {
        bf16_t* base = un.kind ? Hs : H;
        const size_t row0 = (size_t)un.orow0 + wr * 64 + fr; const int col0 = un.pn * 128 + wc * 32 + 8 * fq;
#pragma unroll
        for (int ai = 0; ai < 2; ++ai)
#pragma unroll
            for (int m = 0; m < 4; ++m) { const f32x4 g0 = acc[ai][0][m][0], g1 = acc[ai][0][m][1], u0 = acc[ai][1][m][0], u1 = acc[ai][1][m][1];
                u32x4 w;
                w.x = cvt_pk_bf16(g0[0] * sigmoidf_(g0[0]) * u0[0], g0[1] * sigmoidf_(g0[1]) * u0[1]);
                w.y = cvt_pk_bf16(g0[2] * sigmoidf_(g0[2]) * u0[2], g0[3] * sigmoidf_(g0[3]) * u0[3]);
                w.z = cvt_pk_bf16(g1[0] * sigmoidf_(g1[0]) * u1[0], g1[1] * sigmoidf_(g1[1]) * u1[1]);
                w.w = cvt_pk_bf16(g1[2] * sigmoidf_(g1[2]) * u1[2], g1[3] * sigmoidf_(g1[3]) * u1[3]);
                *(u32x4*)(base + (row0 + ai * 128 + m * 16) * 512 + col0) = w; }
    }
};
struct EpiDown {
    static constexpr bool PERM = true;
    bf16_t* Y; bf16_t* Ysh;
    __device__ __forceinline__ void operator()(const Acc& acc, const Unit& un, int wr, int wc, int fr, int fq) const {
        const int col0 = un.pn * 256 + wc * 32 + 8 * fq; bf16_t* base = (un.kind ? Ysh : Y) + (size_t)un.orow0 * 2048 + col0;
#pragma unroll
        for (int ai = 0; ai < 2; ++ai)
#pragma unroll
            for (int m = 0; m < 4; ++m) { const int r = ai * 128 + wr * 64 + m * 16 + fr;
                if (r < un.nrows) { bf16_t* rowp = base + (size_t)r * 2048;
#pragma unroll
                    for (int bj = 0; bj < 2; ++bj) { const f32x4 v0 = acc[ai][bj][m][0], v1 = acc[ai][bj][m][1];
                        u32x4 w; w.x = cvt_pk_bf16(v0[0], v0[1]); w.y = cvt_pk_bf16(v0[2], v0[3]); w.z = cvt_pk_bf16(v1[0], v1[1]); w.w = cvt_pk_bf16(v1[2], v1[3]);
                        *(u32x4*)(rowp + bj * 128) = w; } } }
    }
};
struct EpiBf16 {
    static constexpr bool PERM = true;
    bf16_t* O; int ldo;
    __device__ __forceinline__ void operator()(const Acc& acc, const Unit& un, int wr, int wc, int fr, int fq) const {
        const int row0 = un.pm * 256 + wr * 64 + fr, col0 = un.pn * 256 + wc * 32 + 8 * fq;
#pragma unroll
        for (int ai = 0; ai < 2; ++ai)
#pragma unroll
            for (int m = 0; m < 4; ++m) { bf16_t* rowp = O + (size_t)(row0 + ai * 128 + m * 16) * ldo + col0;
#pragma unroll
                for (int bj = 0; bj < 2; ++bj) { const f32x4 v0 = acc[ai][bj][m][0], v1 = acc[ai][bj][m][1];
                    u32x4 w; w.x = cvt_pk_bf16(v0[0], v0[1]); w.y = cvt_pk_bf16(v0[2], v0[3]); w.z = cvt_pk_bf16(v1[0], v1[1]); w.w = cvt_pk_bf16(v1[2], v1[3]);
                    *(u32x4*)(rowp + bj * 128) = w; } }
    }
};
struct EpiPle {
    static constexpr bool PERM = false;
    float* out; const bf16_t* proj; const float* h2;
    __device__ __forceinline__ void operator()(const Acc& acc, const Unit& un, int wr, int wc, int fr, int fq) const {
        const int row0 = un.pm * 256 + wr * 64 + fr, col0 = un.pn * 256 + wc * 32 + 4 * fq;
#pragma unroll
        for (int ai = 0; ai < 2; ++ai)
#pragma unroll
            for (int m = 0; m < 4; ++m) { const size_t ro = (size_t)(row0 + ai * 128 + m * 16) * 2048 + col0;
                f32x4 hv[4]; u32x2 pv[4]; ld4x16_4x8<0, 64, 512, 576>(h2 + ro, hv[0], hv[1], hv[2], hv[3], proj + ro, pv[0], pv[1], pv[2], pv[3]);
#pragma unroll
                for (int q = 0; q < 4; ++q) { const int bj = q >> 1, n = q & 1; const f32x4 a = acc[ai][bj][m][n]; f32x4 r;
                    r[0] = hv[q][0] + sigmoidf_(a[0]) * bf_lo(pv[q].x); r[1] = hv[q][1] + sigmoidf_(a[1]) * bf_hi(pv[q].x);
                    r[2] = hv[q][2] + sigmoidf_(a[2]) * bf_lo(pv[q].y); r[3] = hv[q][3] + sigmoidf_(a[3]) * bf_hi(pv[q].y);
                    *(f32x4*)(out + ro + bj * 128 + n * 16) = r; } }
    }
};

struct MoeSched {
    int G, c, n_rt, NPN, K; bool down;
    const LAS int* rt_e; const LAS int* rt_j; const LAS int* rt_n;
    __device__ __forceinline__ Unit next(int i) const {
        Unit u; const int NRT = n_rt + 32, per = (NRT + 7) >> 3, SL = G >> 3, x = c & 7, s = c >> 3;
        const int q = i * SL + s, rl = q / NPN, rtg = x * per + rl;
        const bool valid = s < SL && rl < per && rtg < NRT, routed = valid && rtg < n_rt;
        const int rt = routed ? rtg : 0, spm = (valid && !routed) ? rtg - n_rt : 0;
        const int e = __builtin_amdgcn_readfirstlane(rt_e[rt]), j = __builtin_amdgcn_readfirstlane(rt_j[rt]);
        const int rem = __builtin_amdgcn_readfirstlane(rt_n[rt]);
        const int Lr = q % NPN;
        u.kind = routed ? 0 : 1;
        u.pn = Lr;
        u.pm = routed ? rt : spm;
        u.nrows = routed ? rem : 256;
        const int ee = routed ? e : NE;
        if (!down) {
            u.arow = 0; u.gofs = routed ? (e * CAP + j * 256) : -1;
            u.brow = ee * 1024 + u.pn * 256;
            u.orow0 = routed ? rt * 256 : spm * 256;
        } else {
            u.gofs = -1;
            u.arow = routed ? rt * 256 : 65536 + spm * 256;
            u.brow = ee * 2048 + u.pn * 256;
            u.orow0 = routed ? rt * 256 : spm * 256;
        }
        if (!valid) u.pm = -1;
        return u;
    }
};

__device__ __forceinline__ void cvt_tile(const float* __restrict__ src, int ldw, int k0, int n0, const float* __restrict__ gain, bf16_t* __restrict__ dst, int ldd, int dk0,
                                         int inter, int roff, LAS float* lt) {
    const int tid = threadIdx.x, c4 = tid & 63, r8 = tid >> 6;
    f32x4 v[8];
#pragma unroll
    for (int i = 0; i < 8; ++i) v[i] = *(const f32x4*)(src + (size_t)(k0 + r8 + 8 * i) * ldw + n0 + 4 * c4);
#pragma unroll
    for (int i = 0; i < 8; ++i) { const int k = r8 + 8 * i; const float gsc = gain ? gain[k0 + k] : 1.0f; LAS float* q = lt + k * 257 + 4 * c4;
        q[0] = v[i][0] * gsc; q[1] = v[i][1] * gsc; q[2] = v[i][2] * gsc; q[3] = v[i][3] * gsc; }
    __syncthreads();
#pragma unroll
    for (int i = 0; i < 4; ++i) { const int q = tid + 512 * i, kg = q & 7, n = q >> 3; const LAS float* s = lt + (8 * kg) * 257 + n;
        u32x4 w; w.x = cvt_pk_bf16(s[0], s[257]); w.y = cvt_pk_bf16(s[2 * 257], s[3 * 257]); w.z = cvt_pk_bf16(s[4 * 257], s[5 * 257]); w.w = cvt_pk_bf16(s[6 * 257], s[7 * 257]);
        const int ng = n0 + n; const int drow = inter ? ((ng >> 7) * 256 + roff + (ng & 127)) : ng;
        *(u32x4*)(dst + (size_t)drow * ldd + dk0 + k0 + 8 * kg) = w; }
    __syncthreads();
}
__device__ __forceinline__ void cvt_job(long& base, const float* src, int K, int N, const float* gain, bf16_t* dst, int ldd, int dk0, int inter, int roff, LAS float* lt) {
    const int nk = K / 64, nn = N / 256, ntl = nk * nn, G = gridDim.x;
    int t = (int)(((long)blockIdx.x - base % G + G) % G);
    for (; t < ntl; t += G) { const int kt = t % nk, ntile = t / nk; cvt_tile(src, N, kt * 64, ntile * 256, gain, dst, ldd, dk0, inter, roff, lt); }
    base += ntl;
}
__device__ void phase_prologue(const Params& P, LAS unsigned char* lds) {
    LAS float* lt = (LAS float*)lds;
    const int tid = threadIdx.x, wid = tid >> 6, lane = tid & 63, G = gridDim.x;
    for (int row = blockIdx.x * 8 + wid; row < T_; row += G * 8) {
        const float* xr = P.x + (size_t)row * DM; f32x4 v[8]; float ss = 0.f;
#pragma unroll
        for (int i = 0; i < 8; ++i) { v[i] = *(const f32x4*)(xr + 4 * lane + 256 * i); ss += v[i][0] * v[i][0] + v[i][1] * v[i][1] + v[i][2] * v[i][2] + v[i][3] * v[i][3]; }
        ss = wave_sum(ss); const float r = rsqrtf(ss * (1.0f / DM) + EPS);
#pragma unroll
        for (int i = 0; i < 8; ++i) { u32x2 w; w.x = cvt_pk_bf16(v[i][0] * r, v[i][1] * r); w.y = cvt_pk_bf16(v[i][2] * r, v[i][3] * r); *(u32x2*)(P.R1 + (size_t)row * DM + 4 * lane + 256 * i) = w; }
    }
    if (blockIdx.x == 0) { for (int i = tid; i < DM / 2; i += 512) ((unsigned*)(P.R1 + (size_t)ZROW * DM))[i] = 0u; }
    for (size_t i = (size_t)blockIdx.x * 512 + tid; i < (size_t)T_ * DPLE / 8; i += (size_t)G * 512) { const f32x4 a = *(const f32x4*)(P.p + i * 8), b2 = *(const f32x4*)(P.p + i * 8 + 4);
        u32x4 w; w.x = cvt_pk_bf16(a[0], a[1]); w.y = cvt_pk_bf16(a[2], a[3]); w.z = cvt_pk_bf16(b2[0], b2[1]); w.w = cvt_pk_bf16(b2[2], b2[3]); *(u32x4*)(P.pb + i * 8) = w; }
    for (int i = blockIdx.x * 512 + tid; i < NG * NP; i += G * 512) {
        const int g = i / NP;
        const float lr = P.lam_re[i], li = P.lam_im[i]; const float dt = expf(P.log_dt[g]);
        const double mag = exp((double)lr * (double)dt), ang = (double)li * (double)dt;
        const float ar = (float)(mag * cos(ang)), ai = (float)(mag * sin(ang));
        const double magL = exp((double)lr * (double)dt * SCH), angL = ang * SCH;
        P.abar[i] = make_float2(ar, ai); P.aL[i] = make_float2((float)(magL * cos(angL)), (float)(magL * sin(angL)));
        const float nr = ar - 1.0f, ni = ai, den = lr * lr + li * li;
        const float cr = (nr * lr + ni * li) / den, ci = (ni * lr - nr * li) / den;
#pragma unroll
        for (int h = 0; h < GH; ++h) { const float br = P.b_re[(size_t)i * GH + h], bi = P.b_im[(size_t)i * GH + h];
            P.bbar[(size_t)i * GH + h] = make_float2(cr * br - ci * bi, cr * bi + ci * br); }
    }
    for (int i = blockIdx.x * 512 + tid; i < NE * DM; i += G * 512) { const int e = i / DM, k = i % DM; const float w = P.w_router[(size_t)k * NE + e] * P.norm_ffn[k];
        const unsigned hw = cvt_pk_bf16(w, 0.f); const float hf = bf_lo(hw); P.Wr_hi[i] = (bf16_t)(hw & 0xffffu); P.Wr_lo[i] = (bf16_t)(cvt_pk_bf16(w - hf, 0.f) & 0xffffu); }
    long base = 0;
    cvt_job(base, P.w_in, 2048, 4096, P.norm_mix, P.Wt_in, 2048, 0, 0, 0, lt);
    cvt_job(base, P.w_glu, 1024, 1024, nullptr, P.Wt_glu, 1024, 0, 0, 0, lt);
    cvt_job(base, P.w_out, 1024, 2048, P.attn_out_norm, P.Wt_out, 2048, 0, 0, 0, lt);
    cvt_job(base, P.w_out + (size_t)1024 * 2048, 1024, 2048, P.ssm_out_norm, P.Wt_out, 2048, 1024, 0, 0, lt);
    cvt_job(base, P.w_sg, 2048, 512, nullptr, P.Wt_egu + (size_t)NE * 1024 * 2048, 2048, 0, 1, 0, lt);
    cvt_job(base, P.w_su, 2048, 512, nullptr, P.Wt_egu + (size_t)NE * 1024 * 2048, 2048, 0, 1, 128, lt);
    cvt_job(base, P.w_sd, 512, 2048, nullptr, P.Wt_ed + (size_t)NE * 2048 * 512, 512, 0, 0, 0, lt);
    cvt_job(base, P.w_pg, 2048, 2048, P.norm_ple, P.Wt_pg, 2048, 0, 0, 0, lt);
    cvt_job(base, P.w_pp, 256, 2048, nullptr, P.Wt_pp, 256, 0, 0, 0, lt);
    {
        const int ntl = NE * 192; int t = (int)(((long)blockIdx.x - base % G + G) % G);
        for (; t < ntl; t += G) { const int e = t / 192, r = t % 192;
            if (r < 128) { const int up = r >> 6, q = r & 63, kt = q & 31, ntile = q >> 5;
                cvt_tile((up ? P.w_eu : P.w_eg) + (size_t)e * 2048 * 512, 512, kt * 64, ntile * 256, nullptr, P.Wt_egu + (size_t)e * 1024 * 2048, 2048, 0, 1, up ? 128 : 0, lt); }
            else { const int q = r - 128, kt = q & 7, ntile = q >> 3;
                cvt_tile(P.w_ed + (size_t)e * 512 * 2048, 2048, kt * 64, ntile * 256, nullptr, P.Wt_ed + (size_t)e * 2048 * 512, 512, 0, 0, 0, lt); } }
    }
}

#define KSWZ(row, colB) ((row) * 256 + ((colB) ^ (((row) & 7) << 4)))
#define SBAR() __builtin_amdgcn_sched_barrier(0)
__device__ __forceinline__ int crow(int r, int hi) { return (r & 3) + 8 * (r >> 2) + 4 * hi; }
__device__ __forceinline__ void qkt(f32x16& p0, f32x16& p1, const LAS unsigned char* Ks, const bf16x8* qr, int r32, int hi) {
    p0 = f32x16{}; p1 = f32x16{};
#pragma unroll
    for (int d0 = 0; d0 < 8; ++d0) { const int cb = (d0 * 16 + hi * 8) * 2;
        const bf16x8 b0 = *(const LAS bf16x8*)(Ks + KSWZ(r32, cb));
        const bf16x8 b1 = *(const LAS bf16x8*)(Ks + KSWZ(32 + r32, cb));
        p0 = __builtin_amdgcn_mfma_f32_32x32x16_bf16(b0, qr[d0], p0, 0, 0, 0);
        p1 = __builtin_amdgcn_mfma_f32_32x32x16_bf16(b1, qr[d0], p1, 0, 0, 0); }
}
__device__ __forceinline__ int v_st(int k, int c) { const int kk = (k & ~0xC) | ((k & 4) << 1) | ((k & 8) >> 1); return ((kk >> 3) * 4 + (c >> 5)) * 512 + ((kk & 7) * 32 + (c & 31)) * 2; }
__device__ __forceinline__ int v_rd_base(int lane) { return ((lane & 3) << 3) | (((lane >> 2) & 3) << 6) | (((lane >> 4) & 1) << 5) | (((lane >> 5) & 1) << 8); }
constexpr int v_rd_off(int d0, int ks, int half) { return d0 * 512 + ks * 4096 + half * 2048; }
template <int D0> __device__ __forceinline__ void pv_one(f32x16& od, int vb, bf16x8 pa0, bf16x8 pa1, bf16x8 pa2, bf16x8 pa3) {
    s16x4 l0, h0, l1, h1, l2, h2, l3, h3;
    asm volatile("ds_read_b64_tr_b16 %0, %8 offset:%9\n\t"
                 "ds_read_b64_tr_b16 %1, %8 offset:%10\n\t"
                 "ds_read_b64_tr_b16 %2, %8 offset:%11\n\t"
                 "ds_read_b64_tr_b16 %3, %8 offset:%12\n\t"
                 "ds_read_b64_tr_b16 %4, %8 offset:%13\n\t"
                 "ds_read_b64_tr_b16 %5, %8 offset:%14\n\t"
                 "ds_read_b64_tr_b16 %6, %8 offset:%15\n\t"
                 "ds_read_b64_tr_b16 %7, %8 offset:%16\n\t"
                 "s_waitcnt lgkmcnt(0)"
                 : "=&v"(l0), "=&v"(h0), "=&v"(l1), "=&v"(h1), "=&v"(l2), "=&v"(h2), "=&v"(l3), "=&v"(h3)
                 : "v"(vb), "i"(v_rd_off(D0, 0, 0)), "i"(v_rd_off(D0, 0, 1)), "i"(v_rd_off(D0, 1, 0)), "i"(v_rd_off(D0, 1, 1)),
                   "i"(v_rd_off(D0, 2, 0)), "i"(v_rd_off(D0, 2, 1)), "i"(v_rd_off(D0, 3, 0)), "i"(v_rd_off(D0, 3, 1))
                 : "memory");
    SBAR();
#define PK(L, H) (bf16x8){L[0], L[1], L[2], L[3], H[0], H[1], H[2], H[3]}
    od = __builtin_amdgcn_mfma_f32_32x32x16_bf16(pa0, PK(l0, h0), od, 0, 0, 0);
    od = __builtin_amdgcn_mfma_f32_32x32x16_bf16(pa1, PK(l1, h1), od, 0, 0, 0);
    od = __builtin_amdgcn_mfma_f32_32x32x16_bf16(pa2, PK(l2, h2), od, 0, 0, 0);
    od = __builtin_amdgcn_mfma_f32_32x32x16_bf16(pa3, PK(l3, h3), od, 0, 0, 0);
#undef PK
}
__device__ __forceinline__ float softplus_(float z) { return fmaxf(z, 0.f) + __logf(1.0f + __expf(-fabsf(z))); }

__device__ void attn_unit(const Params& P, int unit, LAS unsigned char* lds) {
    const int qb = unit & 7, h = (unit >> 3) & 7, b = unit >> 6;
    const int tid = threadIdx.x, wid = tid >> 6, lane = tid & 63, r32 = lane & 31, hi = lane >> 5;
    const int q0 = qb * 256; const size_t tokbase = (size_t)b * SEQ;
    LAS unsigned char* K_lds = lds; LAS unsigned char* V_lds = lds + 16384; volatile LAS int* flags = (volatile LAS int*)(lds + LDS_FLAGS);
    const int tq = q0 + wid * 32 + r32;
    bf16x8 qr[8];
    {
        const bf16_t* qp = P.zq + (tokbase + tq) * 3072 + h * HD + hi * 8;
        u32x4 raw[8]; float ss = 0.f;
#pragma unroll
        for (int d0 = 0; d0 < 8; ++d0) { raw[d0] = *(const u32x4*)(qp + d0 * 16);
            const float a0 = bf_lo(raw[d0].x), a1 = bf_hi(raw[d0].x), a2 = bf_lo(raw[d0].y), a3 = bf_hi(raw[d0].y), a4 = bf_lo(raw[d0].z), a5 = bf_hi(raw[d0].z), a6 = bf_lo(raw[d0].w), a7 = bf_hi(raw[d0].w);
            ss += a0 * a0 + a1 * a1 + a2 * a2 + a3 * a3 + a4 * a4 + a5 * a5 + a6 * a6 + a7 * a7; }
        ss += __shfl_xor(ss, 32);
        const float rq = rsqrtf(ss * (1.0f / HD) + EPS) * 0.088388347648318440f;
#pragma unroll
        for (int d0 = 0; d0 < 8; ++d0) { const float* gq = P.q_norm + d0 * 16 + hi * 8; const f32x4 g0 = *(const f32x4*)gq, g1 = *(const f32x4*)(gq + 4);
            u32x4 w;
            w.x = cvt_pk_bf16(bf_lo(raw[d0].x) * rq * g0[0], bf_hi(raw[d0].x) * rq * g0[1]); w.y = cvt_pk_bf16(bf_lo(raw[d0].y) * rq * g0[2], bf_hi(raw[d0].y) * rq * g0[3]);
            w.z = cvt_pk_bf16(bf_lo(raw[d0].z) * rq * g1[0], bf_hi(raw[d0].z) * rq * g1[1]); w.w = cvt_pk_bf16(bf_lo(raw[d0].w) * rq * g1[2], bf_hi(raw[d0].w) * rq * g1[3]);
            qr[d0] = *(bf16x8*)&w; }
    }
    const int sr = tid >> 4, sc = (tid & 15) * 8, vst0 = v_st(sr, sc), vst1 = v_st(32 + sr, sc);
    const int vb0 = (int)(unsigned)(uintptr_t)V_lds + v_rd_base(lane);
    const f32x4 gk0 = *(const f32x4*)(P.k_norm + sc), gk1 = *(const f32x4*)(P.k_norm + sc + 4);
    f32x16 o[4]; o[0] = f32x16{}; o[1] = f32x16{}; o[2] = f32x16{}; o[3] = f32x16{};
    float Rc = 0.f; bool done = false;
    const int tw_max = q0 + wid * 32 + 31;
    if (tid < 8) flags[tid] = 0;
    for (int kt = (q0 >> 6) + 3; kt >= 0; --kt) {
        {
            const bf16_t* kp0 = P.zq + (tokbase + kt * 64 + sr) * 3072 + 1024 + h * HD + sc; const bf16_t* kp1 = kp0 + (size_t)32 * 3072;
            const u32x4 k0 = *(const u32x4*)kp0, k1 = *(const u32x4*)kp1, v0 = *(const u32x4*)(kp0 + 1024), v1 = *(const u32x4*)(kp1 + 1024);
            float s0 = bf_lo(k0.x) * bf_lo(k0.x) + bf_hi(k0.x) * bf_hi(k0.x) + bf_lo(k0.y) * bf_lo(k0.y) + bf_hi(k0.y) * bf_hi(k0.y) + bf_lo(k0.z) * bf_lo(k0.z) + bf_hi(k0.z) * bf_hi(k0.z) + bf_lo(k0.w) * bf_lo(k0.w) + bf_hi(k0.w) * bf_hi(k0.w);
            float s1 = bf_lo(k1.x) * bf_lo(k1.x) + bf_hi(k1.x) * bf_hi(k1.x) + bf_lo(k1.y) * bf_lo(k1.y) + bf_hi(k1.y) * bf_hi(k1.y) + bf_lo(k1.z) * bf_lo(k1.z) + bf_hi(k1.z) * bf_hi(k1.z) + bf_lo(k1.w) * bf_lo(k1.w) + bf_hi(k1.w) * bf_hi(k1.w);
#pragma unroll
            for (int o_ = 8; o_ >= 1; o_ >>= 1) { s0 += __shfl_xor(s0, o_); s1 += __shfl_xor(s1, o_); }
            const float r0 = rsqrtf(s0 * (1.0f / HD) + EPS), r1 = rsqrtf(s1 * (1.0f / HD) + EPS);
            u32x4 w0, w1;
            w0.x = cvt_pk_bf16(bf_lo(k0.x) * r0 * gk0[0], bf_hi(k0.x) * r0 * gk0[1]); w0.y = cvt_pk_bf16(bf_lo(k0.y) * r0 * gk0[2], bf_hi(k0.y) * r0 * gk0[3]);
            w0.z = cvt_pk_bf16(bf_lo(k0.z) * r0 * gk1[0], bf_hi(k0.z) * r0 * gk1[1]); w0.w = cvt_pk_bf16(bf_lo(k0.w) * r0 * gk1[2], bf_hi(k0.w) * r0 * gk1[3]);
            w1.x = cvt_pk_bf16(bf_lo(k1.x) * r1 * gk0[0], bf_hi(k1.x) * r1 * gk0[1]); w1.y = cvt_pk_bf16(bf_lo(k1.y) * r1 * gk0[2], bf_hi(k1.y) * r1 * gk0[3]);
            w1.z = cvt_pk_bf16(bf_lo(k1.z) * r1 * gk1[0], bf_hi(k1.z) * r1 * gk1[1]); w1.w = cvt_pk_bf16(bf_lo(k1.w) * r1 * gk1[2], bf_hi(k1.w) * r1 * gk1[3]);
            *(LAS u32x4*)(K_lds + KSWZ(sr, sc * 2)) = w0; *(LAS u32x4*)(K_lds + KSWZ(32 + sr, sc * 2)) = w1;
            *(LAS u32x4*)(V_lds + vst0) = v0; *(LAS u32x4*)(V_lds + vst1) = v1;
        }
        __syncthreads();
        if (!done && kt * 64 < tw_max) {
            f32x16 p0, p1; qkt(p0, p1, K_lds, qr, r32, hi);
            const int kb = kt * 64;
            float gs[8], pg[8], lz[32];
#pragma unroll
            for (int hf = 0; hf < 2; ++hf)
#pragma unroll
                for (int g = 0; g < 4; ++g) { float s = 0.f;
#pragma unroll
                    for (int i = 0; i < 4; ++i) { const int r = 4 * g + i; const float z = hf ? p1[r] : p0[r]; const bool causal = (kb + 32 * hf + crow(r, hi)) < tq;
                        const float spv = softplus_(z); lz[hf * 16 + r] = causal ? (z - spv) : -1e30f; const float spm = causal ? spv : 0.f;
                        if (hf) p1[r] = spm; else p0[r] = spm; s += spm; }
                    gs[hf * 4 + g] = s; }
#pragma unroll
            for (int i = 0; i < 8; ++i) pg[i] = __shfl_xor(gs[i], 32);
            float suf = 0.f;
            float aft[8];
#pragma unroll
            for (int i = 7; i >= 0; --i) { aft[i] = Rc + suf + (hi == 0 ? pg[i] : 0.f); suf += gs[i] + pg[i]; }
            Rc += suf;
#pragma unroll
            for (int hf = 0; hf < 2; ++hf)
#pragma unroll
                for (int g = 0; g < 4; ++g) { float a = aft[hf * 4 + g];
#pragma unroll
                    for (int i = 3; i >= 0; --i) { const int r = 4 * g + i; const float spm = hf ? p1[r] : p0[r]; const float wv = __expf(lz[hf * 16 + r] - a); a += spm;
                        if (hf) p1[r] = wv; else p0[r] = wv; } }
            bf16x8 pa0, pa1, pa2, pa3;
#define PK4(Pv, BASE, OUT) do { unsigned a0 = cvt_pk_bf16(Pv[BASE + 0], Pv[BASE + 1]), a1 = cvt_pk_bf16(Pv[BASE + 2], Pv[BASE + 3]);   \
    unsigned b0 = cvt_pk_bf16(Pv[BASE + 4], Pv[BASE + 5]), b1 = cvt_pk_bf16(Pv[BASE + 6], Pv[BASE + 7]);                              \
    auto r0 = __builtin_amdgcn_permlane32_swap(a0, b0, false, false); auto r1 = __builtin_amdgcn_permlane32_swap(a1, b1, false, false); \
    u32x4 w = {r0[0], r1[0], r0[1], r1[1]}; OUT = *reinterpret_cast<bf16x8*>(&w); } while (0)
            PK4(p0, 0, pa0); PK4(p0, 8, pa1); PK4(p1, 0, pa2); PK4(p1, 8, pa3);
#undef PK4
            SBAR();
            pv_one<0>(o[0], vb0, pa0, pa1, pa2, pa3); pv_one<1>(o[1], vb0, pa0, pa1, pa2, pa3); pv_one<2>(o[2], vb0, pa0, pa1, pa2, pa3); pv_one<3>(o[3], vb0, pa0, pa1, pa2, pa3);
            done = __all(Rc > 110.0f);
            if (done && lane == 0) flags[wid] = 1;
        }
        __syncthreads();
        int nd = 0;
#pragma unroll
        for (int w = 0; w < 8; ++w) nd += flags[w];
        if (nd == 8) break;
    }
    bf16_t* ob = P.mix + (tokbase + q0 + wid * 32) * 2048 + h * HD;
#pragma unroll
    for (int r = 0; r < 16; ++r) { const int orow = crow(r, hi);
#pragma unroll
        for (int d0 = 0; d0 < 4; ++d0) ob[(size_t)orow * 2048 + d0 * 32 + r32] = (bf16_t)(cvt_pk_bf16(o[d0][r], 0.f) & 0xffffu); }
    __syncthreads();
}

__device__ __forceinline__ float xhalf(float x, int hi) { const auto r = __builtin_amdgcn_permlane32_swap(__float_as_uint(x), __float_as_uint(x), false, false); return __uint_as_float(hi ? r[0] : r[1]); }
__device__ __forceinline__ float2 cmul(float2 a, float2 b) { return make_float2(a.x * b.x - a.y * b.y, a.x * b.y + a.y * b.x); }
__device__ __forceinline__ float2 cfma(float2 a, float2 x, float2 c) { return make_float2(a.x * x.x - a.y * x.y + c.x, a.x * x.y + a.y * x.x + c.y); }
template <bool OUT>
__device__ __forceinline__ void ssm_item(const Params& P, int item, LAS unsigned char* lds) {
    const int tid = threadIdx.x, wid = tid >> 6, lane = tid & 63, r32 = lane & 31, hi = lane >> 5, hh = lane & 15, kq = lane >> 4;
    const int g = item % NG, sc = (item / NG) % NSC, b = item / (NSC * NG);
    LAS unsigned* xs = (LAS unsigned*)(lds + wid * 8192);
    float2 a1[2], a2[2], a3[2], a4[2], cst[2]; bf16x8 bre[2], bim[2];
#pragma unroll
    for (int pb = 0; pb < 2; ++pb) { const int gp = g * NP + pb * 32 + r32;
        a1[pb] = P.abar[gp]; a2[pb] = cmul(a1[pb], a1[pb]); a3[pb] = cmul(a2[pb], a1[pb]); a4[pb] = cmul(a2[pb], a2[pb]);
        const float* bp = (const float*)(P.bbar + (size_t)gp * GH + 8 * hi); const f32x4 v0 = *(const f32x4*)bp, v1 = *(const f32x4*)(bp + 4), v2 = *(const f32x4*)(bp + 8), v3 = *(const f32x4*)(bp + 12);
        u32x4 wr_, wi_; wr_.x = cvt_pk_bf16(v0[0], v0[2]); wr_.y = cvt_pk_bf16(v1[0], v1[2]); wr_.z = cvt_pk_bf16(v2[0], v2[2]); wr_.w = cvt_pk_bf16(v3[0], v3[2]);
        wi_.x = cvt_pk_bf16(v0[1], v0[3]); wi_.y = cvt_pk_bf16(v1[1], v1[3]); wi_.z = cvt_pk_bf16(v2[1], v2[3]); wi_.w = cvt_pk_bf16(v3[1], v3[3]);
        bre[pb] = *(bf16x8*)&wr_; bim[pb] = *(bf16x8*)&wi_;
        cst[pb] = make_float2(0.f, 0.f);
        if (OUT) { const float2 aL = P.aL[gp]; const float2* ep = P.Est + ((size_t)(b * NG + g) * NSC) * NP + pb * 32 + r32; float2 e[NSC - 1];
#pragma unroll
            for (int cc = 0; cc < NSC - 1; ++cc) e[cc] = ep[(size_t)cc * NP];
#pragma unroll
            for (int cc = 0; cc < NSC - 1; ++cc) if (cc < sc) cst[pb] = cfma(aL, cst[pb], e[cc]); } }
    bf16x8 cf[4], dfr; float dsk = 0.f;
    if (OUT) {
#pragma unroll
        for (int s_ = 0; s_ < 4; ++s_) { const size_t ci = ((size_t)g * GH + hh) * NP + 16 * s_ + 4 * kq; const f32x4 cr = *(const f32x4*)(P.c_re + ci), cim = *(const f32x4*)(P.c_im + ci);
            u32x4 w; w.x = cvt_pk_bf16(cr[0], -cim[0]); w.y = cvt_pk_bf16(cr[1], -cim[1]); w.z = cvt_pk_bf16(cr[2], -cim[2]); w.w = cvt_pk_bf16(cr[3], -cim[3]); cf[s_] = *(bf16x8*)&w; }
        dsk = P.ssm_d[g * GH + hh];
        float dv[8];
#pragma unroll
        for (int j = 0; j < 8; ++j) dv[j] = (8 * kq + j == hh) ? dsk : 0.f;
        u32x4 w; w.x = cvt_pk_bf16(dv[0], dv[1]); w.y = cvt_pk_bf16(dv[2], dv[3]); w.z = cvt_pk_bf16(dv[4], dv[5]); w.w = cvt_pk_bf16(dv[6], dv[7]); dfr = *(bf16x8*)&w;
    }
    const float* ubase = P.u + ((size_t)b * SEQ + sc * SCH) * 1024 + g * GH;
    f32x4 un0 = *(const f32x4*)(ubase + (size_t)r32 * 1024 + 8 * hi), un1 = *(const f32x4*)(ubase + (size_t)r32 * 1024 + 8 * hi + 4);
    for (int blk = 0; blk < SCH / 32; ++blk) {
        u32x4 aw; aw.x = cvt_pk_bf16(un0[0], un0[1]); aw.y = cvt_pk_bf16(un0[2], un0[3]); aw.z = cvt_pk_bf16(un1[0], un1[1]); aw.w = cvt_pk_bf16(un1[2], un1[3]);
        bf16x8 Au = *(bf16x8*)&aw; mfma_operand_ready(Au);
        if (blk + 1 < SCH / 32) { const float* up = ubase + (size_t)((blk + 1) * 32 + r32) * 1024 + 8 * hi; un0 = *(const f32x4*)up; un1 = *(const f32x4*)(up + 4); }
#pragma unroll
        for (int pb = 0; pb < 2; ++pb) {
            f32x16 dre = __builtin_amdgcn_mfma_f32_32x32x16_bf16(Au, bre[pb], f32x16{}, 0, 0, 0);
            f32x16 dim = __builtin_amdgcn_mfma_f32_32x32x16_bf16(Au, bim[pb], f32x16{}, 0, 0, 0);
#pragma unroll
            for (int q = 0; q < 4; ++q)
#pragma unroll
                for (int i = 1; i < 4; ++i) { const float2 x = cfma(a1[pb], make_float2(dre[4 * q + i - 1], dim[4 * q + i - 1]), make_float2(dre[4 * q + i], dim[4 * q + i])); dre[4 * q + i] = x.x; dim[4 * q + i] = x.y; }
            float2 cin[4]; float2 cc = cst[pb];
#pragma unroll
            for (int q = 0; q < 4; ++q) { const float2 le = make_float2(dre[4 * q + 3], dim[4 * q + 3]);
                const float2 e0 = cfma(a4[pb], cc, le);
                const float2 pe0 = make_float2(xhalf(e0.x, hi), xhalf(e0.y, hi));
                const float2 e1 = cfma(a4[pb], pe0, le);
                const float2 pe1 = make_float2(xhalf(e1.x, hi), xhalf(e1.y, hi));
                cin[q] = hi ? pe0 : cc; cc = hi ? e1 : pe1; }
            cst[pb] = cc;
            if (OUT) {
#pragma unroll
                for (int q = 0; q < 4; ++q) { const float2 f1 = cmul(a1[pb], cin[q]), f2 = cmul(a2[pb], cin[q]), f3 = cmul(a3[pb], cin[q]), f4 = cmul(a4[pb], cin[q]);
                    const float2 x0 = make_float2(dre[4 * q + 0] + f1.x, dim[4 * q + 0] + f1.y), x1 = make_float2(dre[4 * q + 1] + f2.x, dim[4 * q + 1] + f2.y);
                    const float2 x2 = make_float2(dre[4 * q + 2] + f3.x, dim[4 * q + 2] + f3.y), x3 = make_float2(dre[4 * q + 3] + f4.x, dim[4 * q + 3] + f4.y);
                    LAS unsigned* xp = xs + (8 * q + 4 * hi) * 64 + pb * 32 + r32;
                    xp[0] = cvt_pk_bf16(x0.x, x0.y); xp[64] = cvt_pk_bf16(x1.x, x1.y); xp[128] = cvt_pk_bf16(x2.x, x2.y); xp[192] = cvt_pk_bf16(x3.x, x3.y); }
            }
        }
        if (OUT) {
            asm volatile("s_waitcnt lgkmcnt(0)" ::: "memory");
#pragma unroll
            for (int th = 0; th < 2; ++th) {
                f32x4 yacc = (f32x4){0.f, 0.f, 0.f, 0.f};
#pragma unroll
                for (int s_ = 0; s_ < 4; ++s_) { const bf16x8 af = *(const LAS bf16x8*)((const LAS unsigned char*)xs + (th * 16 + hh) * 256 + s_ * 64 + kq * 16);
                    yacc = __builtin_amdgcn_mfma_f32_16x16x32_bf16(af, cf[s_], yacc, 0, 0, 0); }
                u32x4 uw;
                { const float* up = ubase + (size_t)(blk * 32 + th * 16 + hh) * 1024 + 8 * (kq & 1); const f32x4 y0 = *(const f32x4*)up, y1 = *(const f32x4*)(up + 4);
                    uw.x = cvt_pk_bf16(y0[0], y0[1]); uw.y = cvt_pk_bf16(y0[2], y0[3]); uw.z = cvt_pk_bf16(y1[0], y1[1]); uw.w = cvt_pk_bf16(y1[2], y1[3]); }
                { bf16x8 ua = *(bf16x8*)&uw; mfma_operand_ready(ua); yacc = __builtin_amdgcn_mfma_f32_16x16x32_bf16(ua, dfr, yacc, 0, 0, 0); }
#pragma unroll
                for (int j = 0; j < 4; ++j) { const int t = blk * 32 + th * 16 + 4 * kq + j; const float yv = gelu_tanh(yacc[j]);
                    P.ybuf[((size_t)b * SEQ + sc * SCH + t) * 1024 + g * GH + hh] = (bf16_t)(cvt_pk_bf16(yv, 0.f) & 0xffffu); }
            }
            asm volatile("s_waitcnt lgkmcnt(0)" ::: "memory");
        }
    }
    if (!OUT) { if (hi == 0) {
#pragma unroll
        for (int pb = 0; pb < 2; ++pb) P.Est[((size_t)(b * NG + g) * NSC + sc) * NP + pb * 32 + r32] = cst[pb]; } }
}

__device__ void phase_mixnorm(const Params& P) {
    const int tid = threadIdx.x, wid = tid >> 6, lane = tid & 63, G = gridDim.x;
    for (int row = blockIdx.x * 8 + wid; row < T_; row += G * 8) {
        const bf16_t* mp = P.mix + (size_t)row * 2048; u32x4 v[4]; float ssa = 0.f, ssb = 0.f;
#pragma unroll
        for (int i = 0; i < 4; ++i) { v[i] = *(const u32x4*)(mp + lane * 8 + 512 * i);
            const float s = bf_lo(v[i].x) * bf_lo(v[i].x) + bf_hi(v[i].x) * bf_hi(v[i].x) + bf_lo(v[i].y) * bf_lo(v[i].y) + bf_hi(v[i].y) * bf_hi(v[i].y) + bf_lo(v[i].z) * bf_lo(v[i].z) + bf_hi(v[i].z) * bf_hi(v[i].z) + bf_lo(v[i].w) * bf_lo(v[i].w) + bf_hi(v[i].w) * bf_hi(v[i].w);
            if (i < 2) ssa += s; else ssb += s; }
        ssa = wave_sum(ssa); ssb = wave_sum(ssb);
        const float ra = rsqrtf(ssa * (1.0f / 1024) + EPS), rb = rsqrtf(ssb * (1.0f / 1024) + EPS);
#pragma unroll
        for (int i = 0; i < 4; ++i) { const float r = i < 2 ? ra : rb; u32x4 w;
            w.x = cvt_pk_bf16(bf_lo(v[i].x) * r, bf_hi(v[i].x) * r); w.y = cvt_pk_bf16(bf_lo(v[i].y) * r, bf_hi(v[i].y) * r);
            w.z = cvt_pk_bf16(bf_lo(v[i].z) * r, bf_hi(v[i].z) * r); w.w = cvt_pk_bf16(bf_lo(v[i].w) * r, bf_hi(v[i].w) * r);
            *(u32x4*)(P.R1 + (size_t)row * 2048 + lane * 8 + 512 * i) = w; }
    }
}

__device__ void phase_router(const Params& P, LAS unsigned char* lds) {
    const int tid = threadIdx.x, wid = tid >> 6, lane = tid & 63, r32 = lane & 31, kh = lane >> 5, G = gridDim.x;
    LAS float* part = (LAS float*)lds;
    LAS float* ssq = (LAS float*)(lds + 65536);
    LAS float* rinv = (LAS float*)(lds + 65536 + 1024);
    LAS int* lsel = (LAS int*)(lds + 65536 + 2048); LAS int* lrank = lsel + 32 * TOPK;
    for (int unit = blockIdx.x; unit < T_ / 32; unit += G) {
        const int tok0 = unit * 32;
        f32x16 acc0 = f32x16{}, acc1 = f32x16{}; float ss = 0.f;
        const float* ap = P.h1 + (size_t)(tok0 + r32) * DM + 256 * wid + 8 * kh;
        const bf16_t* bh = P.Wr_hi + (size_t)r32 * DM + 256 * wid + 8 * kh; const bf16_t* bl = P.Wr_lo + (size_t)r32 * DM + 256 * wid + 8 * kh;
#pragma unroll 4
        for (int s_ = 0; s_ < 16; ++s_) {
            const f32x4 x0 = *(const f32x4*)(ap + 16 * s_), x1 = *(const f32x4*)(ap + 16 * s_ + 4);
            ss += x0[0] * x0[0] + x0[1] * x0[1] + x0[2] * x0[2] + x0[3] * x0[3] + x1[0] * x1[0] + x1[1] * x1[1] + x1[2] * x1[2] + x1[3] * x1[3];
            u32x4 hw, lw;
            hw.x = cvt_pk_bf16(x0[0], x0[1]); hw.y = cvt_pk_bf16(x0[2], x0[3]); hw.z = cvt_pk_bf16(x1[0], x1[1]); hw.w = cvt_pk_bf16(x1[2], x1[3]);
            lw.x = cvt_pk_bf16(x0[0] - bf_lo(hw.x), x0[1] - bf_hi(hw.x)); lw.y = cvt_pk_bf16(x0[2] - bf_lo(hw.y), x0[3] - bf_hi(hw.y));
            lw.z = cvt_pk_bf16(x1[0] - bf_lo(hw.z), x1[1] - bf_hi(hw.z)); lw.w = cvt_pk_bf16(x1[2] - bf_lo(hw.w), x1[3] - bf_hi(hw.w));
            bf16x8 Ah = *(bf16x8*)&hw, Al = *(bf16x8*)&lw; mfma_operand_ready(Ah, Al);
            const bf16x8 Bh0 = *(const bf16x8*)(bh + 16 * s_), Bh1 = *(const bf16x8*)(bh + (size_t)32 * DM + 16 * s_);
            const bf16x8 Bl0 = *(const bf16x8*)(bl + 16 * s_), Bl1 = *(const bf16x8*)(bl + (size_t)32 * DM + 16 * s_);
            acc0 = __builtin_amdgcn_mfma_f32_32x32x16_bf16(Ah, Bh0, acc0, 0, 0, 0); acc1 = __builtin_amdgcn_mfma_f32_32x32x16_bf16(Ah, Bh1, acc1, 0, 0, 0);
            acc0 = __builtin_amdgcn_mfma_f32_32x32x16_bf16(Ah, Bl0, acc0, 0, 0, 0); acc1 = __builtin_amdgcn_mfma_f32_32x32x16_bf16(Ah, Bl1, acc1, 0, 0, 0);
            acc0 = __builtin_amdgcn_mfma_f32_32x32x16_bf16(Al, Bh0, acc0, 0, 0, 0); acc1 = __builtin_amdgcn_mfma_f32_32x32x16_bf16(Al, Bh1, acc1, 0, 0, 0);
        }
#pragma unroll
        for (int r = 0; r < 16; ++r) { const int tl = crow(r, kh); part[(wid * 32 + tl) * 64 + r32] = acc0[r]; part[(wid * 32 + tl) * 64 + 32 + r32] = acc1[r]; }
        ss += __shfl_xor(ss, 32); if (kh == 0) ssq[wid * 32 + r32] = ss;
        __syncthreads();
        if (tid < 32) { float sq = 0.f;
#pragma unroll
            for (int w = 0; w < 8; ++w) sq += ssq[w * 32 + tid];
            rinv[tid] = rsqrtf(sq * (1.0f / DM) + EPS); }
        __syncthreads();
        int selE[4]; float selG[4];
#pragma unroll
        for (int tt = 0; tt < 4; ++tt) { const int tl = 4 * wid + tt; float lg = 0.f;
#pragma unroll
            for (int w = 0; w < 8; ++w) lg += part[(w * 32 + tl) * 64 + lane];
            lg *= rinv[tl];
            const float score = 1.0f / (1.0f + expf(-lg)); float selv = score + P.router_bias[lane];
            int myE = 0; float myG = 0.f, gsum = 0.f;
#pragma unroll
            for (int j = 0; j < TOPK; ++j) { const float mx = wave_max(selv); const unsigned long long bal = __ballot(selv == mx); const int first = __builtin_amdgcn_readfirstlane((int)__builtin_ctzll(bal));
                const float gsel = __shfl(score, first); gsum += gsel; if (lane == j) { myE = first; myG = gsel; } if (lane == first) selv = -3.0e38f; }
            selE[tt] = myE; selG[tt] = myG / gsum * 2.5f;
            if (lane < TOPK) lsel[tl * TOPK + lane] = myE; }
        __syncthreads();
        if (wid == 0) { int cn = 0;
            for (int i = 0; i < 32 * TOPK; ++i) { const int se = lsel[i]; if (se == lane) { lrank[i] = cn; ++cn; } }
            P.cntw[unit * NE + lane] = cn; }
        __syncthreads();
        if (lane < TOPK) {
#pragma unroll
            for (int tt = 0; tt < 4; ++tt) { const int tl = 4 * wid + tt, tok = tok0 + tl;
                P.sel_e[tok * TOPK + lane] = selE[tt]; P.sel_pos[tok * TOPK + lane] = lrank[tl * TOPK + lane]; P.sel_gate[tok * TOPK + lane] = selG[tt]; } }
#pragma unroll
        for (int tt = 0; tt < 4; ++tt) { const int tl = 4 * wid + tt; const float r = rinv[tl]; const float* hp = P.h1 + (size_t)(tok0 + tl) * DM;
#pragma unroll
            for (int i = 0; i < 8; ++i) { const f32x4 v = *(const f32x4*)(hp + 4 * lane + 256 * i); const f32x4 gn = *(const f32x4*)(P.norm_ffn + 4 * lane + 256 * i); const f32x4 mv = v * r * gn;
                u32x2 w; w.x = cvt_pk_bf16(mv[0], mv[1]); w.y = cvt_pk_bf16(mv[2], mv[3]); *(u32x2*)(P.R1 + (size_t)(tok0 + tl) * DM + 4 * lane + 256 * i) = w; } }
        __syncthreads();
    }
}

constexpr int NU = T_ / 32;
__device__ __forceinline__ void moe_sum_units(const Params& P, LAS int* tmp, LAS int* out, int ulim) {
    const int e = threadIdx.x & 63, part = threadIdx.x >> 6; int sacc = 0;
#pragma unroll 8
    for (int i = 0; i < NU / 8; ++i) { const int v = part * (NU / 8) + i; const int cv = P.cntw[v * NE + e]; sacc += (v < ulim) ? cv : 0; }
    tmp[part * 64 + e] = sacc;
    __syncthreads();
    if (threadIdx.x < NE) { int tot = 0;
#pragma unroll
        for (int p = 0; p < 8; ++p) tot += tmp[p * 64 + threadIdx.x];
        out[threadIdx.x] = tot; }
    __syncthreads();
}
__device__ int build_moe_tables(const Params& P, LAS unsigned char* lds) {
    LAS int* rt_e = (LAS int*)(lds + LDS_TAB); LAS int* rt_j = rt_e + 256; volatile LAS int* nrt = (volatile LAS int*)(rt_e + 512); LAS int* rt_n = rt_e + 640;
    __syncthreads();
    if (threadIdx.x < NE) { const int e = threadIdx.x; const int n = (int)P.cnt[e]; const int ntile = (n + 255) >> 8; int pre = ntile;
#pragma unroll
        for (int o = 1; o < 64; o <<= 1) { const int t = __shfl_up(pre, o); if (e >= o) pre += t; }
        const int rt = pre - ntile;
        for (int j = 0; j < ntile; ++j) if (rt + j < 256) { rt_e[rt + j] = e; rt_j[rt + j] = j; rt_n[rt + j] = (n - j * 256) < 256 ? (n - j * 256) : 256; }
        if (e == NE - 1) *nrt = pre < 256 ? pre : 256; }
    __syncthreads();
    return *nrt;
}
__device__ void moe_scatter(const Params& P, LAS unsigned char* lds) {
    LAS int* bs = (LAS int*)(lds + LDS_TAB + 2100);
    const int tid = threadIdx.x, G = gridDim.x;
    for (int u = blockIdx.x; u < NU; u += G) {
        __syncthreads();
        moe_sum_units(P, (LAS int*)lds, bs, u);
        if (tid < NE) { P.basew[u * NE + tid] = bs[tid]; if (u == NU - 1) P.cnt[tid] = (unsigned)(bs[tid] + P.cntw[u * NE + tid]); }
        if (tid < 32 * TOPK) { const int tok = u * 32 + tid / TOPK, k = tid % TOPK; const int e = P.sel_e[tok * TOPK + k], loc = P.sel_pos[tok * TOPK + k];
            __hip_atomic_store(&P.tok_of_row[(size_t)e * CAP + bs[e] + loc], tok, __ATOMIC_RELAXED, __HIP_MEMORY_SCOPE_AGENT); }
    }
}

__device__ void phase_combine(const Params& P, LAS unsigned char* lds) {
    const int tid = threadIdx.x, wid = tid >> 6, lane = tid & 63, G = gridDim.x;
    LAS int* rt0 = (LAS int*)(lds + LDS_TAB);
    __syncthreads();
    if (tid < NE) { const int ntile = ((int)P.cnt[tid] + 255) >> 8; int pre = ntile;
#pragma unroll
        for (int o = 1; o < 64; o <<= 1) { const int t = __shfl_up(pre, o); if (tid >= o) pre += t; }
        rt0[tid] = pre - ntile; }
    __syncthreads();
    for (int row = blockIdx.x * 8 + wid; row < T_; row += G * 8) {
        int crw = 0; float gte = 0.f;
        if (lane < TOPK) { const int e = P.sel_e[row * TOPK + lane]; crw = rt0[e] * 256 + P.basew[(row >> 5) * NE + e] + P.sel_pos[row * TOPK + lane]; gte = P.sel_gate[row * TOPK + lane]; }
        float hv[4][8]; float ss = 0.f;
#pragma unroll
        for (int i = 0; i < 4; ++i) { const size_t o = (size_t)row * DM + lane * 8 + 512 * i; const f32x4 a = *(const f32x4*)(P.h1 + o), b2 = *(const f32x4*)(P.h1 + o + 4);
            hv[i][0] = a[0]; hv[i][1] = a[1]; hv[i][2] = a[2]; hv[i][3] = a[3]; hv[i][4] = b2[0]; hv[i][5] = b2[1]; hv[i][6] = b2[2]; hv[i][7] = b2[3];
            const u32x4 sv = *(const u32x4*)(P.Ysh + o);
            hv[i][0] += bf_lo(sv.x); hv[i][1] += bf_hi(sv.x); hv[i][2] += bf_lo(sv.y); hv[i][3] += bf_hi(sv.y); hv[i][4] += bf_lo(sv.z); hv[i][5] += bf_hi(sv.z); hv[i][6] += bf_lo(sv.w); hv[i][7] += bf_hi(sv.w); }
#pragma unroll
        for (int k = 0; k < TOPK; ++k) { const int cr = __builtin_amdgcn_readlane(crw, k); const float gt = __uint_as_float((unsigned)__builtin_amdgcn_readlane((int)__float_as_uint(gte), k)); const bf16_t* yp = P.Y + (size_t)cr * DM + lane * 8;
#pragma unroll
            for (int i = 0; i < 4; ++i) { const u32x4 y = *(const u32x4*)(yp + 512 * i);
                hv[i][0] += gt * bf_lo(y.x); hv[i][1] += gt * bf_hi(y.x); hv[i][2] += gt * bf_lo(y.y); hv[i][3] += gt * bf_hi(y.y); hv[i][4] += gt * bf_lo(y.z); hv[i][5] += gt * bf_hi(y.z); hv[i][6] += gt * bf_lo(y.w); hv[i][7] += gt * bf_hi(y.w); } }
#pragma unroll
        for (int i = 0; i < 4; ++i)
#pragma unroll
            for (int j = 0; j < 8; ++j) ss += hv[i][j] * hv[i][j];
        ss = wave_sum(ss); const float r = rsqrtf(ss * (1.0f / DM) + EPS);
#pragma unroll
        for (int i = 0; i < 4; ++i) { const size_t o = (size_t)row * DM + lane * 8 + 512 * i;
            *(f32x4*)(P.h1 + o) = (f32x4){hv[i][0], hv[i][1], hv[i][2], hv[i][3]}; *(f32x4*)(P.h1 + o + 4) = (f32x4){hv[i][4], hv[i][5], hv[i][6], hv[i][7]};
            u32x4 w; w.x = cvt_pk_bf16(hv[i][0] * r, hv[i][1] * r); w.y = cvt_pk_bf16(hv[i][2] * r, hv[i][3] * r); w.z = cvt_pk_bf16(hv[i][4] * r, hv[i][5] * r); w.w = cvt_pk_bf16(hv[i][6] * r, hv[i][7] * r);
            *(u32x4*)(P.R1 + o) = w; }
    }
}

constexpr int NPHASE = 13;
__global__ void __launch_bounds__(512, 2) fwd(Params P) {
    extern __shared__ __attribute__((aligned(16))) unsigned char shm_raw[];
    LAS unsigned char* lds = (LAS unsigned char*)shm_raw;
    asm volatile("s_nop 0\n\ts_nop 0\n\ts_nop 0" ::: "memory");
    const int G = gridDim.x, c = blockIdx.x;
    for (int i = threadIdx.x; i < LDS_BYTES / 16; i += 512) ((LAS u32x4*)lds)[i] = (u32x4){0u, 0u, 0u, 0u};
    __syncthreads();
    XcdBarrier bar; bar.bar = P.bar; bar.x = 0; bar.st = (volatile LAS unsigned*)(lds + LDS_BARW);
    const int lo = (int)P.ph_lo, hi = (int)P.ph_hi;
    if (hi - lo > 1) bar = xcd_barrier_post(P.bar, (volatile LAS unsigned*)(lds + LDS_BARW));
#define RUN(k) (lo <= (k) && (k) < hi)
#define SEAM(k) do { if (lo <= (k) && (k) + 1 < hi) xcd_barrier(bar); } while (0)
    auto phase_fn_0 = [&]() {
    if (RUN(0)) phase_prologue(P, lds);
    };
    phase_fn_0();
#if REP_PHASE == 0
    xcd_barrier(bar); phase_fn_0();
#endif
    SEAM(0);
    auto phase_fn_1 = [&]() {
    if (RUN(1)) { pg8::StaticOrder S; S.init(T_, NZ, DM, G, c); pg8::Gemm g{P.R1, P.Wt_in, DM, nullptr}; EpiQKVU E{P.zq, P.u}; pg8::gemm_phase<EpiQKVU, pg8::StaticOrder, false>(lds, g, S, E); }
    };
    phase_fn_1();
#if REP_PHASE == 1
    xcd_barrier(bar); phase_fn_1();
#endif
    SEAM(1);
    auto phase_fn_2 = [&]() {
    if (RUN(2)) {
        for (int u = c; u < NB * NHEAD * 8; u += G) attn_unit(P, u, lds);
        for (int it = c * 8 + (threadIdx.x >> 6); it < NB * NG * NSC; it += G * 8) ssm_item<false>(P, it, lds);
    }
    };
    phase_fn_2();
#if REP_PHASE == 2
    xcd_barrier(bar); phase_fn_2();
#endif
    SEAM(2);
    auto phase_fn_3 = [&]() {
    if (RUN(3)) { for (int it = c * 8 + (threadIdx.x >> 6); it < NB * NG * NSC; it += G * 8) ssm_item<true>(P, it, lds); }
    };
    phase_fn_3();
#if REP_PHASE == 3
    xcd_barrier(bar); phase_fn_3();
#endif
    SEAM(3);
    auto phase_fn_4 = [&]() {
    if (RUN(4)) { pg8::StaticOrder S; S.init(T_, 1024, 1024, G, c); pg8::Gemm g{P.ybuf, P.Wt_glu, 1024, nullptr}; EpiGLU E{P.ybuf, P.mix}; pg8::gemm_phase<EpiGLU, pg8::StaticOrder, false>(lds, g, S, E); }
    };
    phase_fn_4();
#if REP_PHASE == 4
    xcd_barrier(bar); phase_fn_4();
#endif
    SEAM(4);
#if REP_PHASE == 100
    xcd_barrier(bar); xcd_barrier(bar); xcd_barrier(bar); xcd_barrier(bar);
#endif
    auto phase_fn_5 = [&]() {
    if (RUN(5)) phase_mixnorm(P);
    };
    phase_fn_5();
#if REP_PHASE == 5
    xcd_barrier(bar); phase_fn_5();
#endif
    SEAM(5);
    auto phase_fn_6 = [&]() {
    if (RUN(6)) { pg8::StaticOrder S; S.init(T_, DM, DM, G, c); pg8::Gemm g{P.R1, P.Wt_out, DM, nullptr}; EpiRes E{P.x, P.h1}; pg8::gemm_phase<EpiRes, pg8::StaticOrder, false>(lds, g, S, E); }
    };
    phase_fn_6();
#if REP_PHASE == 6
    xcd_barrier(bar); phase_fn_6();
#endif
    SEAM(6);
    auto phase_fn_7 = [&]() {
    if (RUN(7)) phase_router(P, lds);
    };
    phase_fn_7();
#if REP_PHASE == 7
    xcd_barrier(bar); if (blockIdx.x == 0 && threadIdx.x < NE) P.cnt[threadIdx.x * 64] = 0u; xcd_barrier(bar); phase_fn_7();
#endif
    SEAM(7);
    auto phase_fn_8 = [&]() {
    if (RUN(8)) { moe_scatter(P, lds); if (hi - lo > 1) xcd_barrier(bar);
        const int n_rt = build_moe_tables(P, lds);
        MoeSched S; S.G = G; S.c = c; S.n_rt = n_rt; S.NPN = 4; S.K = DM; S.down = false; S.rt_e = (const LAS int*)(lds + LDS_TAB); S.rt_j = S.rt_e + 256; S.rt_n = S.rt_e + 640;
        pg8::Gemm g{P.R1, P.Wt_egu, DM, P.tok_of_row}; EpiSwiGLU E{P.H, P.Hs};
        pg8::gemm_phase<EpiSwiGLU, MoeSched, true>(lds, g, S, E); }
    };
    phase_fn_8();
#if REP_PHASE == 8
    xcd_barrier(bar); phase_fn_8();
#endif
    SEAM(8);
    auto phase_fn_9 = [&]() {
    if (RUN(9)) { const int n_rt = build_moe_tables(P, lds);
        for (int j = (c >> 3) & 7; j > 0; --j) __builtin_amdgcn_s_sleep(37);
        MoeSched S; S.G = G; S.c = c; S.n_rt = n_rt; S.NPN = 8; S.K = DE; S.down = true; S.rt_e = (const LAS int*)(lds + LDS_TAB); S.rt_j = S.rt_e + 256; S.rt_n = S.rt_e + 640;
        pg8::Gemm g{P.H, P.Wt_ed, DE, nullptr}; EpiDown E{P.Y, P.Ysh};
        pg8::gemm_phase<EpiDown, MoeSched, false>(lds, g, S, E); }
    };
    phase_fn_9();
#if REP_PHASE == 9
    xcd_barrier(bar); phase_fn_9();
#endif
    SEAM(9);
    auto phase_fn_10 = [&]() {
    if (RUN(10)) phase_combine(P, lds);
    };
    phase_fn_10();
#if REP_PHASE == 10
    xcd_barrier(bar); phase_fn_10();
#endif
    SEAM(10);
    auto phase_fn_11 = [&]() {
    if (RUN(11)) { pg8::StaticOrder S; S.init(T_, DM, DPLE, G, c); pg8::Gemm g{P.pb, P.Wt_pp, DPLE, nullptr}; EpiBf16 E{P.proj, DM}; pg8::gemm_phase<EpiBf16, pg8::StaticOrder, false>(lds, g, S, E); }
    };
    phase_fn_11();
#if REP_PHASE == 11
    xcd_barrier(bar); phase_fn_11();
#endif
    SEAM(11);
    auto phase_fn_12 = [&]() {
    if (RUN(12)) { pg8::StaticOrder S; S.init(T_, DM, DM, G, c); pg8::Gemm g{P.R1, P.Wt_pg, DM, nullptr}; EpiPle E{P.out, P.proj, P.h1}; pg8::gemm_phase<EpiPle, pg8::StaticOrder, false>(lds, g, S, E); }
    };
    phase_fn_12();
#if REP_PHASE == 12
    xcd_barrier(bar); phase_fn_12();
#endif
    if (hi - lo > 1) xcd_barrier(bar);
#undef RUN
#undef SEAM
}

extern "C" void kernel_launch(void* const* d_in, const int* in_sizes, int n_in, void* d_out, int out_size, void* d_ws, size_t ws_size, hipStream_t stream) {
    static int grid = 0;
    size_t off = 0;
    auto take = [&](size_t bytes) { const size_t o = off; off += (bytes + 255) & ~(size_t)255; return o; };
    const size_t o_ctl = take(32768);
    const size_t o_Wt_in = take((size_t)4096 * 2048 * 2), o_Wt_glu = take((size_t)1024 * 1024 * 2), o_Wt_out = take((size_t)2048 * 2048 * 2), o_Wt_pg = take((size_t)2048 * 2048 * 2),
                 o_Wt_pp = take((size_t)2048 * 256 * 2), o_Wt_egu = take((size_t)(NE + 1) * 1024 * 2048 * 2), o_Wt_ed = take((size_t)(NE + 1) * 2048 * 512 * 2);
    const size_t o_R1 = take((size_t)(T_ + 1) * DM * 2), o_h1 = take((size_t)T_ * DM * 4), o_tok = take((size_t)NE * CAP * 4), o_sele = take((size_t)T_ * TOPK * 4), o_selp = take((size_t)T_ * TOPK * 4),
                 o_selg = take((size_t)T_ * TOPK * 4), o_cntw = take((size_t)(T_ / 32) * NE * 4), o_basew = take((size_t)(T_ / 32) * NE * 4), o_H = take((size_t)(65536 + T_) * DE * 2), o_Ysh = take((size_t)T_ * DM * 2), o_proj = take((size_t)T_ * DM * 2), o_pb = take((size_t)T_ * DPLE * 2),
                 o_abar = take((size_t)NG * NP * 8), o_aL = take((size_t)NG * NP * 8), o_bbar = take((size_t)NG * NP * GH * 8), o_wrh = take((size_t)NE * DM * 2), o_wrl = take((size_t)NE * DM * 2);
    const size_t o_Y = take((size_t)65536 * DM * 2);
    size_t off2 = o_Y; auto take2 = [&](size_t bytes) { const size_t o = off2; off2 += (bytes + 255) & ~(size_t)255; return o; };
    const size_t o_zq = take2((size_t)T_ * 3072 * 2), o_u = take2((size_t)T_ * 1024 * 4), o_mix = take2((size_t)T_ * 2048 * 2), o_y = take2((size_t)T_ * 1024 * 2), o_E = take2((size_t)NB * NG * NSC * NP * 8);
    const size_t ws_need = off > off2 ? off : off2;
    if (grid == 0) {
        if (n_in != 30 || in_sizes[0] != T_ * DM || out_size != T_ * DM || ws_size < ws_need) {
            fprintf(stderr, "kernel_launch: unexpected shapes: n_in %d in0 %d out %d ws %zu (need %zu); nothing launched\n", n_in, n_in > 0 ? in_sizes[0] : -1, out_size, ws_size, ws_need); grid = -1; return; }
        int dev = 0, cus = 0, per_cu = 0;
        if (hipGetDevice(&dev) != hipSuccess || hipDeviceGetAttribute(&cus, hipDeviceAttributeMultiprocessorCount, dev) != hipSuccess) { fprintf(stderr, "kernel_launch: device query failed\n"); grid = -1; return; }
        if (hipFuncSetAttribute((const void*)fwd, hipFuncAttributeMaxDynamicSharedMemorySize, LDS_BYTES) != hipSuccess) { fprintf(stderr, "kernel_launch: hipFuncSetAttribute failed\n"); grid = -1; return; }
        if (hipOccupancyMaxActiveBlocksPerMultiprocessor(&per_cu, (const void*)fwd, 512, LDS_BYTES) != hipSuccess || per_cu < 1) fprintf(stderr, "kernel_launch: note: occupancy query reports %d\n", per_cu);
        (void)hipGetLastError();
        grid = cus;
    }
    if (grid < 0) return;
    char* ws = (char*)d_ws;
    if (hipMemsetAsync(ws + o_ctl, 0, 32768, stream) != hipSuccess) { fprintf(stderr, "kernel_launch: memset failed\n"); return; }
    Params P; memset(&P, 0, sizeof(P));
    const float** inp = &P.x;
    for (int i = 0; i < 30; ++i) inp[i] = (const float*)d_in[i];
    P.out = (float*)d_out;
    P.bar = (unsigned*)(ws + o_ctl); P.cnt = (unsigned*)(ws + o_ctl + 16384);
    P.Wt_in = (bf16_t*)(ws + o_Wt_in); P.Wt_glu = (bf16_t*)(ws + o_Wt_glu); P.Wt_out = (bf16_t*)(ws + o_Wt_out); P.Wt_pg = (bf16_t*)(ws + o_Wt_pg); P.Wt_pp = (bf16_t*)(ws + o_Wt_pp);
    P.Wt_egu = (bf16_t*)(ws + o_Wt_egu); P.Wt_ed = (bf16_t*)(ws + o_Wt_ed);
    P.R1 = (bf16_t*)(ws + o_R1); P.zq = (bf16_t*)(ws + o_zq); P.mix = (bf16_t*)(ws + o_mix); P.ybuf = (bf16_t*)(ws + o_y);
    P.H = (bf16_t*)(ws + o_H); P.Hs = P.H + (size_t)65536 * DE; P.Y = (bf16_t*)(ws + o_Y); P.Ysh = (bf16_t*)(ws + o_Ysh); P.proj = (bf16_t*)(ws + o_proj); P.pb = (bf16_t*)(ws + o_pb);
    P.u = (float*)(ws + o_u); P.h1 = (float*)(ws + o_h1); P.sel_gate = (float*)(ws + o_selg);
    P.Est = (float2*)(ws + o_E); P.abar = (float2*)(ws + o_abar); P.aL = (float2*)(ws + o_aL); P.bbar = (float2*)(ws + o_bbar);
    P.tok_of_row = (int*)(ws + o_tok); P.sel_e = (int*)(ws + o_sele); P.sel_pos = (int*)(ws + o_selp); P.cntw = (int*)(ws + o_cntw); P.basew = (int*)(ws + o_basew); P.Wr_hi = (bf16_t*)(ws + o_wrh); P.Wr_lo = (bf16_t*)(ws + o_wrl);
#if MK_LAUNCHES == 1
    P.ph_lo = 0; P.ph_hi = NPHASE;
    hipLaunchKernelGGL(fwd, dim3(grid), dim3(512), LDS_BYTES, stream, P);
#else
    for (int k = 0; k < NPHASE; ++k) { P.ph_lo = k; P.ph_hi = k + 1; hipLaunchKernelGGL(fwd, dim3(grid), dim3(512), LDS_BYTES, stream, P); }
#endif
    const hipError_t le = hipPeekAtLastError();
    if (le != hipSuccess) fprintf(stderr, "kernel_launch: launch failed: %s\n", hipGetErrorName(le));
}
```

```cpp
#include <hip/hip_runtime.h>
#include <cstdio>
#include <cstdint>
#include <cstring>

#ifndef MK_LAUNCHES
#define MK_LAUNCHES 1
#endif

#ifndef REP_PHASE
#define REP_PHASE -1
#endif
#define LAS __attribute__((address_space(3)))
typedef unsigned short bf16_t;
typedef short bf16x8 __attribute__((ext_vector_type(8)));
typedef short s16x4 __attribute__((ext_vector_type(4)));
typedef float f32x4 __attribute__((ext_vector_type(4)));
typedef float f32x16 __attribute__((ext_vector_type(16)));
typedef unsigned u32x4 __attribute__((ext_vector_type(4)));
typedef unsigned u32x2 __attribute__((ext_vector_type(2)));

#define XB_TMO      128
#define XB_XCNT(j)  (256  + 64 * (j))
#define XB_XSUB(j)  (1280 + 64 * (j))
#define XB_XGEN(j)  (2304 + 64 * (j))
#define XB_TOP      3328
#define XB_TOPGEN   3392
#define XCD_BAR_WORDS 3456
#define XB_SPIN_CAP (1u << 18)

__device__ __forceinline__ unsigned xb_ld(unsigned* p)              { return __hip_atomic_load(p, __ATOMIC_RELAXED, __HIP_MEMORY_SCOPE_AGENT); }
__device__ __forceinline__ unsigned xb_add(unsigned* p, unsigned v) { return __hip_atomic_fetch_add(p, v, __ATOMIC_RELAXED, __HIP_MEMORY_SCOPE_AGENT); }
__device__ __forceinline__ unsigned xb_xcc_id() { return (unsigned)__builtin_amdgcn_s_getreg((3 << 11) | 20) & 0xFu; }
#define XB_SPIN(cond, bar) do { unsigned _sp = 0; while (cond) { __builtin_amdgcn_s_sleep(1); \
    if ((++_sp & 255u) == 0u) { if (xb_ld(&(bar)[XB_TMO])) break; if (_sp > XB_SPIN_CAP) { atomicAdd(&(bar)[XB_TMO], 1u); break; } } } } while (0)

struct XcdBarrier { unsigned* bar; unsigned x; volatile LAS unsigned* st; };

__device__ __forceinline__ XcdBarrier xcd_barrier_post(unsigned* bar, volatile LAS unsigned* st) {
    XcdBarrier b; b.bar = bar; b.x = xb_xcc_id(); b.st = st;
    if (threadIdx.x == 0) (void)xb_add(&bar[XB_XCNT(b.x)], 1u);
    return b;
}
__device__ __forceinline__ void xcd_barrier_complete(unsigned* bar, unsigned x, unsigned& nloc, unsigned& nx) {
    const unsigned G = gridDim.x * gridDim.y * gridDim.z;
    unsigned sum, cnt, mine, sp = 0u;
    for (;;) {
        sum = 0u; cnt = 0u; mine = 0u;
#pragma unroll
        for (unsigned j = 0; j < 16; ++j) { const unsigned c = xb_ld(&bar[XB_XCNT(j)]); sum += c; cnt += (c > 0u) ? 1u : 0u; mine = (j == x) ? c : mine; }
        if (sum == G) break;
        __builtin_amdgcn_s_sleep(1);
        if ((++sp & 255u) == 0u) { if (xb_ld(&bar[XB_TMO])) break; if (sp > XB_SPIN_CAP) { atomicAdd(&bar[XB_TMO], 1u); break; } }
    }
    nloc = mine > 0u ? mine : 1u; nx = cnt > 0u ? cnt : 1u;
}
__device__ __forceinline__ void xcd_barrier(const XcdBarrier& b) {
    asm volatile("s_waitcnt vmcnt(0)" ::: "memory");
    __syncthreads();
    if (threadIdx.x == 0) {
        unsigned* bar = b.bar;
        __builtin_amdgcn_s_waitcnt(0);
        unsigned nloc = b.st[0], nx = b.st[1];
        if (nloc == 0u) { xcd_barrier_complete(bar, b.x, nloc, nx); b.st[0] = nloc; b.st[1] = nx; }
        const unsigned old = xb_add(&bar[XB_XSUB(b.x)], 1u);
        const unsigned gen = old / nloc;
        if (old + 1u == (gen + 1u) * nloc) {
            __builtin_amdgcn_fence(__ATOMIC_RELEASE, "agent");
            asm volatile("s_waitcnt vmcnt(0)" ::: "memory");
            const unsigned og = xb_add(&bar[XB_TOP], 1u);
            const unsigned tg = og / nx;
            if (og + 1u == (tg + 1u) * nx) xb_add(&bar[XB_TOPGEN], 1u);
            else XB_SPIN(xb_ld(&bar[XB_TOPGEN]) == tg, bar);
            __builtin_amdgcn_fence(__ATOMIC_ACQUIRE, "agent");
            xb_add(&bar[XB_XGEN(b.x)], 1u);
            asm volatile("s_waitcnt vmcnt(0)" ::: "memory");
        } else {
            XB_SPIN(xb_ld(&bar[XB_XGEN(b.x)]) == gen, bar);
            __builtin_amdgcn_fence(__ATOMIC_ACQUIRE, "agent");
            asm volatile("s_waitcnt vmcnt(0)" ::: "memory");
        }
    }
    __syncthreads();
}

constexpr int T_ = 8192, DM = 2048, NZ = 4096, SEQ = 2048, NB = 4, NHEAD = 8, HD = 128;
constexpr int NG = 64, GH = 16, NP = 64, SCH = 256, NSC = SEQ / SCH;
constexpr int NE = 64, TOPK = 6, DE = 512, DPLE = 256, CAP = 8192;
constexpr int ZROW = T_;
constexpr float EPS = 1e-6f;

constexpr int LDS_STAGE = 131072;
constexpr int LDS_TAB = LDS_STAGE;
constexpr int LDS_BARW = LDS_STAGE + 4096;
constexpr int LDS_FLAGS = LDS_BARW + 16;
constexpr int LDS_BYTES = LDS_STAGE + 4096 + 256;

struct Params {
    const float *x, *p, *norm_mix, *w_in, *q_norm, *k_norm, *lam_re, *lam_im, *log_dt, *b_re, *b_im, *c_re, *c_im, *ssm_d, *w_glu,
                *attn_out_norm, *ssm_out_norm, *w_out, *norm_ffn, *w_router, *router_bias, *w_eg, *w_eu, *w_ed, *w_sg, *w_su, *w_sd,
                *norm_ple, *w_pg, *w_pp;
    float* out;
    unsigned* bar; unsigned* cnt;
    bf16_t *Wt_in, *Wt_glu, *Wt_out, *Wt_pg, *Wt_pp, *Wt_egu, *Wt_ed, *Wr_hi, *Wr_lo;
    bf16_t *R1, *zq, *mix, *ybuf, *H, *Hs, *Y, *Ysh, *proj, *pb, *R3;
    float *u, *h1, *sel_gate;
    float2 *Est, *abar, *aL, *bbar;
    int *tok_of_row, *sel_e, *sel_pos, *cntw, *basew;
    long long ph_lo, ph_hi;
};

typedef __bf16 bf16x2_t __attribute__((ext_vector_type(2)));
typedef float f32x2_t __attribute__((ext_vector_type(2)));
__device__ __forceinline__ unsigned cvt_pk_bf16(float lo, float hi) { const f32x2_t v = {lo, hi}; const bf16x2_t b = __builtin_convertvector(v, bf16x2_t); return __builtin_bit_cast(unsigned, b); }
__device__ __forceinline__ void mfma_operand_ready(bf16x8& a) { asm volatile("s_nop 7" : "+v"(a)); }
__device__ __forceinline__ void mfma_operand_ready(bf16x8& a, bf16x8& b) { asm volatile("s_nop 7" : "+v"(a), "+v"(b)); }
__device__ __forceinline__ float bf_lo(unsigned w) { return __uint_as_float(w << 16); }
__device__ __forceinline__ float bf_hi(unsigned w) { return __uint_as_float(w & 0xffff0000u); }
__device__ __forceinline__ float sigmoidf_(float v) { return 1.0f / (1.0f + __expf(-v)); }
__device__ __forceinline__ float wave_sum(float v) {
#pragma unroll
    for (int o = 32; o >= 1; o >>= 1) v += __shfl_xor(v, o);
    return v;
}
__device__ __forceinline__ float wave_max(float v) {
#pragma unroll
    for (int o = 32; o >= 1; o >>= 1) v = fmaxf(v, __shfl_xor(v, o));
    return v;
}
__device__ __forceinline__ float gelu_tanh(float v) {
    const float c = 0.7978845608028654f;
    const float in = c * (v + 0.044715f * v * v * v);
    const float e = __expf(2.0f * in);
    const float th = 1.0f - 2.0f / (1.0f + e);
    return 0.5f * v * (1.0f + th);
}

namespace pg8 {
constexpr int BM = 256, BK = 64, HALF = 128, HTB = HALF * BK * 2, STAGE_BYTES = 8 * HTB, NXCD = 8, WGM = 8;
__host__ __device__ __forceinline__ int lds_byte(int r, int c) { const int st = (r >> 4) * 2 + (c >> 5), rr = r & 15, cc = c & 31, ob = rr * 64 + cc * 2; return st * 1024 + (ob ^ (((ob >> 9) & 1) << 5)); }
__host__ __device__ __forceinline__ void stage_rc(int b, int& R, int& C) { const int st = b / 1024, sb = b % 1024, swz = sb ^ (((sb >> 9) & 1) << 5); R = (st >> 1) * 16 + swz / 64; C = (st & 1) * 32 + (swz % 64) / 2; }
__host__ __device__ __forceinline__ int perm32(int rho) { const int n = rho >> 4, i = rho & 15; return 8 * (i >> 2) + 4 * n + (i & 3); }

struct Unit { int pm, pn, kind, nrows, arow, brow, orow0, gofs; };
struct Gemm { const bf16_t* A; const bf16_t* Bt; int K; const int* gtab; };

struct StaticOrder {
    int nM, nN, nwg, G, c, K;
    __device__ void init(int M, int N, int K_, int G_, int c_) { nM = M / BM; nN = N / BM; nwg = nM * nN; G = G_; c = c_; K = K_; }
    __device__ __forceinline__ Unit next(int i) const {
        Unit u; const long L = (long)i * G + c; const bool valid = L < nwg;
        int wgid = valid ? (int)L : 0; { const int q = nwg / NXCD, r = nwg % NXCD, xcd = wgid % NXCD, off = wgid / NXCD; wgid = (xcd < r ? xcd * (q + 1) : r * (q + 1) + (xcd - r) * q) + off; }
        const int nig = WGM * nN, gid = wgid / nig, fm = gid * WGM, gsz = (nM - fm) < WGM ? (nM - fm) : WGM;
        u.pm = fm + ((wgid % nig) % gsz); u.pn = (wgid % nig) / gsz;
        u.arow = u.pm * BM; u.brow = u.pn * BM; u.gofs = -1; u.nrows = BM; u.kind = 0; u.orow0 = u.pm * BM;
        if (!valid) u.pm = -1;
        return u;
    }
};

template <class Epi, class Sched, bool GATHER>
__device__ __forceinline__ void gemm_phase(LAS unsigned char* lds, const Gemm g, const Sched& S, const Epi& E) {
    const int tid = threadIdx.x, wid = __builtin_amdgcn_readfirstlane(tid >> 6), lane = tid & 63, wr = wid >> 2, wc = wid & 3, fr = lane & 15, fq = lane >> 4;
    const int K = g.K, nt = K / BK;
    unsigned voffA[2], voffB[2];
#pragma unroll
    for (int i = 0; i < 2; ++i) { int R, C; stage_rc(tid * 16 + i * 8192, R, C); const int Rb = Epi::PERM ? ((R & ~31) + perm32(R & 31)) : R;
        voffA[i] = (unsigned)(R * K + C) * 2u; voffB[i] = (unsigned)(Rb * K + C) * 2u; }
    const size_t kstep = (size_t)(BK * 2);
    const size_t hstep = (size_t)HALF * K * 2;
    const unsigned ldsw = (unsigned)wid * 1024u;
    const int aoff = lds_byte(wr * 64 + fr, fq * 8), boff = lds_byte(wc * 32 + fr, fq * 8);
#define PG8_SA(b, h) (((b) * 2 + (h)) * HTB)
#define PG8_SB(b, h) ((4 + (b) * 2 + (h)) * HTB)
#define PG8_STAGE(bufoff, gbase, voff) do { _Pragma("unroll") for (int _i = 0; _i < 2; ++_i) \
        __builtin_amdgcn_global_load_lds((const unsigned*)((const char*)(gbase) + (voff)[_i]), (LAS unsigned*)(lds + (bufoff) + ldsw + _i * 8192), 16, 0, 0); } while (0)
#define PG8_LDA(dst, b, h) do { _Pragma("unroll") for (int m = 0; m < 4; ++m) _Pragma("unroll") for (int k = 0; k < 2; ++k) dst[m][k] = *(const LAS bf16x8*)(lds + PG8_SA(b, h) + aoff + m * 2048 + k * 1024); } while (0)
#define PG8_LDB(dst, b, h) do { _Pragma("unroll") for (int n = 0; n < 2; ++n) _Pragma("unroll") for (int k = 0; k < 2; ++k) dst[n][k] = *(const LAS bf16x8*)(lds + PG8_SB(b, h) + boff + n * 2048 + k * 1024); } while (0)
#define PG8_MMA(ai, bj, At, Bt) do { __builtin_amdgcn_s_setprio(1); _Pragma("unroll") for (int m = 0; m < 4; ++m) _Pragma("unroll") for (int n = 0; n < 2; ++n) _Pragma("unroll") for (int k = 0; k < 2; ++k) \
        acc[ai][bj][m][n] = __builtin_amdgcn_mfma_f32_16x16x32_bf16(Bt[n][k], At[m][k], acc[ai][bj][m][n], 0, 0, 0); __builtin_amdgcn_s_setprio(0); } while (0)
#define PG8_WAIT_V(n) asm volatile("s_waitcnt vmcnt(" #n ")" ::: "memory")
#define PG8_WAIT_L(n) asm volatile("s_waitcnt lgkmcnt(" #n ")" ::: "memory")
#define PG8_BAR __builtin_amdgcn_s_barrier()
#define PG8_SCHED __builtin_amdgcn_sched_barrier(0)
    Unit cur = S.next(0), nxt; int ui = 0;
    if (cur.pm < 0) return;
    f32x4 acc[2][2][4][2];
#pragma unroll
    for (int a = 0; a < 2; ++a)
#pragma unroll
        for (int b = 0; b < 2; ++b)
#pragma unroll
            for (int m = 0; m < 4; ++m)
#pragma unroll
                for (int n = 0; n < 2; ++n) acc[a][b][m][n] = (f32x4){0.f, 0.f, 0.f, 0.f};
    bf16x8 At[4][2], B0[2][2], B1[2][2];
    unsigned cvo0[2] = {0u, 0u}, cvo1[2] = {0u, 0u}, nvo0[2] = {0u, 0u}, nvo1[2] = {0u, 0u};
    auto load_vo = [&](const Unit& u, unsigned (&v0)[2], unsigned (&v1)[2]) {
#pragma unroll
        for (int i = 0; i < 2; ++i) { int R, C; stage_rc(tid * 16 + i * 8192, R, C);
            int r0 = R, r1 = HALF + R;
            int t0, t1;
            if (u.gofs >= 0) { t0 = (r0 < u.nrows) ? g.gtab[u.gofs + r0] : ZROW; t1 = (r1 < u.nrows) ? g.gtab[u.gofs + r1] : ZROW; }
            else { t0 = u.orow0 + r0; t1 = u.orow0 + r1; }
            v0[i] = (unsigned)t0 * (unsigned)(K * 2) + (unsigned)(C * 2); v1[i] = (unsigned)t1 * (unsigned)(K * 2) + (unsigned)(C * 2); }
    };
    const size_t rowb = (size_t)K * 2;
    const char* cA = (const char*)g.A + (GATHER ? 0 : (size_t)cur.arow * rowb); const char* cB = (const char*)g.Bt + (size_t)cur.brow * rowb;
    if (GATHER) load_vo(cur, cvo0, cvo1);
    if (GATHER) {
        PG8_STAGE(PG8_SB(0, 0), cB, voffB); PG8_STAGE(PG8_SA(0, 0), cA, cvo0); PG8_STAGE(PG8_SB(0, 1), cB + hstep, voffB); PG8_STAGE(PG8_SA(0, 1), cA, cvo1);
    } else {
        PG8_STAGE(PG8_SB(0, 0), cB, voffB); PG8_STAGE(PG8_SA(0, 0), cA, voffA); PG8_STAGE(PG8_SB(0, 1), cB + hstep, voffB); PG8_STAGE(PG8_SA(0, 1), cA + hstep, voffA);
    }
    if (wr == 1) PG8_BAR;
    PG8_WAIT_V(4); PG8_BAR;
    if (GATHER) {
        PG8_STAGE(PG8_SB(1, 0), cB + kstep, voffB); PG8_STAGE(PG8_SA(1, 0), cA + kstep, cvo0); PG8_STAGE(PG8_SB(1, 1), cB + hstep + kstep, voffB);
    } else {
        PG8_STAGE(PG8_SB(1, 0), cB + kstep, voffB); PG8_STAGE(PG8_SA(1, 0), cA + kstep, voffA); PG8_STAGE(PG8_SB(1, 1), cB + hstep + kstep, voffB);
    }
    PG8_WAIT_V(6); PG8_BAR;
    for (;;) {
        nxt = S.next(ui + 1); const bool has_next = nxt.pm >= 0;
        const char* nA = GATHER ? cA : (has_next ? (const char*)g.A + (size_t)nxt.arow * rowb : cA); const char* nB = has_next ? (const char*)g.Bt + (size_t)nxt.brow * rowb : cB;
        if (GATHER) { if (has_next) load_vo(nxt, nvo0, nvo1); else { nvo0[0] = cvo0[0]; nvo0[1] = cvo0[1]; nvo1[0] = cvo1[0]; nvo1[1] = cvo1[1]; } }
        for (int t = 0; t < nt; t += 2) {
            const bool last = (t == nt - 2);
            const char* a1 = cA + (size_t)(t + 1) * kstep;
            const char* a2 = last ? nA : cA + (size_t)(t + 2) * kstep; const char* b2 = last ? nB : cB + (size_t)(t + 2) * kstep;
            const char* a3 = a2 + kstep; const char* b3 = b2 + kstep;
            unsigned s0[2], s1[2];
            if (GATHER) { s0[0] = last ? nvo0[0] : cvo0[0]; s0[1] = last ? nvo0[1] : cvo0[1]; s1[0] = last ? nvo1[0] : cvo1[0]; s1[1] = last ? nvo1[1] : cvo1[1]; }
            PG8_LDB(B0, 0, 0); PG8_SCHED; PG8_LDA(At, 0, 0);
            if (GATHER) PG8_STAGE(PG8_SA(1, 1), a1, cvo1); else PG8_STAGE(PG8_SA(1, 1), a1 + hstep, voffA);
            PG8_WAIT_L(8); PG8_BAR; PG8_WAIT_L(0); PG8_MMA(0, 0, At, B0); PG8_BAR; PG8_SCHED;
            PG8_LDB(B1, 0, 1); PG8_STAGE(PG8_SB(0, 0), b2, voffB);
            PG8_BAR; PG8_WAIT_L(0); PG8_MMA(0, 1, At, B1); PG8_BAR;
            PG8_LDA(At, 0, 1);
            if (GATHER) PG8_STAGE(PG8_SA(0, 0), a2, s0); else PG8_STAGE(PG8_SA(0, 0), a2, voffA);
            PG8_BAR; PG8_WAIT_L(0); PG8_MMA(1, 0, At, B0); PG8_BAR; PG8_SCHED;
            PG8_STAGE(PG8_SB(0, 1), b2 + hstep, voffB);
            PG8_WAIT_V(6); PG8_BAR; PG8_MMA(1, 1, At, B1); PG8_BAR;
            PG8_LDB(B0, 1, 0); PG8_SCHED; PG8_LDA(At, 1, 0);
            if (GATHER) PG8_STAGE(PG8_SA(0, 1), a2, s1); else PG8_STAGE(PG8_SA(0, 1), a2 + hstep, voffA);
            PG8_WAIT_L(8); PG8_BAR; PG8_WAIT_L(0); PG8_MMA(0, 0, At, B0); PG8_BAR; PG8_SCHED;
            PG8_LDB(B1, 1, 1); PG8_STAGE(PG8_SB(1, 0), b3, voffB);
            PG8_BAR; PG8_WAIT_L(0); PG8_MMA(0, 1, At, B1); PG8_BAR;
            PG8_LDA(At, 1, 1);
            if (GATHER) PG8_STAGE(PG8_SA(1, 0), a3, s0); else PG8_STAGE(PG8_SA(1, 0), a3, voffA);
            PG8_BAR; PG8_WAIT_L(0); PG8_MMA(1, 0, At, B0); PG8_BAR; PG8_SCHED;
            PG8_STAGE(PG8_SB(1, 1), b3 + hstep, voffB);
            PG8_WAIT_V(6); PG8_BAR; PG8_MMA(1, 1, At, B1); PG8_BAR;
        }
        E(acc, cur, wr, wc, fr, fq);
        if (!has_next) break;
#pragma unroll
        for (int a = 0; a < 2; ++a)
#pragma unroll
            for (int b = 0; b < 2; ++b)
#pragma unroll
                for (int m = 0; m < 4; ++m)
#pragma unroll
                    for (int n = 0; n < 2; ++n) acc[a][b][m][n] = (f32x4){0.f, 0.f, 0.f, 0.f};
        cur = nxt; cA = nA; cB = nB; ++ui;
        if (GATHER) { cvo0[0] = nvo0[0]; cvo0[1] = nvo0[1]; cvo1[0] = nvo1[0]; cvo1[1] = nvo1[1]; }
    }
    PG8_WAIT_V(0);
    if (wr == 0) PG8_BAR;
    PG8_BAR;
#undef PG8_SA
#undef PG8_SB
#undef PG8_STAGE
#undef PG8_LDA
#undef PG8_LDB
#undef PG8_MMA
#undef PG8_WAIT_V
#undef PG8_WAIT_L
#undef PG8_BAR
#undef PG8_SCHED
}
}
using pg8::Unit;

typedef f32x4 Acc[2][2][4][2];

template <int O0, int O1, int O2, int O3>
__device__ __forceinline__ void ld4x16(const void* p, f32x4& a, f32x4& b, f32x4& c, f32x4& d) {
    asm volatile("global_load_dwordx4 %0, %4, off offset:%5\n\tglobal_load_dwordx4 %1, %4, off offset:%6\n\tglobal_load_dwordx4 %2, %4, off offset:%7\n\tglobal_load_dwordx4 %3, %4, off offset:%8\n\ts_waitcnt vmcnt(0)"
                 : "=&v"(a), "=&v"(b), "=&v"(c), "=&v"(d) : "v"(p), "i"(O0), "i"(O1), "i"(O2), "i"(O3) : "memory");
}
template <int O0, int O1, int O2, int O3>
__device__ __forceinline__ void ld4x16_4x8(const void* p, f32x4& a, f32x4& b, f32x4& c, f32x4& d, const void* q, u32x2& e, u32x2& f, u32x2& g, u32x2& h) {
    asm volatile("global_load_dwordx4 %0, %8, off offset:%10\n\tglobal_load_dwordx4 %1, %8, off offset:%11\n\tglobal_load_dwordx4 %2, %8, off offset:%12\n\tglobal_load_dwordx4 %3, %8, off offset:%13\n\t"
                 "global_load_dwordx2 %4, %9, off offset:%14\n\tglobal_load_dwordx2 %5, %9, off offset:%15\n\tglobal_load_dwordx2 %6, %9, off offset:%16\n\tglobal_load_dwordx2 %7, %9, off offset:%17\n\ts_waitcnt vmcnt(0)"
                 : "=&v"(a), "=&v"(b), "=&v"(c), "=&v"(d), "=&v"(e), "=&v"(f), "=&v"(g), "=&v"(h)
                 : "v"(p), "v"(q), "i"(O0), "i"(O1), "i"(O2), "i"(O3), "i"(O0 / 2), "i"(O1 / 2), "i"(O2 / 2), "i"(O3 / 2) : "memory");
}
struct EpiQKVU {
    static constexpr bool PERM = true;
    bf16_t* zq; float* u;
    __device__ __forceinline__ void operator()(const Acc& acc, const Unit& un, int wr, int wc, int fr, int fq) const {
        const int row0 = un.pm * 256 + wr * 64 + fr, col0 = un.pn * 256 + wc * 32 + 8 * fq;
        if (un.pn < 12) {
#pragma unroll
            for (int ai = 0; ai < 2; ++ai)
#pragma unroll
                for (int m = 0; m < 4; ++m) { bf16_t* rowp = zq + (size_t)(row0 + ai * 128 + m * 16) * 3072 + col0;
#pragma unroll
                    for (int bj = 0; bj < 2; ++bj) { const f32x4 v0 = acc[ai][bj][m][0], v1 = acc[ai][bj][m][1];
                        u32x4 w; w.x = cvt_pk_bf16(v0[0], v0[1]); w.y = cvt_pk_bf16(v0[2], v0[3]); w.z = cvt_pk_bf16(v1[0], v1[1]); w.w = cvt_pk_bf16(v1[2], v1[3]);
                        *(u32x4*)(rowp + bj * 128) = w; } }
        } else {
#pragma unroll
            for (int ai = 0; ai < 2; ++ai)
#pragma unroll
                for (int m = 0; m < 4; ++m) { float* rowp = u + (size_t)(row0 + ai * 128 + m * 16) * 1024 + (col0 - 3072);
#pragma unroll
                    for (int bj = 0; bj < 2; ++bj) { *(f32x4*)(rowp + bj * 128) = acc[ai][bj][m][0]; *(f32x4*)(rowp + bj * 128 + 4) = acc[ai][bj][m][1]; } }
        }
    }
};
struct EpiGLU {
    static constexpr bool PERM = true;
    const bf16_t* __restrict__ y; bf16_t* __restrict__ mix;
    __device__ __forceinline__ void operator()(const Acc& acc, const Unit& un, int wr, int wc, int fr, int fq) const {
        const int row0 = un.pm * 256 + wr * 64 + fr, col0 = un.pn * 256 + wc * 32 + 8 * fq;
#pragma unroll
        for (int ai = 0; ai < 2; ++ai)
#pragma unroll
            for (int m = 0; m < 4; ++m) { const size_t row = (size_t)(row0 + ai * 128 + m * 16);
#pragma unroll
                for (int bj = 0; bj < 2; ++bj) { const f32x4 v0 = acc[ai][bj][m][0], v1 = acc[ai][bj][m][1];
                    const u32x4 yv = *(const u32x4*)(y + row * 1024 + col0 + bj * 128);
                    u32x4 w;
                    w.x = cvt_pk_bf16(bf_lo(yv.x) * sigmoidf_(v0[0]), bf_hi(yv.x) * sigmoidf_(v0[1]));
                    w.y = cvt_pk_bf16(bf_lo(yv.y) * sigmoidf_(v0[2]), bf_hi(yv.y) * sigmoidf_(v0[3]));
                    w.z = cvt_pk_bf16(bf_lo(yv.z) * sigmoidf_(v1[0]), bf_hi(yv.z) * sigmoidf_(v1[1]));
                    w.w = cvt_pk_bf16(bf_lo(yv.w) * sigmoidf_(v1[2]), bf_hi(yv.w) * sigmoidf_(v1[3]));
                    *(u32x4*)(mix + row * 2048 + 1024 + col0 + bj * 128) = w; } }
    }
};
struct EpiRes {
    static constexpr bool PERM = false;
    const float* x; float* h1;
    __device__ __forceinline__ void operator()(const Acc& acc, const Unit& un, int wr, int wc, int fr, int fq) const {
        const int row0 = un.pm * 256 + wr * 64 + fr, col0 = un.pn * 256 + wc * 32 + 4 * fq;
#pragma unroll
        for (int ai = 0; ai < 2; ++ai)
#pragma unroll
            for (int m = 0; m < 4; ++m) { const size_t ro = (size_t)(row0 + ai * 128 + m * 16) * 2048 + col0;
                f32x4 x00, x01, x10, x11; ld4x16<0, 64, 512, 576>(x + ro, x00, x01, x10, x11);
                *(f32x4*)(h1 + ro) = x00 + acc[ai][0][m][0]; *(f32x4*)(h1 + ro + 16) = x01 + acc[ai][0][m][1];
                *(f32x4*)(h1 + ro + 128) = x10 + acc[ai][1][m][0]; *(f32x4*)(h1 + ro + 144) = x11 + acc[ai][1][m][1]; }
    }
};
struct EpiSwiGLU {
    static constexpr bool PERM = true;
    bf16_t* H; bf16_t* Hs;
    __device__ __forceinline__ void operator()(const Acc& acc, const Unit& un, int wr, int wc, int fr, int fq) const {
        bf16_t* base = un.kind ? Hs : H;
        const size_t row0 = (size_t)un.orow0 + wr * 64 + fr; const int col0 = un.pn * 128 + wc * 32 + 8 * fq;
#pragma unroll
        for (int ai = 0; ai < 2; ++ai)
#pragma unroll
            for (int m = 0; m < 4; ++m) { const f32x4 g0 = acc[ai][0][m][0], g1 = acc[ai][0][m][1], u0 = acc[ai][1][m][0], u1 = acc[ai][1][m][1];
                u32x4 w;
                w.x = cvt_pk_bf16(g0[0] * sigmoidf_(g0[0]) * u0[0], g0[1] * sigmoidf_(g0[1]) * u0[1]);
                w.y = cvt_pk_bf16(g0[2] * sigmoidf_(g0[2]) * u0[2], g0[3] * sigmoidf_(g0[3]) * u0[3]);
                w.z = cvt_pk_bf16(g1[0] * sigmoidf_(g1[0]) * u1[0], g1[1] * sigmoidf_(g1[1]) * u1[1]);
                w.w = cvt_pk_bf16(g1[2] * sigmoidf_(g1[2]) * u1[2], g1[3] * sigmoidf_(g1[3]) * u1[3]);
                *(u32x4*)(base + (row0 + ai * 128 + m * 16) * 512 + col0) = w; }
    }
};
struct EpiDown {
    static constexpr bool PERM = true;
    bf16_t* Y; bf16_t* Ysh;
    __device__ __forceinline__ void operator()(const Acc& acc, const Unit& un, int wr, int wc, int fr, int fq) const {
        const int col0 = un.pn * 256 + wc * 32 + 8 * fq; bf16_t* base = (un.kind ? Ysh : Y) + (size_t)un.orow0 * 2048 + col0;
#pragma unroll
        for (int ai = 0; ai < 2; ++ai)
#pragma unroll
            for (int m = 0; m < 4; ++m) { const int r = ai * 128 + wr * 64 + m * 16 + fr;
                if (r < un.nrows) { bf16_t* rowp = base + (size_t)r * 2048;
#pragma unroll
                    for (int bj = 0; bj < 2; ++bj) { const f32x4 v0 = acc[ai][bj][m][0], v1 = acc[ai][bj][m][1];
                        u32x4 w; w.x = cvt_pk_bf16(v0[0], v0[1]); w.y = cvt_pk_bf16(v0[2], v0[3]); w.z = cvt_pk_bf16(v1[0], v1[1]); w.w = cvt_pk_bf16(v1[2], v1[3]);
                        *(u32x4*)(rowp + bj * 128) = w; } } }
    }
};
struct EpiBf16 {
    static constexpr bool PERM = true;
    bf16_t* O; int ldo;
    __device__ __forceinline__ void operator()(const Acc& acc, const Unit& un, int wr, int wc, int fr, int fq) const {
        const int row0 = un.pm * 256 + wr * 64 + fr, col0 = un.pn * 256 + wc * 32 + 8 * fq;
#pragma unroll
        for (int ai = 0; ai < 2; ++ai)
#pragma unroll
            for (int m = 0; m < 4; ++m) { bf16_t* rowp = O + (size_t)(row0 + ai * 128 + m * 16) * ldo + col0;
#pragma unroll
                for (int bj = 0; bj < 2; ++bj) { const f32x4 v0 = acc[ai][bj][m][0], v1 = acc[ai][bj][m][1];
                    u32x4 w; w.x = cvt_pk_bf16(v0[0], v0[1]); w.y = cvt_pk_bf16(v0[2], v0[3]); w.z = cvt_pk_bf16(v1[0], v1[1]); w.w = cvt_pk_bf16(v1[2], v1[3]);
                    *(u32x4*)(rowp + bj * 128) = w; } }
    }
};
struct EpiPle {
    static constexpr bool PERM = false;
    float* out; const bf16_t* proj; const float* h2;
    __device__ __forceinline__ void operator()(const Acc& acc, const Unit& un, int wr, int wc, int fr, int fq) const {
        const int row0 = un.pm * 256 + wr * 64 + fr, col0 = un.pn * 256 + wc * 32 + 4 * fq;
#pragma unroll
        for (int ai = 0; ai < 2; ++ai)
#pragma unroll
            for (int m = 0; m < 4; ++m) { const size_t ro = (size_t)(row0 + ai * 128 + m * 16) * 2048 + col0;
                f32x4 hv[4]; u32x2 pv[4]; ld4x16_4x8<0, 64, 512, 576>(h2 + ro, hv[0], hv[1], hv[2], hv[3], proj + ro, pv[0], pv[1], pv[2], pv[3]);
#pragma unroll
                for (int q = 0; q < 4; ++q) { const int bj = q >> 1, n = q & 1; const f32x4 a = acc[ai][bj][m][n]; f32x4 r;
                    r[0] = hv[q][0] + sigmoidf_(a[0]) * bf_lo(pv[q].x); r[1] = hv[q][1] + sigmoidf_(a[1]) * bf_hi(pv[q].x);
                    r[2] = hv[q][2] + sigmoidf_(a[2]) * bf_lo(pv[q].y); r[3] = hv[q][3] + sigmoidf_(a[3]) * bf_hi(pv[q].y);
                    *(f32x4*)(out + ro + bj * 128 + n * 16) = r; } }
    }
};

struct MoeSched {
    int G, c, n_rt, NPN, K; bool down;
    const LAS int* rt_e; const LAS int* rt_j; const LAS int* rt_n;
    __device__ __forceinline__ Unit next(int i) const {
        Unit u; const int NRT = n_rt + 32, per = (NRT + 7) >> 3, SL = G >> 3, x = c & 7, s = c >> 3;
        const int q = i * SL + s, rl = q / NPN, rtg = x * per + rl;
        const bool valid = s < SL && rl < per && rtg < NRT, routed = valid && rtg < n_rt;
        const int rt = routed ? rtg : 0, spm = (valid && !routed) ? rtg - n_rt : 0;
        const int e = __builtin_amdgcn_readfirstlane(rt_e[rt]), j = __builtin_amdgcn_readfirstlane(rt_j[rt]);
        const int rem = __builtin_amdgcn_readfirstlane(rt_n[rt]);
        const int Lr = q % NPN;
        u.kind = routed ? 0 : 1;
        u.pn = Lr;
        u.pm = routed ? rt : spm;
        u.nrows = routed ? rem : 256;
        const int ee = routed ? e : NE;
        if (!down) {
            u.arow = 0; u.gofs = routed ? (e * CAP + j * 256) : -1;
            u.brow = ee * 1024 + u.pn * 256;
            u.orow0 = routed ? rt * 256 : spm * 256;
        } else {
            u.gofs = -1;
            u.arow = routed ? rt * 256 : 65536 + spm * 256;
            u.brow = ee * 2048 + u.pn * 256;
            u.orow0 = routed ? rt * 256 : spm * 256;
        }
        if (!valid) u.pm = -1;
        return u;
    }
};

__device__ __forceinline__ void cvt_tile(const float* __restrict__ src, int ldw, int k0, int n0, const float* __restrict__ gain, bf16_t* __restrict__ dst, int ldd, int dk0,
                                         int inter, int roff, LAS float* lt) {
    const int tid = threadIdx.x, c4 = tid & 63, r8 = tid >> 6;
    f32x4 v[8];
#pragma unroll
    for (int i = 0; i < 8; ++i) v[i] = *(const f32x4*)(src + (size_t)(k0 + r8 + 8 * i) * ldw + n0 + 4 * c4);
#pragma unroll
    for (int i = 0; i < 8; ++i) { const int k = r8 + 8 * i; const float gsc = gain ? gain[k0 + k] : 1.0f; LAS float* q = lt + k * 257 + 4 * c4;
        q[0] = v[i][0] * gsc; q[1] = v[i][1] * gsc; q[2] = v[i][2] * gsc; q[3] = v[i][3] * gsc; }
    __syncthreads();
#pragma unroll
    for (int i = 0; i < 4; ++i) { const int q = tid + 512 * i, kg = q & 7, n = q >> 3; const LAS float* s = lt + (8 * kg) * 257 + n;
        u32x4 w; w.x = cvt_pk_bf16(s[0], s[257]); w.y = cvt_pk_bf16(s[2 * 257], s[3 * 257]); w.z = cvt_pk_bf16(s[4 * 257], s[5 * 257]); w.w = cvt_pk_bf16(s[6 * 257], s[7 * 257]);
        const int ng = n0 + n; const int drow = inter ? ((ng >> 7) * 256 + roff + (ng & 127)) : ng;
        *(u32x4*)(dst + (size_t)drow * ldd + dk0 + k0 + 8 * kg) = w; }
    __syncthreads();
}
__device__ __forceinline__ void cvt_job(long& base, const float* src, int K, int N, const float* gain, bf16_t* dst, int ldd, int dk0, int inter, int roff, LAS float* lt) {
    const int nk = K / 64, nn = N / 256, ntl = nk * nn, G = gridDim.x;
    int t = (int)(((long)blockIdx.x - base % G + G) % G);
    for (; t < ntl; t += G) { const int kt = t % nk, ntile = t / nk; cvt_tile(src, N, kt * 64, ntile * 256, gain, dst, ldd, dk0, inter, roff, lt); }
    base += ntl;
}
__device__ void phase_prologue(const Params& P, LAS unsigned char* lds) {
    LAS float* lt = (LAS float*)lds;
    const int tid = threadIdx.x, wid = tid >> 6, lane = tid & 63, G = gridDim.x;
    for (int row = blockIdx.x * 8 + wid; row < T_; row += G * 8) {
        const float* xr = P.x + (size_t)row * DM; f32x4 v[8]; float ss = 0.f;
#pragma unroll
        for (int i = 0; i < 8; ++i) { v[i] = *(const f32x4*)(xr + 4 * lane + 256 * i); ss += v[i][0] * v[i][0] + v[i][1] * v[i][1] + v[i][2] * v[i][2] + v[i][3] * v[i][3]; }
        ss = wave_sum(ss); const float r = rsqrtf(ss * (1.0f / DM) + EPS);
#pragma unroll
        for (int i = 0; i < 8; ++i) { u32x2 w; w.x = cvt_pk_bf16(v[i][0] * r, v[i][1] * r); w.y = cvt_pk_bf16(v[i][2] * r, v[i][3] * r); *(u32x2*)(P.R1 + (size_t)row * DM + 4 * lane + 256 * i) = w; }
    }
    if (blockIdx.x == 0) { for (int i = tid; i < DM / 2; i += 512) ((unsigned*)(P.R1 + (size_t)ZROW * DM))[i] = 0u; }
    for (size_t i = (size_t)blockIdx.x * 512 + tid; i < (size_t)T_ * DPLE / 8; i += (size_t)G * 512) { const f32x4 a = *(const f32x4*)(P.p + i * 8), b2 = *(const f32x4*)(P.p + i * 8 + 4);
        u32x4 w; w.x = cvt_pk_bf16(a[0], a[1]); w.y = cvt_pk_bf16(a[2], a[3]); w.z = cvt_pk_bf16(b2[0], b2[1]); w.w = cvt_pk_bf16(b2[2], b2[3]); *(u32x4*)(P.pb + i * 8) = w; }
    for (int i = blockIdx.x * 512 + tid; i < NG * NP; i += G * 512) {
        const int g = i / NP;
        const float lr = P.lam_re[i], li = P.lam_im[i]; const float dt = expf(P.log_dt[g]);
        const double mag = exp((double)lr * (double)dt), ang = (double)li * (double)dt;
        const float ar = (float)(mag * cos(ang)), ai = (float)(mag * sin(ang));
        const double magL = exp((double)lr * (double)dt * SCH), angL = ang * SCH;
        P.abar[i] = make_float2(ar, ai); P.aL[i] = make_float2((float)(magL * cos(angL)), (float)(magL * sin(angL)));
        const float nr = ar - 1.0f, ni = ai, den = lr * lr + li * li;
        const float cr = (nr * lr + ni * li) / den, ci = (ni * lr - nr * li) / den;
#pragma unroll
        for (int h = 0; h < GH; ++h) { const float br = P.b_re[(size_t)i * GH + h], bi = P.b_im[(size_t)i * GH + h];
            P.bbar[(size_t)i * GH + h] = make_float2(cr * br - ci * bi, cr * bi + ci * br); }
    }
    for (int i = blockIdx.x * 512 + tid; i < NE * DM; i += G * 512) { const int e = i / DM, k = i % DM; const float w = P.w_router[(size_t)k * NE + e] * P.norm_ffn[k];
        const unsigned hw = cvt_pk_bf16(w, 0.f); const float hf = bf_lo(hw); P.Wr_hi[i] = (bf16_t)(hw & 0xffffu); P.Wr_lo[i] = (bf16_t)(cvt_pk_bf16(w - hf, 0.f) & 0xffffu); }
    long base = 0;
    cvt_job(base, P.w_in, 2048, 4096, P.norm_mix, P.Wt_in, 2048, 0, 0, 0, lt);
    cvt_job(base, P.w_glu, 1024, 1024, nullptr, P.Wt_glu, 1024, 0, 0, 0, lt);
    cvt_job(base, P.w_out, 1024, 2048, P.attn_out_norm, P.Wt_out, 2048, 0, 0, 0, lt);
    cvt_job(base, P.w_out + (size_t)1024 * 2048, 1024, 2048, P.ssm_out_norm, P.Wt_out, 2048, 1024, 0, 0, lt);
    cvt_job(base, P.w_sg, 2048, 512, nullptr, P.Wt_egu + (size_t)NE * 1024 * 2048, 2048, 0, 1, 0, lt);
    cvt_job(base, P.w_su, 2048, 512, nullptr, P.Wt_egu + (size_t)NE * 1024 * 2048, 2048, 0, 1, 128, lt);
    cvt_job(base, P.w_sd, 512, 2048, nullptr, P.Wt_ed + (size_t)NE * 2048 * 512, 512, 0, 0, 0, lt);
    cvt_job(base, P.w_pg, 2048, 2048, P.norm_ple, P.Wt_pg, 2048, 0, 0, 0, lt);
    cvt_job(base, P.w_pp, 256, 2048, nullptr, P.Wt_pp, 256, 0, 0, 0, lt);
    {
        const int ntl = NE * 192; int t = (int)(((long)blockIdx.x - base % G + G) % G);
        for (; t < ntl; t += G) { const int e = t / 192, r = t % 192;
            if (r < 128) { const int up = r >> 6, q = r & 63, kt = q & 31, ntile = q >> 5;
                cvt_tile((up ? P.w_eu : P.w_eg) + (size_t)e * 2048 * 512, 512, kt * 64, ntile * 256, nullptr, P.Wt_egu + (size_t)e * 1024 * 2048, 2048, 0, 1, up ? 128 : 0, lt); }
            else { const int q = r - 128, kt = q & 7, ntile = q >> 3;
                cvt_tile(P.w_ed + (size_t)e * 512 * 2048, 2048, kt * 64, ntile * 256, nullptr, P.Wt_ed + (size_t)e * 2048 * 512, 512, 0, 0, 0, lt); } }
    }
}

#define KSWZ(row, colB) ((row) * 256 + ((colB) ^ (((row) & 7) << 4)))
#define SBAR() __builtin_amdgcn_sched_barrier(0)
__device__ __forceinline__ int crow(int r, int hi) { return (r & 3) + 8 * (r >> 2) + 4 * hi; }
__device__ __forceinline__ void qkt(f32x16& p0, f32x16& p1, const LAS unsigned char* Ks, const bf16x8* qr, int r32, int hi) {
    p0 = f32x16{}; p1 = f32x16{};
#pragma unroll
    for (int d0 = 0; d0 < 8; ++d0) { const int cb = (d0 * 16 + hi * 8) * 2;
        const bf16x8 b0 = *(const LAS bf16x8*)(Ks + KSWZ(r32, cb));
        const bf16x8 b1 = *(const LAS bf16x8*)(Ks + KSWZ(32 + r32, cb));
        p0 = __builtin_amdgcn_mfma_f32_32x32x16_bf16(b0, qr[d0], p0, 0, 0, 0);
        p1 = __builtin_amdgcn_mfma_f32_32x32x16_bf16(b1, qr[d0], p1, 0, 0, 0); }
}
__device__ __forceinline__ int v_st(int k, int c) { const int kk = (k & ~0xC) | ((k & 4) << 1) | ((k & 8) >> 1); return ((kk >> 3) * 4 + (c >> 5)) * 512 + ((kk & 7) * 32 + (c & 31)) * 2; }
__device__ __forceinline__ int v_rd_base(int lane) { return ((lane & 3) << 3) | (((lane >> 2) & 3) << 6) | (((lane >> 4) & 1) << 5) | (((lane >> 5) & 1) << 8); }
constexpr int v_rd_off(int d0, int ks, int half) { return d0 * 512 + ks * 4096 + half * 2048; }
template <int D0> __device__ __forceinline__ void pv_one(f32x16& od, int vb, bf16x8 pa0, bf16x8 pa1, bf16x8 pa2, bf16x8 pa3) {
    s16x4 l0, h0, l1, h1, l2, h2, l3, h3;
    asm volatile("ds_read_b64_tr_b16 %0, %8 offset:%9\n\t"
                 "ds_read_b64_tr_b16 %1, %8 offset:%10\n\t"
                 "ds_read_b64_tr_b16 %2, %8 offset:%11\n\t"
                 "ds_read_b64_tr_b16 %3, %8 offset:%12\n\t"
                 "ds_read_b64_tr_b16 %4, %8 offset:%13\n\t"
                 "ds_read_b64_tr_b16 %5, %8 offset:%14\n\t"
                 "ds_read_b64_tr_b16 %6, %8 offset:%15\n\t"
                 "ds_read_b64_tr_b16 %7, %8 offset:%16\n\t"
                 "s_waitcnt lgkmcnt(0)"
                 : "=&v"(l0), "=&v"(h0), "=&v"(l1), "=&v"(h1), "=&v"(l2), "=&v"(h2), "=&v"(l3), "=&v"(h3)
                 : "v"(vb), "i"(v_rd_off(D0, 0, 0)), "i"(v_rd_off(D0, 0, 1)), "i"(v_rd_off(D0, 1, 0)), "i"(v_rd_off(D0, 1, 1)),
                   "i"(v_rd_off(D0, 2, 0)), "i"(v_rd_off(D0, 2, 1)), "i"(v_rd_off(D0, 3, 0)), "i"(v_rd_off(D0, 3, 1))
                 : "memory");
    SBAR();
#define PK(L, H) (bf16x8){L[0], L[1], L[2], L[3], H[0], H[1], H[2], H[3]}
    od = __builtin_amdgcn_mfma_f32_32x32x16_bf16(pa0, PK(l0, h0), od, 0, 0, 0);
    od = __builtin_amdgcn_mfma_f32_32x32x16_bf16(pa1, PK(l1, h1), od, 0, 0, 0);
    od = __builtin_amdgcn_mfma_f32_32x32x16_bf16(pa2, PK(l2, h2), od, 0, 0, 0);
    od = __builtin_amdgcn_mfma_f32_32x32x16_bf16(pa3, PK(l3, h3), od, 0, 0, 0);
#undef PK
}
__device__ __forceinline__ float softplus_(float z) { return fmaxf(z, 0.f) + __logf(1.0f + __expf(-fabsf(z))); }

__device__ void attn_unit(const Params& P, int unit, LAS unsigned char* lds) {
    const int qb = unit & 7, h = (unit >> 3) & 7, b = unit >> 6;
    const int tid = threadIdx.x, wid = tid >> 6, lane = tid & 63, r32 = lane & 31, hi = lane >> 5;
    const int q0 = qb * 256; const size_t tokbase = (size_t)b * SEQ;
    LAS unsigned char* K_lds = lds; LAS unsigned char* V_lds = lds + 16384; volatile LAS int* flags = (volatile LAS int*)(lds + LDS_FLAGS);
    const int tq = q0 + wid * 32 + r32;
    bf16x8 qr[8];
    {
        const bf16_t* qp = P.zq + (tokbase + tq) * 3072 + h * HD + hi * 8;
        u32x4 raw[8]; float ss = 0.f;
#pragma unroll
        for (int d0 = 0; d0 < 8; ++d0) { raw[d0] = *(const u32x4*)(qp + d0 * 16);
            const float a0 = bf_lo(raw[d0].x), a1 = bf_hi(raw[d0].x), a2 = bf_lo(raw[d0].y), a3 = bf_hi(raw[d0].y), a4 = bf_lo(raw[d0].z), a5 = bf_hi(raw[d0].z), a6 = bf_lo(raw[d0].w), a7 = bf_hi(raw[d0].w);
            ss += a0 * a0 + a1 * a1 + a2 * a2 + a3 * a3 + a4 * a4 + a5 * a5 + a6 * a6 + a7 * a7; }
        ss += __shfl_xor(ss, 32);
        const float rq = rsqrtf(ss * (1.0f / HD) + EPS) * 0.088388347648318440f;
#pragma unroll
        for (int d0 = 0; d0 < 8; ++d0) { const float* gq = P.q_norm + d0 * 16 + hi * 8; const f32x4 g0 = *(const f32x4*)gq, g1 = *(const f32x4*)(gq + 4);
            u32x4 w;
            w.x = cvt_pk_bf16(bf_lo(raw[d0].x) * rq * g0[0], bf_hi(raw[d0].x) * rq * g0[1]); w.y = cvt_pk_bf16(bf_lo(raw[d0].y) * rq * g0[2], bf_hi(raw[d0].y) * rq * g0[3]);
            w.z = cvt_pk_bf16(bf_lo(raw[d0].z) * rq * g1[0], bf_hi(raw[d0].z) * rq * g1[1]); w.w = cvt_pk_bf16(bf_lo(raw[d0].w) * rq * g1[2], bf_hi(raw[d0].w) * rq * g1[3]);
            qr[d0] = *(bf16x8*)&w; }
    }
    const int sr = tid >> 4, sc = (tid & 15) * 8, vst0 = v_st(sr, sc), vst1 = v_st(32 + sr, sc);
    const int vb0 = (int)(unsigned)(uintptr_t)V_lds + v_rd_base(lane);
    const f32x4 gk0 = *(const f32x4*)(P.k_norm + sc), gk1 = *(const f32x4*)(P.k_norm + sc + 4);
    f32x16 o[4]; o[0] = f32x16{}; o[1] = f32x16{}; o[2] = f32x16{}; o[3] = f32x16{};
    float Rc = 0.f; bool done = false;
    const int tw_max = q0 + wid * 32 + 31;
    if (tid < 8) flags[tid] = 0;
    for (int kt = (q0 >> 6) + 3; kt >= 0; --kt) {
        {
            const bf16_t* kp0 = P.zq + (tokbase + kt * 64 + sr) * 3072 + 1024 + h * HD + sc; const bf16_t* kp1 = kp0 + (size_t)32 * 3072;
            const u32x4 k0 = *(const u32x4*)kp0, k1 = *(const u32x4*)kp1, v0 = *(const u32x4*)(kp0 + 1024), v1 = *(const u32x4*)(kp1 + 1024);
            float s0 = bf_lo(k0.x) * bf_lo(k0.x) + bf_hi(k0.x) * bf_hi(k0.x) + bf_lo(k0.y) * bf_lo(k0.y) + bf_hi(k0.y) * bf_hi(k0.y) + bf_lo(k0.z) * bf_lo(k0.z) + bf_hi(k0.z) * bf_hi(k0.z) + bf_lo(k0.w) * bf_lo(k0.w) + bf_hi(k0.w) * bf_hi(k0.w);
            float s1 = bf_lo(k1.x) * bf_lo(k1.x) + bf_hi(k1.x) * bf_hi(k1.x) + bf_lo(k1.y) * bf_lo(k1.y) + bf_hi(k1.y) * bf_hi(k1.y) + bf_lo(k1.z) * bf_lo(k1.z) + bf_hi(k1.z) * bf_hi(k1.z) + bf_lo(k1.w) * bf_lo(k1.w) + bf_hi(k1.w) * bf_hi(k1.w);
#pragma unroll
            for (int o_ = 8; o_ >= 1; o_ >>= 1) { s0 += __shfl_xor(s0, o_); s1 += __shfl_xor(s1, o_); }
            const float r0 = rsqrtf(s0 * (1.0f / HD) + EPS), r1 = rsqrtf(s1 * (1.0f / HD) + EPS);
            u32x4 w0, w1;
            w0.x = cvt_pk_bf16(bf_lo(k0.x) * r0 * gk0[0], bf_hi(k0.x) * r0 * gk0[1]); w0.y = cvt_pk_bf16(bf_lo(k0.y) * r0 * gk0[2], bf_hi(k0.y) * r0 * gk0[3]);
            w0.z = cvt_pk_bf16(bf_lo(k0.z) * r0 * gk1[0], bf_hi(k0.z) * r0 * gk1[1]); w0.w = cvt_pk_bf16(bf_lo(k0.w) * r0 * gk1[2], bf_hi(k0.w) * r0 * gk1[3]);
            w1.x = cvt_pk_bf16(bf_lo(k1.x) * r1 * gk0[0], bf_hi(k1.x) * r1 * gk0[1]); w1.y = cvt_pk_bf16(bf_lo(k1.y) * r1 * gk0[2], bf_hi(k1.y) * r1 * gk0[3]);
            w1.z = cvt_pk_bf16(bf_lo(k1.z) * r1 * gk1[0], bf_hi(k1.z) * r1 * gk1[1]); w1.w = cvt_pk_bf16(bf_lo(k1.w) * r1 * gk1[2], bf_hi(k1.w) * r1 * gk1[3]);
            *(LAS u32x4*)(K_lds + KSWZ(sr, sc * 2)) = w0; *(LAS u32x4*)(K_lds + KSWZ(32 + sr, sc * 2)) = w1;
            *(LAS u32x4*)(V_lds + vst0) = v0; *(LAS u32x4*)(V_lds + vst1) = v1;
        }
        __syncthreads();
        if (!done && kt * 64 < tw_max) {
            f32x16 p0, p1; qkt(p0, p1, K_lds, qr, r32, hi);
            const int kb = kt * 64;
            float gs[8], pg[8], lz[32];
#pragma unroll
            for (int hf = 0; hf < 2; ++hf)
#pragma unroll
                for (int g = 0; g < 4; ++g) { float s = 0.f;
#pragma unroll
                    for (int i = 0; i < 4; ++i) { const int r = 4 * g + i; const float z = hf ? p1[r] : p0[r]; const bool causal = (kb + 32 * hf + crow(r, hi)) < tq;
                        const float spv = softplus_(z); lz[hf * 16 + r] = causal ? (z - spv) : -1e30f; const float spm = causal ? spv : 0.f;
                        if (hf) p1[r] = spm; else p0[r] = spm; s += spm; }
                    gs[hf * 4 + g] = s; }
#pragma unroll
            for (int i = 0; i < 8; ++i) pg[i] = __shfl_xor(gs[i], 32);
            float suf = 0.f;
            float aft[8];
#pragma unroll
            for (int i = 7; i >= 0; --i) { aft[i] = Rc + suf + (hi == 0 ? pg[i] : 0.f); suf += gs[i] + pg[i]; }
            Rc += suf;
#pragma unroll
            for (int hf = 0; hf < 2; ++hf)
#pragma unroll
                for (int g = 0; g < 4; ++g) { float a = aft[hf * 4 + g];
#pragma unroll
                    for (int i = 3; i >= 0; --i) { const int r = 4 * g + i; const float spm = hf ? p1[r] : p0[r]; const float wv = __expf(lz[hf * 16 + r] - a); a += spm;
                        if (hf) p1[r] = wv; else p0[r] = wv; } }
            bf16x8 pa0, pa1, pa2, pa3;
#define PK4(Pv, BASE, OUT) do { unsigned a0 = cvt_pk_bf16(Pv[BASE + 0], Pv[BASE + 1]), a1 = cvt_pk_bf16(Pv[BASE + 2], Pv[BASE + 3]);   \
    unsigned b0 = cvt_pk_bf16(Pv[BASE + 4], Pv[BASE + 5]), b1 = cvt_pk_bf16(Pv[BASE + 6], Pv[BASE + 7]);                              \
    auto r0 = __builtin_amdgcn_permlane32_swap(a0, b0, false, false); auto r1 = __builtin_amdgcn_permlane32_swap(a1, b1, false, false); \
    u32x4 w = {r0[0], r1[0], r0[1], r1[1]}; OUT = *reinterpret_cast<bf16x8*>(&w); } while (0)
            PK4(p0, 0, pa0); PK4(p0, 8, pa1); PK4(p1, 0, pa2); PK4(p1, 8, pa3);
#undef PK4
            SBAR();
            pv_one<0>(o[0], vb0, pa0, pa1, pa2, pa3); pv_one<1>(o[1], vb0, pa0, pa1, pa2, pa3); pv_one<2>(o[2], vb0, pa0, pa1, pa2, pa3); pv_one<3>(o[3], vb0, pa0, pa1, pa2, pa3);
            done = __all(Rc > 110.0f);
            if (done && lane == 0) flags[wid] = 1;
        }
        __syncthreads();
        int nd = 0;
#pragma unroll
        for (int w = 0; w < 8; ++w) nd += flags[w];
        if (nd == 8) break;
    }
    bf16_t* ob = P.mix + (tokbase + q0 + wid * 32) * 2048 + h * HD;
#pragma unroll
    for (int r = 0; r < 16; ++r) { const int orow = crow(r, hi);
#pragma unroll
        for (int d0 = 0; d0 < 4; ++d0) ob[(size_t)orow * 2048 + d0 * 32 + r32] = (bf16_t)(cvt_pk_bf16(o[d0][r], 0.f) & 0xffffu); }
    __syncthreads();
}

__device__ __forceinline__ float xhalf(float x, int hi) { const auto r = __builtin_amdgcn_permlane32_swap(__float_as_uint(x), __float_as_uint(x), false, false); return __uint_as_float(hi ? r[0] : r[1]); }
__device__ __forceinline__ float2 cmul(float2 a, float2 b) { return make_float2(a.x * b.x - a.y * b.y, a.x * b.y + a.y * b.x); }
__device__ __forceinline__ float2 cfma(float2 a, float2 x, float2 c) { return make_float2(a.x * x.x - a.y * x.y + c.x, a.x * x.y + a.y * x.x + c.y); }
template <bool OUT>
__device__ __forceinline__ void ssm_item(const Params& P, int item, LAS unsigned char* lds) {
    const int tid = threadIdx.x, wid = tid >> 6, lane = tid & 63, r32 = lane & 31, hi = lane >> 5, hh = lane & 15, kq = lane >> 4;
    const int g = item % NG, sc = (item / NG) % NSC, b = item / (NSC * NG);
    LAS unsigned* xs = (LAS unsigned*)(lds + wid * 8192);
    float2 a1[2], a2[2], a3[2], a4[2], cst[2]; bf16x8 bre[2], bim[2];
#pragma unroll
    for (int pb = 0; pb < 2; ++pb) { const int gp = g * NP + pb * 32 + r32;
        a1[pb] = P.abar[gp]; a2[pb] = cmul(a1[pb], a1[pb]); a3[pb] = cmul(a2[pb], a1[pb]); a4[pb] = cmul(a2[pb], a2[pb]);
        const float* bp = (const float*)(P.bbar + (size_t)gp * GH + 8 * hi); const f32x4 v0 = *(const f32x4*)bp, v1 = *(const f32x4*)(bp + 4), v2 = *(const f32x4*)(bp + 8), v3 = *(const f32x4*)(bp + 12);
        u32x4 wr_, wi_; wr_.x = cvt_pk_bf16(v0[0], v0[2]); wr_.y = cvt_pk_bf16(v1[0], v1[2]); wr_.z = cvt_pk_bf16(v2[0], v2[2]); wr_.w = cvt_pk_bf16(v3[0], v3[2]);
        wi_.x = cvt_pk_bf16(v0[1], v0[3]); wi_.y = cvt_pk_bf16(v1[1], v1[3]); wi_.z = cvt_pk_bf16(v2[1], v2[3]); wi_.w = cvt_pk_bf16(v3[1], v3[3]);
        bre[pb] = *(bf16x8*)&wr_; bim[pb] = *(bf16x8*)&wi_;
        cst[pb] = make_float2(0.f, 0.f);
        if (OUT) { const float2 aL = P.aL[gp]; const float2* ep = P.Est + ((size_t)(b * NG + g) * NSC) * NP + pb * 32 + r32; float2 e[NSC - 1];
#pragma unroll
            for (int cc = 0; cc < NSC - 1; ++cc) e[cc] = ep[(size_t)cc * NP];
#pragma unroll
            for (int cc = 0; cc < NSC - 1; ++cc) if (cc < sc) cst[pb] = cfma(aL, cst[pb], e[cc]); } }
    bf16x8 cf[4], dfr; float dsk = 0.f;
    if (OUT) {
#pragma unroll
        for (int s_ = 0; s_ < 4; ++s_) { const size_t ci = ((size_t)g * GH + hh) * NP + 16 * s_ + 4 * kq; const f32x4 cr = *(const f32x4*)(P.c_re + ci), cim = *(const f32x4*)(P.c_im + ci);
            u32x4 w; w.x = cvt_pk_bf16(cr[0], -cim[0]); w.y = cvt_pk_bf16(cr[1], -cim[1]); w.z = cvt_pk_bf16(cr[2], -cim[2]); w.w = cvt_pk_bf16(cr[3], -cim[3]); cf[s_] = *(bf16x8*)&w; }
        dsk = P.ssm_d[g * GH + hh];
        float dv[8];
#pragma unroll
        for (int j = 0; j < 8; ++j) dv[j] = (8 * kq + j == hh) ? dsk : 0.f;
        u32x4 w; w.x = cvt_pk_bf16(dv[0], dv[1]); w.y = cvt_pk_bf16(dv[2], dv[3]); w.z = cvt_pk_bf16(dv[4], dv[5]); w.w = cvt_pk_bf16(dv[6], dv[7]); dfr = *(bf16x8*)&w;
    }
    const float* ubase = P.u + ((size_t)b * SEQ + sc * SCH) * 1024 + g * GH;
    f32x4 un0 = *(const f32x4*)(ubase + (size_t)r32 * 1024 + 8 * hi), un1 = *(const f32x4*)(ubase + (size_t)r32 * 1024 + 8 * hi + 4);
    for (int blk = 0; blk < SCH / 32; ++blk) {
        u32x4 aw; aw.x = cvt_pk_bf16(un0[0], un0[1]); aw.y = cvt_pk_bf16(un0[2], un0[3]); aw.z = cvt_pk_bf16(un1[0], un1[1]); aw.w = cvt_pk_bf16(un1[2], un1[3]);
        bf16x8 Au = *(bf16x8*)&aw; mfma_operand_ready(Au);
        if (blk + 1 < SCH / 32) { const float* up = ubase + (size_t)((blk + 1) * 32 + r32) * 1024 + 8 * hi; un0 = *(const f32x4*)up; un1 = *(const f32x4*)(up + 4); }
#pragma unroll
        for (int pb = 0; pb < 2; ++pb) {
            f32x16 dre = __builtin_amdgcn_mfma_f32_32x32x16_bf16(Au, bre[pb], f32x16{}, 0, 0, 0);
            f32x16 dim = __builtin_amdgcn_mfma_f32_32x32x16_bf16(Au, bim[pb], f32x16{}, 0, 0, 0);
#pragma unroll
            for (int q = 0; q < 4; ++q)
#pragma unroll
                for (int i = 1; i < 4; ++i) { const float2 x = cfma(a1[pb], make_float2(dre[4 * q + i - 1], dim[4 * q + i - 1]), make_float2(dre[4 * q + i], dim[4 * q + i])); dre[4 * q + i] = x.x; dim[4 * q + i] = x.y; }
            float2 cin[4]; float2 cc = cst[pb];
#pragma unroll
            for (int q = 0; q < 4; ++q) { const float2 le = make_float2(dre[4 * q + 3], dim[4 * q + 3]);
                const float2 e0 = cfma(a4[pb], cc, le);
                const float2 pe0 = make_float2(xhalf(e0.x, hi), xhalf(e0.y, hi));
                const float2 e1 = cfma(a4[pb], pe0, le);
                const float2 pe1 = make_float2(xhalf(e1.x, hi), xhalf(e1.y, hi));
                cin[q] = hi ? pe0 : cc; cc = hi ? e1 : pe1; }
            cst[pb] = cc;
            if (OUT) {
#pragma unroll
                for (int q = 0; q < 4; ++q) { const float2 f1 = cmul(a1[pb], cin[q]), f2 = cmul(a2[pb], cin[q]), f3 = cmul(a3[pb], cin[q]), f4 = cmul(a4[pb], cin[q]);
                    const float2 x0 = make_float2(dre[4 * q + 0] + f1.x, dim[4 * q + 0] + f1.y), x1 = make_float2(dre[4 * q + 1] + f2.x, dim[4 * q + 1] + f2.y);
                    const float2 x2 = make_float2(dre[4 * q + 2] + f3.x, dim[4 * q + 2] + f3.y), x3 = make_float2(dre[4 * q + 3] + f4.x, dim[4 * q + 3] + f4.y);
                    LAS unsigned* xp = xs + (8 * q + 4 * hi) * 64 + pb * 32 + r32;
                    xp[0] = cvt_pk_bf16(x0.x, x0.y); xp[64] = cvt_pk_bf16(x1.x, x1.y); xp[128] = cvt_pk_bf16(x2.x, x2.y); xp[192] = cvt_pk_bf16(x3.x, x3.y); }
            }
        }
        if (OUT) {
            asm volatile("s_waitcnt lgkmcnt(0)" ::: "memory");
#pragma unroll
            for (int th = 0; th < 2; ++th) {
                f32x4 yacc = (f32x4){0.f, 0.f, 0.f, 0.f};
#pragma unroll
                for (int s_ = 0; s_ < 4; ++s_) { const bf16x8 af = *(const LAS bf16x8*)((const LAS unsigned char*)xs + (th * 16 + hh) * 256 + s_ * 64 + kq * 16);
                    yacc = __builtin_amdgcn_mfma_f32_16x16x32_bf16(af, cf[s_], yacc, 0, 0, 0); }
                u32x4 uw;
                { const float* up = ubase + (size_t)(blk * 32 + th * 16 + hh) * 1024 + 8 * (kq & 1); const f32x4 y0 = *(const f32x4*)up, y1 = *(const f32x4*)(up + 4);
                    uw.x = cvt_pk_bf16(y0[0], y0[1]); uw.y = cvt_pk_bf16(y0[2], y0[3]); uw.z = cvt_pk_bf16(y1[0], y1[1]); uw.w = cvt_pk_bf16(y1[2], y1[3]); }
                { bf16x8 ua = *(bf16x8*)&uw; mfma_operand_ready(ua); yacc = __builtin_amdgcn_mfma_f32_16x16x32_bf16(ua, dfr, yacc, 0, 0, 0); }
#pragma unroll
                for (int j = 0; j < 4; ++j) { const int t = blk * 32 + th * 16 + 4 * kq + j; const float yv = gelu_tanh(yacc[j]);
                    P.ybuf[((size_t)b * SEQ + sc * SCH + t) * 1024 + g * GH + hh] = (bf16_t)(cvt_pk_bf16(yv, 0.f) & 0xffffu); }
            }
            asm volatile("s_waitcnt lgkmcnt(0)" ::: "memory");
        }
    }
    if (!OUT) { if (hi == 0) {
#pragma unroll
        for (int pb = 0; pb < 2; ++pb) P.Est[((size_t)(b * NG + g) * NSC + sc) * NP + pb * 32 + r32] = cst[pb]; } }
}

__device__ void phase_mixnorm(const Params& P) {
    const int tid = threadIdx.x, wid = tid >> 6, lane = tid & 63, G = gridDim.x;
    for (int row = blockIdx.x * 8 + wid; row < T_; row += G * 8) {
        const bf16_t* mp = P.mix + (size_t)row * 2048; u32x4 v[4]; float ssa = 0.f, ssb = 0.f;
#pragma unroll
        for (int i = 0; i < 4; ++i) { v[i] = *(const u32x4*)(mp + lane * 8 + 512 * i);
            const float s = bf_lo(v[i].x) * bf_lo(v[i].x) + bf_hi(v[i].x) * bf_hi(v[i].x) + bf_lo(v[i].y) * bf_lo(v[i].y) + bf_hi(v[i].y) * bf_hi(v[i].y) + bf_lo(v[i].z) * bf_lo(v[i].z) + bf_hi(v[i].z) * bf_hi(v[i].z) + bf_lo(v[i].w) * bf_lo(v[i].w) + bf_hi(v[i].w) * bf_hi(v[i].w);
            if (i < 2) ssa += s; else ssb += s; }
        ssa = wave_sum(ssa); ssb = wave_sum(ssb);
        const float ra = rsqrtf(ssa * (1.0f / 1024) + EPS), rb = rsqrtf(ssb * (1.0f / 1024) + EPS);
#pragma unroll
        for (int i = 0; i < 4; ++i) { const float r = i < 2 ? ra : rb; u32x4 w;
            w.x = cvt_pk_bf16(bf_lo(v[i].x) * r, bf_hi(v[i].x) * r); w.y = cvt_pk_bf16(bf_lo(v[i].y) * r, bf_hi(v[i].y) * r);
            w.z = cvt_pk_bf16(bf_lo(v[i].z) * r, bf_hi(v[i].z) * r); w.w = cvt_pk_bf16(bf_lo(v[i].w) * r, bf_hi(v[i].w) * r);
            *(u32x4*)(P.R1 + (size_t)row * 2048 + lane * 8 + 512 * i) = w; }
    }
}

__device__ void phase_router(const Params& P, LAS unsigned char* lds) {
    const int tid = threadIdx.x, wid = tid >> 6, lane = tid & 63, r32 = lane & 31, kh = lane >> 5, G = gridDim.x;
    LAS float* part = (LAS float*)lds;
    LAS float* ssq = (LAS float*)(lds + 65536);
    LAS float* rinv = (LAS float*)(lds + 65536 + 1024);
    LAS int* lsel = (LAS int*)(lds + 65536 + 2048); LAS int* lrank = lsel + 32 * TOPK;
    for (int unit = blockIdx.x; unit < T_ / 32; unit += G) {
        const int tok0 = unit * 32;
        f32x16 acc0 = f32x16{}, acc1 = f32x16{}; float ss = 0.f;
        const float* ap = P.h1 + (size_t)(tok0 + r32) * DM + 256 * wid + 8 * kh;
        const bf16_t* bh = P.Wr_hi + (size_t)r32 * DM + 256 * wid + 8 * kh; const bf16_t* bl = P.Wr_lo + (size_t)r32 * DM + 256 * wid + 8 * kh;
#pragma unroll 4
        for (int s_ = 0; s_ < 16; ++s_) {
            const f32x4 x0 = *(const f32x4*)(ap + 16 * s_), x1 = *(const f32x4*)(ap + 16 * s_ + 4);
            ss += x0[0] * x0[0] + x0[1] * x0[1] + x0[2] * x0[2] + x0[3] * x0[3] + x1[0] * x1[0] + x1[1] * x1[1] + x1[2] * x1[2] + x1[3] * x1[3];
            u32x4 hw, lw;
            hw.x = cvt_pk_bf16(x0[0], x0[1]); hw.y = cvt_pk_bf16(x0[2], x0[3]); hw.z = cvt_pk_bf16(x1[0], x1[1]); hw.w = cvt_pk_bf16(x1[2], x1[3]);
            lw.x = cvt_pk_bf16(x0[0] - bf_lo(hw.x), x0[1] - bf_hi(hw.x)); lw.y = cvt_pk_bf16(x0[2] - bf_lo(hw.y), x0[3] - bf_hi(hw.y));
            lw.z = cvt_pk_bf16(x1[0] - bf_lo(hw.z), x1[1] - bf_hi(hw.z)); lw.w = cvt_pk_bf16(x1[2] - bf_lo(hw.w), x1[3] - bf_hi(hw.w));
            bf16x8 Ah = *(bf16x8*)&hw, Al = *(bf16x8*)&lw; mfma_operand_ready(Ah, Al);
            const bf16x8 Bh0 = *(const bf16x8*)(bh + 16 * s_), Bh1 = *(const bf16x8*)(bh + (size_t)32 * DM + 16 * s_);
            const bf16x8 Bl0 = *(const bf16x8*)(bl + 16 * s_), Bl1 = *(const bf16x8*)(bl + (size_t)32 * DM + 16 * s_);
            acc0 = __builtin_amdgcn_mfma_f32_32x32x16_bf16(Ah, Bh0, acc0, 0, 0, 0); acc1 = __builtin_amdgcn_mfma_f32_32x32x16_bf16(Ah, Bh1, acc1, 0, 0, 0);
            acc0 = __builtin_amdgcn_mfma_f32_32x32x16_bf16(Ah, Bl0, acc0, 0, 0, 0); acc1 = __builtin_amdgcn_mfma_f32_32x32x16_bf16(Ah, Bl1, acc1, 0, 0, 0);
            acc0 = __builtin_amdgcn_mfma_f32_32x32x16_bf16(Al, Bh0, acc0, 0, 0, 0); acc1 = __builtin_amdgcn_mfma_f32_32x32x16_bf16(Al, Bh1, acc1, 0, 0, 0);
        }
#pragma unroll
        for (int r = 0; r < 16; ++r) { const int tl = crow(r, kh); part[(wid * 32 + tl) * 64 + r32] = acc0[r]; part[(wid * 32 + tl) * 64 + 32 + r32] = acc1[r]; }
        ss += __shfl_xor(ss, 32); if (kh == 0) ssq[wid * 32 + r32] = ss;
        __syncthreads();
        if (tid < 32) { float sq = 0.f;
#pragma unroll
            for (int w = 0; w < 8; ++w) sq += ssq[w * 32 + tid];
            rinv[tid] = rsqrtf(sq * (1.0f / DM) + EPS); }
        __syncthreads();
        int selE[4]; float selG[4];
#pragma unroll
        for (int tt = 0; tt < 4; ++tt) { const int tl = 4 * wid + tt; float lg = 0.f;
#pragma unroll
            for (int w = 0; w < 8; ++w) lg += part[(w * 32 + tl) * 64 + lane];
            lg *= rinv[tl];
            const float score = 1.0f / (1.0f + expf(-lg)); float selv = score + P.router_bias[lane];
            int myE = 0; float myG = 0.f, gsum = 0.f;
#pragma unroll
            for (int j = 0; j < TOPK; ++j) { const float mx = wave_max(selv); const unsigned long long bal = __ballot(selv == mx); const int first = __builtin_amdgcn_readfirstlane((int)__builtin_ctzll(bal));
                const float gsel = __shfl(score, first); gsum += gsel; if (lane == j) { myE = first; myG = gsel; } if (lane == first) selv = -3.0e38f; }
            selE[tt] = myE; selG[tt] = myG / gsum * 2.5f;
            if (lane < TOPK) lsel[tl * TOPK + lane] = myE; }
        __syncthreads();
        if (wid == 0) { int cn = 0;
            for (int i = 0; i < 32 * TOPK; ++i) { const int se = lsel[i]; if (se == lane) { lrank[i] = cn; ++cn; } }
            P.cntw[unit * NE + lane] = cn; }
        __syncthreads();
        if (lane < TOPK) {
#pragma unroll
            for (int tt = 0; tt < 4; ++tt) { const int tl = 4 * wid + tt, tok = tok0 + tl;
                P.sel_e[tok * TOPK + lane] = selE[tt]; P.sel_pos[tok * TOPK + lane] = lrank[tl * TOPK + lane]; P.sel_gate[tok * TOPK + lane] = selG[tt]; } }
#pragma unroll
        for (int tt = 0; tt < 4; ++tt) { const int tl = 4 * wid + tt; const float r = rinv[tl]; const float* hp = P.h1 + (size_t)(tok0 + tl) * DM;
#pragma unroll
            for (int i = 0; i < 8; ++i) { const f32x4 v = *(const f32x4*)(hp + 4 * lane + 256 * i); const f32x4 gn = *(const f32x4*)(P.norm_ffn + 4 * lane + 256 * i); const f32x4 mv = v * r * gn;
                u32x2 w; w.x = cvt_pk_bf16(mv[0], mv[1]); w.y = cvt_pk_bf16(mv[2], mv[3]); *(u32x2*)(P.R1 + (size_t)(tok0 + tl) * DM + 4 * lane + 256 * i) = w; } }
        __syncthreads();
    }
}

constexpr int NU = T_ / 32;
__device__ __forceinline__ void moe_sum_units(const Params& P, LAS int* tmp, LAS int* out, int ulim) {
    const int e = threadIdx.x & 63, part = threadIdx.x >> 6; int sacc = 0;
#pragma unroll 8
    for (int i = 0; i < NU / 8; ++i) { const int v = part * (NU / 8) + i; const int cv = P.cntw[v * NE + e]; sacc += (v < ulim) ? cv : 0; }
    tmp[part * 64 + e] = sacc;
    __syncthreads();
    if (threadIdx.x < NE) { int tot = 0;
#pragma unroll
        for (int p = 0; p < 8; ++p) tot += tmp[p * 64 + threadIdx.x];
        out[threadIdx.x] = tot; }
    __syncthreads();
}
__device__ int build_moe_tables(const Params& P, LAS unsigned char* lds) {
    LAS int* rt_e = (LAS int*)(lds + LDS_TAB); LAS int* rt_j = rt_e + 256; volatile LAS int* nrt = (volatile LAS int*)(rt_e + 512); LAS int* rt_n = rt_e + 640;
    __syncthreads();
    if (threadIdx.x < NE) { const int e = threadIdx.x; const int n = (int)P.cnt[e]; const int ntile = (n + 255) >> 8; int pre = ntile;
#pragma unroll
        for (int o = 1; o < 64; o <<= 1) { const int t = __shfl_up(pre, o); if (e >= o) pre += t; }
        const int rt = pre - ntile;
        for (int j = 0; j < ntile; ++j) if (rt + j < 256) { rt_e[rt + j] = e; rt_j[rt + j] = j; rt_n[rt + j] = (n - j * 256) < 256 ? (n - j * 256) : 256; }
        if (e == NE - 1) *nrt = pre < 256 ? pre : 256; }
    __syncthreads();
    return *nrt;
}
__device__ void moe_scatter(const Params& P, LAS unsigned char* lds) {
    LAS int* bs = (LAS int*)(lds + LDS_TAB + 2100);
    const int tid = threadIdx.x, G = gridDim.x;
    for (int u = blockIdx.x; u < NU; u += G) {
        __syncthreads();
        moe_sum_units(P, (LAS int*)lds, bs, u);
        if (tid < NE) { P.basew[u * NE + tid] = bs[tid]; if (u == NU - 1) P.cnt[tid] = (unsigned)(bs[tid] + P.cntw[u * NE + tid]); }
        if (tid < 32 * TOPK) { const int tok = u * 32 + tid / TOPK, k = tid % TOPK; const int e = P.sel_e[tok * TOPK + k], loc = P.sel_pos[tok * TOPK + k];
            __hip_atomic_store(&P.tok_of_row[(size_t)e * CAP + bs[e] + loc], tok, __ATOMIC_RELAXED, __HIP_MEMORY_SCOPE_AGENT); }
    }
}

__device__ void phase_combine(const Params& P, LAS unsigned char* lds) {
    const int tid = threadIdx.x, wid = tid >> 6, lane = tid & 63, G = gridDim.x;
    LAS int* rt0 = (LAS int*)(lds + LDS_TAB);
    __syncthreads();
    if (tid < NE) { const int ntile = ((int)P.cnt[tid] + 255) >> 8; int pre = ntile;
#pragma unroll
        for (int o = 1; o < 64; o <<= 1) { const int t = __shfl_up(pre, o); if (tid >= o) pre += t; }
        rt0[tid] = pre - ntile; }
    __syncthreads();
    for (int row = blockIdx.x * 8 + wid; row < T_; row += G * 8) {
        int crw = 0; float gte = 0.f;
        if (lane < TOPK) { const int e = P.sel_e[row * TOPK + lane]; crw = rt0[e] * 256 + P.basew[(row >> 5) * NE + e] + P.sel_pos[row * TOPK + lane]; gte = P.sel_gate[row * TOPK + lane]; }
        float hv[4][8]; float ss = 0.f;
#pragma unroll
        for (int i = 0; i < 4; ++i) { const size_t o = (size_t)row * DM + lane * 8 + 512 * i; const f32x4 a = *(const f32x4*)(P.h1 + o), b2 = *(const f32x4*)(P.h1 + o + 4);
            hv[i][0] = a[0]; hv[i][1] = a[1]; hv[i][2] = a[2]; hv[i][3] = a[3]; hv[i][4] = b2[0]; hv[i][5] = b2[1]; hv[i][6] = b2[2]; hv[i][7] = b2[3];
            const u32x4 sv = *(const u32x4*)(P.Ysh + o);
            hv[i][0] += bf_lo(sv.x); hv[i][1] += bf_hi(sv.x); hv[i][2] += bf_lo(sv.y); hv[i][3] += bf_hi(sv.y); hv[i][4] += bf_lo(sv.z); hv[i][5] += bf_hi(sv.z); hv[i][6] += bf_lo(sv.w); hv[i][7] += bf_hi(sv.w); }
#pragma unroll
        for (int k = 0; k < TOPK; ++k) { const int cr = __builtin_amdgcn_readlane(crw, k); const float gt = __uint_as_float((unsigned)__builtin_amdgcn_readlane((int)__float_as_uint(gte), k)); const bf16_t* yp = P.Y + (size_t)cr * DM + lane * 8;
#pragma unroll
            for (int i = 0; i < 4; ++i) { const u32x4 y = *(const u32x4*)(yp + 512 * i);
                hv[i][0] += gt * bf_lo(y.x); hv[i][1] += gt * bf_hi(y.x); hv[i][2] += gt * bf_lo(y.y); hv[i][3] += gt * bf_hi(y.y); hv[i][4] += gt * bf_lo(y.z); hv[i][5] += gt * bf_hi(y.z); hv[i][6] += gt * bf_lo(y.w); hv[i][7] += gt * bf_hi(y.w); } }
#pragma unroll
        for (int i = 0; i < 4; ++i)
#pragma unroll
            for (int j = 0; j < 8; ++j) ss += hv[i][j] * hv[i][j];
        ss = wave_sum(ss); const float r = rsqrtf(ss * (1.0f / DM) + EPS);
#pragma unroll
        for (int i = 0; i < 4; ++i) { const size_t o = (size_t)row * DM + lane * 8 + 512 * i;
            *(f32x4*)(P.h1 + o) = (f32x4){hv[i][0], hv[i][1], hv[i][2], hv[i][3]}; *(f32x4*)(P.h1 + o + 4) = (f32x4){hv[i][4], hv[i][5], hv[i][6], hv[i][7]};
            u32x4 w; w.x = cvt_pk_bf16(hv[i][0] * r, hv[i][1] * r); w.y = cvt_pk_bf16(hv[i][2] * r, hv[i][3] * r); w.z = cvt_pk_bf16(hv[i][4] * r, hv[i][5] * r); w.w = cvt_pk_bf16(hv[i][6] * r, hv[i][7] * r);
            *(u32x4*)(P.R3 + o) = w; }
    }
}

constexpr int NPHASE = 13;
__global__ void __launch_bounds__(512, 2) fwd(Params P) {
    extern __shared__ __attribute__((aligned(16))) unsigned char shm_raw[];
    LAS unsigned char* lds = (LAS unsigned char*)shm_raw;
    const int G = gridDim.x, c = blockIdx.x;
    for (int i = threadIdx.x; i < LDS_BYTES / 16; i += 512) ((LAS u32x4*)lds)[i] = (u32x4){0u, 0u, 0u, 0u};
    __syncthreads();
    XcdBarrier bar; bar.bar = P.bar; bar.x = 0; bar.st = (volatile LAS unsigned*)(lds + LDS_BARW);
    const int lo = (int)P.ph_lo, hi = (int)P.ph_hi;
    if (hi - lo > 1) bar = xcd_barrier_post(P.bar, (volatile LAS unsigned*)(lds + LDS_BARW));
#define RUN(k) (lo <= (k) && (k) < hi)
#define SEAM(k) do { if (lo <= (k) && (k) + 1 < hi) xcd_barrier(bar); } while (0)
    auto phase_fn_0 = [&]() {
    if (RUN(0)) phase_prologue(P, lds);
    };
    phase_fn_0();
#if REP_PHASE == 0
    xcd_barrier(bar); phase_fn_0();
#endif
    SEAM(0);
    auto phase_fn_1 = [&]() {
    if (RUN(1)) { pg8::StaticOrder S; S.init(T_, NZ, DM, G, c); pg8::Gemm g{P.R1, P.Wt_in, DM, nullptr}; EpiQKVU E{P.zq, P.u}; pg8::gemm_phase<EpiQKVU, pg8::StaticOrder, false>(lds, g, S, E); }
    };
    phase_fn_1();
#if REP_PHASE == 1
    xcd_barrier(bar); phase_fn_1();
#endif
    SEAM(1);
    auto phase_fn_2 = [&]() {
    if (RUN(2)) {
        for (int u = c; u < NB * NHEAD * 8; u += G) attn_unit(P, u, lds);
        for (int it = c * 8 + (threadIdx.x >> 6); it < NB * NG * NSC; it += G * 8) ssm_item<false>(P, it, lds);
    }
    };
    phase_fn_2();
#if REP_PHASE == 2
    xcd_barrier(bar); phase_fn_2();
#endif
    SEAM(2);
    auto phase_fn_3 = [&]() {
    if (RUN(3)) { for (int it = c * 8 + (threadIdx.x >> 6); it < NB * NG * NSC; it += G * 8) ssm_item<true>(P, it, lds); }
    };
    phase_fn_3();
#if REP_PHASE == 3
    xcd_barrier(bar); phase_fn_3();
#endif
    SEAM(3);
    auto phase_fn_4 = [&]() {
    if (RUN(4)) { pg8::StaticOrder S; S.init(T_, 1024, 1024, G, c); pg8::Gemm g{P.ybuf, P.Wt_glu, 1024, nullptr}; EpiGLU E{P.ybuf, P.mix}; pg8::gemm_phase<EpiGLU, pg8::StaticOrder, false>(lds, g, S, E); }
    };
    phase_fn_4();
#if REP_PHASE == 4
    xcd_barrier(bar); phase_fn_4();
#endif
    SEAM(4);
#if REP_PHASE == 100
    xcd_barrier(bar); xcd_barrier(bar); xcd_barrier(bar); xcd_barrier(bar);
#endif
    auto phase_fn_5 = [&]() {
    if (RUN(5)) phase_mixnorm(P);
    };
    phase_fn_5();
#if REP_PHASE == 5
    xcd_barrier(bar); phase_fn_5();
#endif
    SEAM(5);
    auto phase_fn_6 = [&]() {
    if (RUN(6)) { pg8::StaticOrder S; S.init(T_, DM, DM, G, c); pg8::Gemm g{P.R1, P.Wt_out, DM, nullptr}; EpiRes E{P.x, P.h1}; pg8::gemm_phase<EpiRes, pg8::StaticOrder, false>(lds, g, S, E); }
    };
    phase_fn_6();
#if REP_PHASE == 6
    xcd_barrier(bar); phase_fn_6();
#endif
    SEAM(6);
    auto phase_fn_7 = [&]() {
    if (RUN(7)) phase_router(P, lds);
    };
    phase_fn_7();
#if REP_PHASE == 7
    xcd_barrier(bar); if (blockIdx.x == 0 && threadIdx.x < NE) P.cnt[threadIdx.x * 64] = 0u; xcd_barrier(bar); phase_fn_7();
#endif
    SEAM(7);
    auto phase_fn_8 = [&]() {
    if (RUN(8)) { moe_scatter(P, lds); if (hi - lo > 1) xcd_barrier(bar);
        const int n_rt = build_moe_tables(P, lds);
        MoeSched S; S.G = G; S.c = c; S.n_rt = n_rt; S.NPN = 4; S.K = DM; S.down = false; S.rt_e = (const LAS int*)(lds + LDS_TAB); S.rt_j = S.rt_e + 256; S.rt_n = S.rt_e + 640;
        pg8::Gemm g{P.R1, P.Wt_egu, DM, P.tok_of_row}; EpiSwiGLU E{P.H, P.Hs};
        pg8::gemm_phase<EpiSwiGLU, MoeSched, true>(lds, g, S, E); }
    };
    phase_fn_8();
#if REP_PHASE == 8
    xcd_barrier(bar); phase_fn_8();
#endif
    SEAM(8);
    auto phase_fn_9 = [&]() {
    if (RUN(9)) { const int n_rt = build_moe_tables(P, lds);
        for (int j = (c >> 3) & 7; j > 0; --j) __builtin_amdgcn_s_sleep(37);
        MoeSched S; S.G = G; S.c = c; S.n_rt = n_rt; S.NPN = 8; S.K = DE; S.down = true; S.rt_e = (const LAS int*)(lds + LDS_TAB); S.rt_j = S.rt_e + 256; S.rt_n = S.rt_e + 640;
        pg8::Gemm g{P.H, P.Wt_ed, DE, nullptr}; EpiDown E{P.Y, P.Ysh};
        pg8::gemm_phase<EpiDown, MoeSched, false>(lds, g, S, E); }
    };
    phase_fn_9();
#if REP_PHASE == 9
    xcd_barrier(bar); phase_fn_9();
#endif
    SEAM(9);
    auto phase_fn_10 = [&]() {
    if (RUN(10)) phase_combine(P, lds);
    };
    phase_fn_10();
#if REP_PHASE == 10
    xcd_barrier(bar); phase_fn_10();
#endif
    SEAM(10);
    auto phase_fn_11 = [&]() {
    if (RUN(11)) { pg8::StaticOrder S; S.init(T_, DM, DPLE, G, c); pg8::Gemm g{P.pb, P.Wt_pp, DPLE, nullptr}; EpiBf16 E{P.proj, DM}; pg8::gemm_phase<EpiBf16, pg8::StaticOrder, false>(lds, g, S, E); }
    };
    phase_fn_11();
#if REP_PHASE == 11
    xcd_barrier(bar); phase_fn_11();
#endif
    SEAM(11);
    auto phase_fn_12 = [&]() {
    if (RUN(12)) { pg8::StaticOrder S; S.init(T_, DM, DM, G, c); pg8::Gemm g{P.R3, P.Wt_pg, DM, nullptr}; EpiPle E{P.out, P.proj, P.h1}; pg8::gemm_phase<EpiPle, pg8::StaticOrder, false>(lds, g, S, E); }
    };
    phase_fn_12();
#if REP_PHASE == 12
    xcd_barrier(bar); phase_fn_12();
#endif
#undef RUN
#undef SEAM
}

extern "C" void kernel_launch(void* const* d_in, const int* in_sizes, int n_in, void* d_out, int out_size, void* d_ws, size_t ws_size, hipStream_t stream) {
    static int grid = 0;
    size_t off = 0;
    auto take = [&](size_t bytes) { const size_t o = off; off += (bytes + 255) & ~(size_t)255; return o; };
    const size_t o_ctl = take(32768);
    const size_t o_Wt_in = take((size_t)4096 * 2048 * 2), o_Wt_glu = take((size_t)1024 * 1024 * 2), o_Wt_out = take((size_t)2048 * 2048 * 2), o_Wt_pg = take((size_t)2048 * 2048 * 2),
                 o_Wt_pp = take((size_t)2048 * 256 * 2), o_Wt_egu = take((size_t)(NE + 1) * 1024 * 2048 * 2), o_Wt_ed = take((size_t)(NE + 1) * 2048 * 512 * 2);
    const size_t o_R1 = take((size_t)(T_ + 1) * DM * 2), o_h1 = take((size_t)T_ * DM * 4), o_tok = take((size_t)NE * CAP * 4), o_sele = take((size_t)T_ * TOPK * 4), o_selp = take((size_t)T_ * TOPK * 4),
                 o_selg = take((size_t)T_ * TOPK * 4), o_cntw = take((size_t)(T_ / 32) * NE * 4), o_basew = take((size_t)(T_ / 32) * NE * 4), o_H = take((size_t)(65536 + T_) * DE * 2), o_Ysh = take((size_t)T_ * DM * 2), o_proj = take((size_t)T_ * DM * 2), o_pb = take((size_t)T_ * DPLE * 2),
                 o_abar = take((size_t)NG * NP * 8), o_aL = take((size_t)NG * NP * 8), o_bbar = take((size_t)NG * NP * GH * 8), o_wrh = take((size_t)NE * DM * 2), o_wrl = take((size_t)NE * DM * 2), o_R3 = take((size_t)T_ * DM * 2);
    const size_t o_Y = take((size_t)65536 * DM * 2);
    size_t off2 = o_Y; auto take2 = [&](size_t bytes) { const size_t o = off2; off2 += (bytes + 255) & ~(size_t)255; return o; };
    const size_t o_zq = take2((size_t)T_ * 3072 * 2), o_u = take2((size_t)T_ * 1024 * 4), o_mix = take2((size_t)T_ * 2048 * 2), o_y = take2((size_t)T_ * 1024 * 2), o_E = take2((size_t)NB * NG * NSC * NP * 8);
    const size_t ws_need = off > off2 ? off : off2;
    if (grid == 0) {
        if (n_in != 30 || in_sizes[0] != T_ * DM || out_size != T_ * DM || ws_size < ws_need) {
            fprintf(stderr, "kernel_launch: unexpected shapes: n_in %d in0 %d out %d ws %zu (need %zu); nothing launched\n", n_in, n_in > 0 ? in_sizes[0] : -1, out_size, ws_size, ws_need); grid = -1; return; }
        int dev = 0, cus = 0, per_cu = 0;
        if (hipGetDevice(&dev) != hipSuccess || hipDeviceGetAttribute(&cus, hipDeviceAttributeMultiprocessorCount, dev) != hipSuccess) { fprintf(stderr, "kernel_launch: device query failed\n"); grid = -1; return; }
        if (hipFuncSetAttribute((const void*)fwd, hipFuncAttributeMaxDynamicSharedMemorySize, LDS_BYTES) != hipSuccess) { fprintf(stderr, "kernel_launch: hipFuncSetAttribute failed\n"); grid = -1; return; }
        if (hipOccupancyMaxActiveBlocksPerMultiprocessor(&per_cu, (const void*)fwd, 512, LDS_BYTES) != hipSuccess || per_cu < 1) fprintf(stderr, "kernel_launch: note: occupancy query reports %d\n", per_cu);
        (void)hipGetLastError();
        grid = cus;
    }
    if (grid < 0) return;
    char* ws = (char*)d_ws;
    if (hipMemsetAsync(ws + o_ctl, 0, 32768, stream) != hipSuccess) { fprintf(stderr, "kernel_launch: memset failed\n"); return; }
    Params P; memset(&P, 0, sizeof(P));
    const float** inp = &P.x;
    for (int i = 0; i < 30; ++i) inp[i] = (const float*)d_in[i];
    P.out = (float*)d_out;
    P.bar = (unsigned*)(ws + o_ctl); P.cnt = (unsigned*)(ws + o_ctl + 16384);
    P.Wt_in = (bf16_t*)(ws + o_Wt_in); P.Wt_glu = (bf16_t*)(ws + o_Wt_glu); P.Wt_out = (bf16_t*)(ws + o_Wt_out); P.Wt_pg = (bf16_t*)(ws + o_Wt_pg); P.Wt_pp = (bf16_t*)(ws + o_Wt_pp);
    P.Wt_egu = (bf16_t*)(ws + o_Wt_egu); P.Wt_ed = (bf16_t*)(ws + o_Wt_ed);
    P.R3 = (bf16_t*)(ws + o_R3); P.R1 = (bf16_t*)(ws + o_R1); P.zq = (bf16_t*)(ws + o_zq); P.mix = (bf16_t*)(ws + o_mix); P.ybuf = (bf16_t*)(ws + o_y);
    P.H = (bf16_t*)(ws + o_H); P.Hs = P.H + (size_t)65536 * DE; P.Y = (bf16_t*)(ws + o_Y); P.Ysh = (bf16_t*)(ws + o_Ysh); P.proj = (bf16_t*)(ws + o_proj); P.pb = (bf16_t*)(ws + o_pb);
    P.u = (float*)(ws + o_u); P.h1 = (float*)(ws + o_h1); P.sel_gate = (float*)(ws + o_selg);
    P.Est = (float2*)(ws + o_E); P.abar = (float2*)(ws + o_abar); P.aL = (float2*)(ws + o_aL); P.bbar = (float2*)(ws + o_bbar);
    P.tok_of_row = (int*)(ws + o_tok); P.sel_e = (int*)(ws + o_sele); P.sel_pos = (int*)(ws + o_selp); P.cntw = (int*)(ws + o_cntw); P.basew = (int*)(ws + o_basew); P.Wr_hi = (bf16_t*)(ws + o_wrh); P.Wr_lo = (bf16_t*)(ws + o_wrl);
#if MK_LAUNCHES == 1
    P.ph_lo = 0; P.ph_hi = NPHASE;
    hipLaunchKernelGGL(fwd, dim3(grid), dim3(512), LDS_BYTES, stream, P);
#else
    for (int k = 0; k < NPHASE; ++k) { P.ph_lo = k; P.ph_hi = k + 1; hipLaunchKernelGGL(fwd, dim3(grid), dim3(512), LDS_BYTES, stream, P); }
#endif
    const hipError_t le = hipPeekAtLastError();
    if (le != hipSuccess) fprintf(stderr, "kernel_launch: launch failed: %s\n", hipGetErrorName(le));
}
```

```cpp
#include <hip/hip_runtime.h>
#include <cstdio>
#include <cstdint>
#include <cstring>

#ifndef MK_LAUNCHES
#define MK_LAUNCHES 1
#endif

#ifndef REP_PHASE
#define REP_PHASE -1
#endif
#define LAS __attribute__((address_space(3)))
typedef unsigned short bf16_t;
typedef short bf16x8 __attribute__((ext_vector_type(8)));
typedef short s16x4 __attribute__((ext_vector_type(4)));
typedef float f32x4 __attribute__((ext_vector_type(4)));
typedef float f32x16 __attribute__((ext_vector_type(16)));
typedef unsigned u32x4 __attribute__((ext_vector_type(4)));
typedef unsigned u32x2 __attribute__((ext_vector_type(2)));

#define XB_TMO      128
#define XB_XCNT(j)  (256  + 64 * (j))
#define XB_XSUB(j)  (1280 + 64 * (j))
#define XB_XGEN(j)  (2304 + 64 * (j))
#define XB_TOP      3328
#define XB_TOPGEN   3392
#define XCD_BAR_WORDS 3456
#define XB_SPIN_CAP (1u << 18)

__device__ __forceinline__ unsigned xb_ld(unsigned* p)              { return __hip_atomic_load(p, __ATOMIC_RELAXED, __HIP_MEMORY_SCOPE_AGENT); }
__device__ __forceinline__ unsigned xb_add(unsigned* p, unsigned v) { return __hip_atomic_fetch_add(p, v, __ATOMIC_RELAXED, __HIP_MEMORY_SCOPE_AGENT); }
__device__ __forceinline__ unsigned xb_xcc_id() { return (unsigned)__builtin_amdgcn_s_getreg((3 << 11) | 20) & 0xFu; }
#define XB_SPIN(cond, bar) do { unsigned _sp = 0; while (cond) { __builtin_amdgcn_s_sleep(1); \
    if ((++_sp & 255u) == 0u) { if (xb_ld(&(bar)[XB_TMO])) break; if (_sp > XB_SPIN_CAP) { atomicAdd(&(bar)[XB_TMO], 1u); break; } } } } while (0)

struct XcdBarrier { unsigned* bar; unsigned x; volatile LAS unsigned* st; };

__device__ __forceinline__ XcdBarrier xcd_barrier_post(unsigned* bar, volatile LAS unsigned* st) {
    XcdBarrier b; b.bar = bar; b.x = xb_xcc_id(); b.st = st;
    if (threadIdx.x == 0) (void)xb_add(&bar[XB_XCNT(b.x)], 1u);
    return b;
}
__device__ __forceinline__ void xcd_barrier_complete(unsigned* bar, unsigned x, unsigned& nloc, unsigned& nx) {
    const unsigned G = gridDim.x * gridDim.y * gridDim.z;
    unsigned sum, cnt, mine, sp = 0u;
    for (;;) {
        sum = 0u; cnt = 0u; mine = 0u;
#pragma unroll
        for (unsigned j = 0; j < 16; ++j) { const unsigned c = xb_ld(&bar[XB_XCNT(j)]); sum += c; cnt += (c > 0u) ? 1u : 0u; mine = (j == x) ? c : mine; }
        if (sum == G) break;
        __builtin_amdgcn_s_sleep(1);
        if ((++sp & 255u) == 0u) { if (xb_ld(&bar[XB_TMO])) break; if (sp > XB_SPIN_CAP) { atomicAdd(&bar[XB_TMO], 1u); break; } }
    }
    nloc = mine > 0u ? mine : 1u; nx = cnt > 0u ? cnt : 1u;
}
__device__ __forceinline__ void xcd_barrier(const XcdBarrier& b) {
    asm volatile("s_waitcnt vmcnt(0)" ::: "memory");
    __syncthreads();
    if (threadIdx.x == 0) {
        unsigned* bar = b.bar;
        __builtin_amdgcn_s_waitcnt(0);
        unsigned nloc = b.st[0], nx = b.st[1];
        if (nloc == 0u) { xcd_barrier_complete(bar, b.x, nloc, nx); b.st[0] = nloc; b.st[1] = nx; }
        const unsigned old = xb_add(&bar[XB_XSUB(b.x)], 1u);
        const unsigned gen = old / nloc;
        if (old + 1u == (gen + 1u) * nloc) {
            __builtin_amdgcn_fence(__ATOMIC_RELEASE, "agent");
            asm volatile("s_waitcnt vmcnt(0)" ::: "memory");
            const unsigned og = xb_add(&bar[XB_TOP], 1u);
            const unsigned tg = og / nx;
            if (og + 1u == (tg + 1u) * nx) xb_add(&bar[XB_TOPGEN], 1u);
            else XB_SPIN(xb_ld(&bar[XB_TOPGEN]) == tg, bar);
            __builtin_amdgcn_fence(__ATOMIC_ACQUIRE, "agent");
            xb_add(&bar[XB_XGEN(b.x)], 1u);
            asm volatile("s_waitcnt vmcnt(0)" ::: "memory");
        } else {
            XB_SPIN(xb_ld(&bar[XB_XGEN(b.x)]) == gen, bar);
            __builtin_amdgcn_fence(__ATOMIC_ACQUIRE, "agent");
            asm volatile("s_waitcnt vmcnt(0)" ::: "memory");
        }
    }
    __syncthreads();
}

constexpr int T_ = 8192, DM = 2048, NZ = 4096, SEQ = 2048, NB = 4, NHEAD = 8, HD = 128;
constexpr int NG = 64, GH = 16, NP = 64, SCH = 256, NSC = SEQ / SCH;
constexpr int NE = 64, TOPK = 6, DE = 512, DPLE = 256, CAP = 8192;
constexpr int ZROW = T_;
constexpr float EPS = 1e-6f;

constexpr int LDS_STAGE = 131072;
constexpr int LDS_TAB = LDS_STAGE;
constexpr int LDS_BARW = LDS_STAGE + 4096;
constexpr int LDS_FLAGS = LDS_BARW + 16;
constexpr int LDS_BYTES = LDS_STAGE + 4096 + 256;

struct Params {
    const float *x, *p, *norm_mix, *w_in, *q_norm, *k_norm, *lam_re, *lam_im, *log_dt, *b_re, *b_im, *c_re, *c_im, *ssm_d, *w_glu,
                *attn_out_norm, *ssm_out_norm, *w_out, *norm_ffn, *w_router, *router_bias, *w_eg, *w_eu, *w_ed, *w_sg, *w_su, *w_sd,
                *norm_ple, *w_pg, *w_pp;
    float* out;
    unsigned* bar; unsigned* cnt;
    bf16_t *Wt_in, *Wt_glu, *Wt_out, *Wt_pg, *Wt_pp, *Wt_egu, *Wt_ed, *Wr_hi, *Wr_lo;
    bf16_t *R1, *zq, *mix, *ybuf, *H, *Hs, *Y, *Ysh, *proj, *pb, *R3;
    float *u, *h1, *sel_gate;
    float2 *Est, *abar, *aL, *bbar;
    int *tok_of_row, *sel_e, *sel_pos, *cntw, *basew;
    long long ph_lo, ph_hi;
};

typedef __bf16 bf16x2_t __attribute__((ext_vector_type(2)));
typedef float f32x2_t __attribute__((ext_vector_type(2)));
__device__ __forceinline__ unsigned cvt_pk_bf16(float lo, float hi) { const f32x2_t v = {lo, hi}; const bf16x2_t b = __builtin_convertvector(v, bf16x2_t); return __builtin_bit_cast(unsigned, b); }
__device__ __forceinline__ void mfma_operand_ready(bf16x8& a) { asm volatile("s_nop 7" : "+v"(a)); }
__device__ __forceinline__ void mfma_operand_ready(bf16x8& a, bf16x8& b) { asm volatile("s_nop 7" : "+v"(a), "+v"(b)); }
__device__ __forceinline__ float bf_lo(unsigned w) { return __uint_as_float(w << 16); }
__device__ __forceinline__ float bf_hi(unsigned w) { return __uint_as_float(w & 0xffff0000u); }
__device__ __forceinline__ float sigmoidf_(float v) { return 1.0f / (1.0f + __expf(-v)); }
__device__ __forceinline__ float wave_sum(float v) {
#pragma unroll
    for (int o = 32; o >= 1; o >>= 1) v += __shfl_xor(v, o);
    return v;
}
__device__ __forceinline__ float wave_max(float v) {
#pragma unroll
    for (int o = 32; o >= 1; o >>= 1) v = fmaxf(v, __shfl_xor(v, o));
    return v;
}
__device__ __forceinline__ float gelu_tanh(float v) {
    const float c = 0.7978845608028654f;
    const float in = c * (v + 0.044715f * v * v * v);
    const float e = __expf(2.0f * in);
    const float th = 1.0f - 2.0f / (1.0f + e);
    return 0.5f * v * (1.0f + th);
}

namespace pg8 {
constexpr int BM = 256, BK = 64, HALF = 128, HTB = HALF * BK * 2, STAGE_BYTES = 8 * HTB, NXCD = 8, WGM = 8;
__host__ __device__ __forceinline__ int lds_byte(int r, int c) { const int st = (r >> 4) * 2 + (c >> 5), rr = r & 15, cc = c & 31, ob = rr * 64 + cc * 2; return st * 1024 + (ob ^ (((ob >> 9) & 1) << 5)); }
__host__ __device__ __forceinline__ void stage_rc(int b, int& R, int& C) { const int st = b / 1024, sb = b % 1024, swz = sb ^ (((sb >> 9) & 1) << 5); R = (st >> 1) * 16 + swz / 64; C = (st & 1) * 32 + (swz % 64) / 2; }
__host__ __device__ __forceinline__ int perm32(int rho) { const int n = rho >> 4, i = rho & 15; return 8 * (i >> 2) + 4 * n + (i & 3); }

struct Unit { int pm, pn, kind, nrows, arow, brow, orow0, gofs; };
struct Gemm { const bf16_t* A; const bf16_t* Bt; int K; const int* gtab; };

struct StaticOrder {
    int nM, nN, nwg, G, c, K;
    __device__ void init(int M, int N, int K_, int G_, int c_) { nM = M / BM; nN = N / BM; nwg = nM * nN; G = G_; c = c_; K = K_; }
    __device__ __forceinline__ Unit next(int i) const {
        Unit u; const long L = (long)i * G + c; const bool valid = L < nwg;
        int wgid = valid ? (int)L : 0; { const int q = nwg / NXCD, r = nwg % NXCD, xcd = wgid % NXCD, off = wgid / NXCD; wgid = (xcd < r ? xcd * (q + 1) : r * (q + 1) + (xcd - r) * q) + off; }
        const int nig = WGM * nN, gid = wgid / nig, fm = gid * WGM, gsz = (nM - fm) < WGM ? (nM - fm) : WGM;
        u.pm = fm + ((wgid % nig) % gsz); u.pn = (wgid % nig) / gsz;
        u.arow = u.pm * BM; u.brow = u.pn * BM; u.gofs = -1; u.nrows = BM; u.kind = 0; u.orow0 = u.pm * BM;
        if (!valid) u.pm = -1;
        return u;
    }
};

template <class Epi, class Sched, bool GATHER>
__device__ __forceinline__ void gemm_phase(LAS unsigned char* lds, const Gemm g, const Sched& S, const Epi& E) {
    const int tid = threadIdx.x, wid = __builtin_amdgcn_readfirstlane(tid >> 6), lane = tid & 63, wr = wid >> 2, wc = wid & 3, fr = lane & 15, fq = lane >> 4;
    const int K = g.K, nt = K / BK;
    unsigned voffA[2], voffB[2];
#pragma unroll
    for (int i = 0; i < 2; ++i) { int R, C; stage_rc(tid * 16 + i * 8192, R, C); const int Rb = Epi::PERM ? ((R & ~31) + perm32(R & 31)) : R;
        voffA[i] = (unsigned)(R * K + C) * 2u; voffB[i] = (unsigned)(Rb * K + C) * 2u; }
    const size_t kstep = (size_t)(BK * 2);
    const size_t hstep = (size_t)HALF * K * 2;
    const unsigned ldsw = (unsigned)wid * 1024u;
    const int aoff = lds_byte(wr * 64 + fr, fq * 8), boff = lds_byte(wc * 32 + fr, fq * 8);
#define PG8_SA(b, h) (((b) * 2 + (h)) * HTB)
#define PG8_SB(b, h) ((4 + (b) * 2 + (h)) * HTB)
#define PG8_STAGE(bufoff, gbase, voff) do { _Pragma("unroll") for (int _i = 0; _i < 2; ++_i) \
        __builtin_amdgcn_global_load_lds((const unsigned*)((const char*)(gbase) + (voff)[_i]), (LAS unsigned*)(lds + (bufoff) + ldsw + _i * 8192), 16, 0, 0); } while (0)
#define PG8_LDA(dst, b, h) do { _Pragma("unroll") for (int m = 0; m < 4; ++m) _Pragma("unroll") for (int k = 0; k < 2; ++k) dst[m][k] = *(const LAS bf16x8*)(lds + PG8_SA(b, h) + aoff + m * 2048 + k * 1024); } while (0)
#define PG8_LDB(dst, b, h) do { _Pragma("unroll") for (int n = 0; n < 2; ++n) _Pragma("unroll") for (int k = 0; k < 2; ++k) dst[n][k] = *(const LAS bf16x8*)(lds + PG8_SB(b, h) + boff + n * 2048 + k * 1024); } while (0)
#define PG8_MMA(ai, bj, At, Bt) do { __builtin_amdgcn_s_setprio(1); _Pragma("unroll") for (int m = 0; m < 4; ++m) _Pragma("unroll") for (int n = 0; n < 2; ++n) _Pragma("unroll") for (int k = 0; k < 2; ++k) \
        acc[ai][bj][m][n] = __builtin_amdgcn_mfma_f32_16x16x32_bf16(Bt[n][k], At[m][k], acc[ai][bj][m][n], 0, 0, 0); __builtin_amdgcn_s_setprio(0); } while (0)
#define PG8_WAIT_V(n) asm volatile("s_waitcnt vmcnt(" #n ")" ::: "memory")
#define PG8_WAIT_L(n) asm volatile("s_waitcnt lgkmcnt(" #n ")" ::: "memory")
#define PG8_BAR __builtin_amdgcn_s_barrier()
#define PG8_SCHED __builtin_amdgcn_sched_barrier(0)
    Unit cur = S.next(0), nxt; int ui = 0;
    if (cur.pm < 0) return;
    f32x4 acc[2][2][4][2];
#pragma unroll
    for (int a = 0; a < 2; ++a)
#pragma unroll
        for (int b = 0; b < 2; ++b)
#pragma unroll
            for (int m = 0; m < 4; ++m)
#pragma unroll
                for (int n = 0; n < 2; ++n) acc[a][b][m][n] = (f32x4){0.f, 0.f, 0.f, 0.f};
    bf16x8 At[4][2], B0[2][2], B1[2][2];
    unsigned cvo0[2] = {0u, 0u}, cvo1[2] = {0u, 0u}, nvo0[2] = {0u, 0u}, nvo1[2] = {0u, 0u};
    auto load_vo = [&](const Unit& u, unsigned (&v0)[2], unsigned (&v1)[2]) {
#pragma unroll
        for (int i = 0; i < 2; ++i) { int R, C; stage_rc(tid * 16 + i * 8192, R, C);
            int r0 = R, r1 = HALF + R;
            int t0, t1;
            if (u.gofs >= 0) { t0 = (r0 < u.nrows) ? g.gtab[u.gofs + r0] : ZROW; t1 = (r1 < u.nrows) ? g.gtab[u.gofs + r1] : ZROW; }
            else { t0 = u.orow0 + r0; t1 = u.orow0 + r1; }
            v0[i] = (unsigned)t0 * (unsigned)(K * 2) + (unsigned)(C * 2); v1[i] = (unsigned)t1 * (unsigned)(K * 2) + (unsigned)(C * 2); }
    };
    const size_t rowb = (size_t)K * 2;
    const char* cA = (const char*)g.A + (GATHER ? 0 : (size_t)cur.arow * rowb); const char* cB = (const char*)g.Bt + (size_t)cur.brow * rowb;
    if (GATHER) load_vo(cur, cvo0, cvo1);
    if (GATHER) {
        PG8_STAGE(PG8_SB(0, 0), cB, voffB); PG8_STAGE(PG8_SA(0, 0), cA, cvo0); PG8_STAGE(PG8_SB(0, 1), cB + hstep, voffB); PG8_STAGE(PG8_SA(0, 1), cA, cvo1);
    } else {
        PG8_STAGE(PG8_SB(0, 0), cB, voffB); PG8_STAGE(PG8_SA(0, 0), cA, voffA); PG8_STAGE(PG8_SB(0, 1), cB + hstep, voffB); PG8_STAGE(PG8_SA(0, 1), cA + hstep, voffA);
    }
    if (wr == 1) PG8_BAR;
    PG8_WAIT_V(4); PG8_BAR;
    if (GATHER) {
        PG8_STAGE(PG8_SB(1, 0), cB + kstep, voffB); PG8_STAGE(PG8_SA(1, 0), cA + kstep, cvo0); PG8_STAGE(PG8_SB(1, 1), cB + hstep + kstep, voffB);
    } else {
        PG8_STAGE(PG8_SB(1, 0), cB + kstep, voffB); PG8_STAGE(PG8_SA(1, 0), cA + kstep, voffA); PG8_STAGE(PG8_SB(1, 1), cB + hstep + kstep, voffB);
    }
    PG8_WAIT_V(6); PG8_BAR;
    for (;;) {
        nxt = S.next(ui + 1); const bool has_next = nxt.pm >= 0;
        const char* nA = GATHER ? cA : (has_next ? (const char*)g.A + (size_t)nxt.arow * rowb : cA); const char* nB = has_next ? (const char*)g.Bt + (size_t)nxt.brow * rowb : cB;
        if (GATHER) { if (has_next) load_vo(nxt, nvo0, nvo1); else { nvo0[0] = cvo0[0]; nvo0[1] = cvo0[1]; nvo1[0] = cvo1[0]; nvo1[1] = cvo1[1]; } }
        for (int t = 0; t < nt; t += 2) {
            const bool last = (t == nt - 2);
            const char* a1 = cA + (size_t)(t + 1) * kstep;
            const char* a2 = last ? nA : cA + (size_t)(t + 2) * kstep; const char* b2 = last ? nB : cB + (size_t)(t + 2) * kstep;
            const char* a3 = a2 + kstep; const char* b3 = b2 + kstep;
            unsigned s0[2], s1[2];
            if (GATHER) { s0[0] = last ? nvo0[0] : cvo0[0]; s0[1] = last ? nvo0[1] : cvo0[1]; s1[0] = last ? nvo1[0] : cvo1[0]; s1[1] = last ? nvo1[1] : cvo1[1]; }
            PG8_LDB(B0, 0, 0); PG8_SCHED; PG8_LDA(At, 0, 0);
            if (GATHER) PG8_STAGE(PG8_SA(1, 1), a1, cvo1); else PG8_STAGE(PG8_SA(1, 1), a1 + hstep, voffA);
            PG8_WAIT_L(8); PG8_BAR; PG8_WAIT_L(0); PG8_MMA(0, 0, At, B0); PG8_BAR; PG8_SCHED;
            PG8_LDB(B1, 0, 1); PG8_STAGE(PG8_SB(0, 0), b2, voffB);
            PG8_BAR; PG8_WAIT_L(0); PG8_MMA(0, 1, At, B1); PG8_BAR;
            PG8_LDA(At, 0, 1);
            if (GATHER) PG8_STAGE(PG8_SA(0, 0), a2, s0); else PG8_STAGE(PG8_SA(0, 0), a2, voffA);
            PG8_BAR; PG8_WAIT_L(0); PG8_MMA(1, 0, At, B0); PG8_BAR; PG8_SCHED;
            PG8_STAGE(PG8_SB(0, 1), b2 + hstep, voffB);
            PG8_WAIT_V(6); PG8_BAR; PG8_MMA(1, 1, At, B1); PG8_BAR;
            PG8_LDB(B0, 1, 0); PG8_SCHED; PG8_LDA(At, 1, 0);
            if (GATHER) PG8_STAGE(PG8_SA(0, 1), a2, s1); else PG8_STAGE(PG8_SA(0, 1), a2 + hstep, voffA);
            PG8_WAIT_L(8); PG8_BAR; PG8_WAIT_L(0); PG8_MMA(0, 0, At, B0); PG8_BAR; PG8_SCHED;
            PG8_LDB(B1, 1, 1); PG8_STAGE(PG8_SB(1, 0), b3, voffB);
            PG8_BAR; PG8_WAIT_L(0); PG8_MMA(0, 1, At, B1); PG8_BAR;
            PG8_LDA(At, 1, 1);
            if (GATHER) PG8_STAGE(PG8_SA(1, 0), a3, s0); else PG8_STAGE(PG8_SA(1, 0), a3, voffA);
            PG8_BAR; PG8_WAIT_L(0); PG8_MMA(1, 0, At, B0); PG8_BAR; PG8_SCHED;
            PG8_STAGE(PG8_SB(1, 1), b3 + hstep, voffB);
            PG8_WAIT_V(6); PG8_BAR; PG8_MMA(1, 1, At, B1); PG8_BAR;
        }
        E(acc, cur, wr, wc, fr, fq);
        if (!has_next) break;
#pragma unroll
        for (int a = 0; a < 2; ++a)
#pragma unroll
            for (int b = 0; b < 2; ++b)
#pragma unroll
                for (int m = 0; m < 4; ++m)
#pragma unroll
                    for (int n = 0; n < 2; ++n) acc[a][b][m][n] = (f32x4){0.f, 0.f, 0.f, 0.f};
        cur = nxt; cA = nA; cB = nB; ++ui;
        if (GATHER) { cvo0[0] = nvo0[0]; cvo0[1] = nvo0[1]; cvo1[0] = nvo1[0]; cvo1[1] = nvo1[1]; }
    }
    PG8_WAIT_V(0);
    if (wr == 0) PG8_BAR;
    PG8_BAR;
#undef PG8_SA
#undef PG8_SB
#undef PG8_STAGE
#undef PG8_LDA
#undef PG8_LDB
#undef PG8_MMA
#undef PG8_WAIT_V
#undef PG8_WAIT_L
#undef PG8_BAR
#undef PG8_SCHED
}
}
using pg8::Unit;

typedef f32x4 Acc[2][2][4][2];

template <int O0, int O1, int O2, int O3>
__device__ __forceinline__ void ld4x16(const void* p, f32x4& a, f32x4& b, f32x4& c, f32x4& d) {
    asm volatile("global_load_dwordx4 %0, %4, off offset:%5\n\tglobal_load_dwordx4 %1, %4, off offset:%6\n\tglobal_load_dwordx4 %2, %4, off offset:%7\n\tglobal_load_dwordx4 %3, %4, off offset:%8\n\ts_waitcnt vmcnt(0)"
                 : "=&v"(a), "=&v"(b), "=&v"(c), "=&v"(d) : "v"(p), "i"(O0), "i"(O1), "i"(O2), "i"(O3) : "memory");
}
template <int O0, int O1, int O2, int O3>
__device__ __forceinline__ void ld4x16_4x8(const void* p, f32x4& a, f32x4& b, f32x4& c, f32x4& d, const void* q, u32x2& e, u32x2& f, u32x2& g, u32x2& h) {
    asm volatile("global_load_dwordx4 %0, %8, off offset:%10\n\tglobal_load_dwordx4 %1, %8, off offset:%11\n\tglobal_load_dwordx4 %2, %8, off offset:%12\n\tglobal_load_dwordx4 %3, %8, off offset:%13\n\t"
                 "global_load_dwordx2 %4, %9, off offset:%14\n\tglobal_load_dwordx2 %5, %9, off offset:%15\n\tglobal_load_dwordx2 %6, %9, off offset:%16\n\tglobal_load_dwordx2 %7, %9, off offset:%17\n\ts_waitcnt vmcnt(0)"
                 : "=&v"(a), "=&v"(b), "=&v"(c), "=&v"(d), "=&v"(e), "=&v"(f), "=&v"(g), "=&v"(h)
                 : "v"(p), "v"(q), "i"(O0), "i"(O1), "i"(O2), "i"(O3), "i"(O0 / 2), "i"(O1 / 2), "i"(O2 / 2), "i"(O3 / 2) : "memory");
}
struct EpiQKVU {
    static constexpr bool PERM = true;
    bf16_t* zq; float* u;
    __device__ __forceinline__ void operator()(const Acc& acc, const Unit& un, int wr, int wc, int fr, int fq) const {
        const int row0 = un.pm * 256 + wr * 64 + fr, col0 = un.pn * 256 + wc * 32 + 8 * fq;
        if (un.pn < 12) {
#pragma unroll
            for (int ai = 0; ai < 2; ++ai)
#pragma unroll
                for (int m = 0; m < 4; ++m) { bf16_t* rowp = zq + (size_t)(row0 + ai * 128 + m * 16) * 3072 + col0;
#pragma unroll
                    for (int bj = 0; bj < 2; ++bj) { const f32x4 v0 = acc[ai][bj][m][0], v1 = acc[ai][bj][m][1];
                        u32x4 w; w.x = cvt_pk_bf16(v0[0], v0[1]); w.y = cvt_pk_bf16(v0[2], v0[3]); w.z = cvt_pk_bf16(v1[0], v1[1]); w.w = cvt_pk_bf16(v1[2], v1[3]);
                        *(u32x4*)(rowp + bj * 128) = w; } }
        } else {
#pragma unroll
            for (int ai = 0; ai < 2; ++ai)
#pragma unroll
                for (int m = 0; m < 4; ++m) { float* rowp = u + (size_t)(row0 + ai * 128 + m * 16) * 1024 + (col0 - 3072);
#pragma unroll
                    for (int bj = 0; bj < 2; ++bj) { *(f32x4*)(rowp + bj * 128) = acc[ai][bj][m][0]; *(f32x4*)(rowp + bj * 128 + 4) = acc[ai][bj][m][1]; } }
        }
    }
};
struct EpiGLU {
    static constexpr bool PERM = true;
    const bf16_t* __restrict__ y; bf16_t* __restrict__ mix;
    __device__ __forceinline__ void operator()(const Acc& acc, const Unit& un, int wr, int wc, int fr, int fq) const {
        const int row0 = un.pm * 256 + wr * 64 + fr, col0 = un.pn * 256 + wc * 32 + 8 * fq;
#pragma unroll
        for (int ai = 0; ai < 2; ++ai)
#pragma unroll
            for (int m = 0; m < 4; ++m) { const size_t row = (size_t)(row0 + ai * 128 + m * 16);
#pragma unroll
                for (int bj = 0; bj < 2; ++bj) { const f32x4 v0 = acc[ai][bj][m][0], v1 = acc[ai][bj][m][1];
                    const u32x4 yv = *(const u32x4*)(y + row * 1024 + col0 + bj * 128);
                    u32x4 w;
                    w.x = cvt_pk_bf16(bf_lo(yv.x) * sigmoidf_(v0[0]), bf_hi(yv.x) * sigmoidf_(v0[1]));
                    w.y = cvt_pk_bf16(bf_lo(yv.y) * sigmoidf_(v0[2]), bf_hi(yv.y) * sigmoidf_(v0[3]));
                    w.z = cvt_pk_bf16(bf_lo(yv.z) * sigmoidf_(v1[0]), bf_hi(yv.z) * sigmoidf_(v1[1]));
                    w.w = cvt_pk_bf16(bf_lo(yv.w) * sigmoidf_(v1[2]), bf_hi(yv.w) * sigmoidf_(v1[3]));
                    *(u32x4*)(mix + row * 2048 + 1024 + col0 + bj * 128) = w; } }
    }
};
struct EpiRes {
    static constexpr bool PERM = false;
    const float* x; float* h1;
    __device__ __forceinline__ void operator()(const Acc& acc, const Unit& un, int wr, int wc, int fr, int fq) const {
        const int row0 = un.pm * 256 + wr * 64 + fr, col0 = un.pn * 256 + wc * 32 + 4 * fq;
#pragma unroll
        for (int ai = 0; ai < 2; ++ai)
#pragma unroll
            for (int m = 0; m < 4; ++m) { const size_t ro = (size_t)(row0 + ai * 128 + m * 16) * 2048 + col0;
                f32x4 x00, x01, x10, x11; ld4x16<0, 64, 512, 576>(x + ro, x00, x01, x10, x11);
                *(f32x4*)(h1 + ro) = x00 + acc[ai][0][m][0]; *(f32x4*)(h1 + ro + 16) = x01 + acc[ai][0][m][1];
                *(f32x4*)(h1 + ro + 128) = x10 + acc[ai][1][m][0]; *(f32x4*)(h1 + ro + 144) = x11 + acc[ai][1][m][1]; }
    }
};
struct EpiSwiGLU {
    static constexpr bool PERM = true;
    bf16_t* H; bf16_t* Hs;
    __device__ __forceinline__ void operator()(const Acc& acc, const Unit& un, int wr, int wc, int fr, int fq) const {
        bf16_t* base = un.kind ? Hs : H;
        const size_t row0 = (size_t)un.orow0 + wr * 64 + fr; const int col0 = un.pn * 128 + wc * 32 + 8 * fq;
#pragma unroll
        for (int ai = 0; ai < 2; ++ai)
#pragma unroll
            for (int m = 0; m < 4; ++m) { const f32x4 g0 = acc[ai][0][m][0], g1 = acc[ai][0][m][1], u0 = acc[ai][1][m][0], u1 = acc[ai][1][m][1];
                u32x4 w;
                w.x = cvt_pk_bf16(g0[0] * sigmoidf_(g0[0]) * u0[0], g0[1] * sigmoidf_(g0[1]) * u0[1]);
                w.y = cvt_pk_bf16(g0[2] * sigmoidf_(g0[2]) * u0[2], g0[3] * sigmoidf_(g0[3]) * u0[3]);
                w.z = cvt_pk_bf16(g1[0] * sigmoidf_(g1[0]) * u1[0], g1[1] * sigmoidf_(g1[1]) * u1[1]);
                w.w = cvt_pk_bf16(g1[2] * sigmoidf_(g1[2]) * u1[2], g1[3] * sigmoidf_(g1[3]) * u1[3]);
                *(u32x4*)(base + (row0 + ai * 128 + m * 16) * 512 + col0) = w; }
    }
};
struct EpiDown {
    static constexpr bool PERM = true;
    bf16_t* Y; bf16_t* Ysh;
    __device__ __forceinline__ void operator()(const Acc& acc, const Unit& un, int wr, int wc, int fr, int fq) const {
        const int col0 = un.pn * 256 + wc * 32 + 8 * fq; bf16_t* base = (un.kind ? Ysh : Y) + (size_t)un.orow0 * 2048 + col0;
#pragma unroll
        for (int ai = 0; ai < 2; ++ai)
#pragma unroll
            for (int m = 0; m < 4; ++m) { const int r = ai * 128 + wr * 64 + m * 16 + fr;
                if (r < un.nrows) { bf16_t* rowp = base + (size_t)r * 2048;
#pragma unroll
                    for (int bj = 0; bj < 2; ++bj) { const f32x4 v0 = acc[ai][bj][m][0], v1 = acc[ai][bj][m][1];
                        u32x4 w; w.x = cvt_pk_bf16(v0[0], v0[1]); w.y = cvt_pk_bf16(v0[2], v0[3]); w.z = cvt_pk_bf16(v1[0], v1[1]); w.w = cvt_pk_bf16(v1[2], v1[3]);
                        *(u32x4*)(rowp + bj * 128) = w; } } }
    }
};
struct EpiBf16 {
    static constexpr bool PERM = true;
    bf16_t* O; int ldo;
    __device__ __forceinline__ void operator()(const Acc& acc, const Unit& un, int wr, int wc, int fr, int fq) const {
        const int row0 = un.pm * 256 + wr * 64 + fr, col0 = un.pn * 256 + wc * 32 + 8 * fq;
#pragma unroll
        for (int ai = 0; ai < 2; ++ai)
#pragma unroll
            for (int m = 0; m < 4; ++m) { bf16_t* rowp = O + (size_t)(row0 + ai * 128 + m * 16) * ldo + col0;
#pragma unroll
                for (int bj = 0; bj < 2; ++bj) { const f32x4 v0 = acc[ai][bj][m][0], v1 = acc[ai][bj][m][1];
                    u32x4 w; w.x = cvt_pk_bf16(v0[0], v0[1]); w.y = cvt_pk_bf16(v0[2], v0[3]); w.z = cvt_pk_bf16(v1[0], v1[1]); w.w = cvt_pk_bf16(v1[2], v1[3]);
                    *(u32x4*)(rowp + bj * 128) = w; } }
    }
};
struct EpiPle {
    static constexpr bool PERM = false;
    float* out; const bf16_t* proj; const float* h2;
    __device__ __forceinline__ void operator()(const Acc& acc, const Unit& un, int wr, int wc, int fr, int fq) const {
        const int row0 = un.pm * 256 + wr * 64 + fr, col0 = un.pn * 256 + wc * 32 + 4 * fq;
#pragma unroll
        for (int ai = 0; ai < 2; ++ai)
#pragma unroll
            for (int m = 0; m < 4; ++m) { const size_t ro = (size_t)(row0 + ai * 128 + m * 16) * 2048 + col0;
                f32x4 hv[4]; u32x2 pv[4]; ld4x16_4x8<0, 64, 512, 576>(h2 + ro, hv[0], hv[1], hv[2], hv[3], proj + ro, pv[0], pv[1], pv[2], pv[3]);
#pragma unroll
                for (int q = 0; q < 4; ++q) { const int bj = q >> 1, n = q & 1; const f32x4 a = acc[ai][bj][m][n]; f32x4 r;
                    r[0] = hv[q][0] + sigmoidf_(a[0]) * bf_lo(pv[q].x); r[1] = hv[q][1] + sigmoidf_(a[1]) * bf_hi(pv[q].x);
                    r[2] = hv[q][2] + sigmoidf_(a[2]) * bf_lo(pv[q].y); r[3] = hv[q][3] + sigmoidf_(a[3]) * bf_hi(pv[q].y);
                    *(f32x4*)(out + ro + bj * 128 + n * 16) = r; } }
    }
};

struct MoeSched {
    int G, c, n_rt, NPN, K; bool down;
    const LAS int* rt_e; const LAS int* rt_j; const LAS int* rt_n;
    __device__ __forceinline__ Unit next(int i) const {
        Unit u; const int NRT = n_rt + 32, per = (NRT + 7) >> 3, SL = G >> 3, x = c & 7, s = c >> 3;
        const int q = i * SL + s, rl = q / NPN, rtg = x * per + rl;
        const bool valid = s < SL && rl < per && rtg < NRT, routed = valid && rtg < n_rt;
        const int rt = routed ? rtg : 0, spm = (valid && !routed) ? rtg - n_rt : 0;
        const int e = __builtin_amdgcn_readfirstlane(rt_e[rt]), j = __builtin_amdgcn_readfirstlane(rt_j[rt]);
        const int rem = __builtin_amdgcn_readfirstlane(rt_n[rt]);
        const int Lr = q % NPN;
        u.kind = routed ? 0 : 1;
        u.pn = Lr;
        u.pm = routed ? rt : spm;
        u.nrows = routed ? rem : 256;
        const int ee = routed ? e : NE;
        if (!down) {
            u.arow = 0; u.gofs = routed ? (e * CAP + j * 256) : -1;
            u.brow = ee * 1024 + u.pn * 256;
            u.orow0 = routed ? rt * 256 : spm * 256;
        } else {
            u.gofs = -1;
            u.arow = routed ? rt * 256 : 65536 + spm * 256;
            u.brow = ee * 2048 + u.pn * 256;
            u.orow0 = routed ? rt * 256 : spm * 256;
        }
        if (!valid) u.pm = -1;
        return u;
    }
};

__device__ __forceinline__ void cvt_tile(const float* __restrict__ src, int ldw, int k0, int n0, const float* __restrict__ gain, bf16_t* __restrict__ dst, int ldd, int dk0,
                                         int inter, int roff, LAS float* lt) {
    const int tid = threadIdx.x, c4 = tid & 63, r8 = tid >> 6;
    f32x4 v[8];
#pragma unroll
    for (int i = 0; i < 8; ++i) v[i] = *(const f32x4*)(src + (size_t)(k0 + r8 + 8 * i) * ldw + n0 + 4 * c4);
#pragma unroll
    for (int i = 0; i < 8; ++i) { const int k = r8 + 8 * i; const float gsc = gain ? gain[k0 + k] : 1.0f; LAS float* q = lt + k * 257 + 4 * c4;
        q[0] = v[i][0] * gsc; q[1] = v[i][1] * gsc; q[2] = v[i][2] * gsc; q[3] = v[i][3] * gsc; }
    __syncthreads();
#pragma unroll
    for (int i = 0; i < 4; ++i) { const int q = tid + 512 * i, kg = q & 7, n = q >> 3; const LAS float* s = lt + (8 * kg) * 257 + n;
        u32x4 w; w.x = cvt_pk_bf16(s[0], s[257]); w.y = cvt_pk_bf16(s[2 * 257], s[3 * 257]); w.z = cvt_pk_bf16(s[4 * 257], s[5 * 257]); w.w = cvt_pk_bf16(s[6 * 257], s[7 * 257]);
        const int ng = n0 + n; const int drow = inter ? ((ng >> 7) * 256 + roff + (ng & 127)) : ng;
        *(u32x4*)(dst + (size_t)drow * ldd + dk0 + k0 + 8 * kg) = w; }
    __syncthreads();
}
__device__ __forceinline__ void cvt_job(long& base, const float* src, int K, int N, const float* gain, bf16_t* dst, int ldd, int dk0, int inter, int roff, LAS float* lt) {
    const int nk = K / 64, nn = N / 256, ntl = nk * nn, G = gridDim.x;
    int t = (int)(((long)blockIdx.x - base % G + G) % G);
    for (; t < ntl; t += G) { const int kt = t % nk, ntile = t / nk; cvt_tile(src, N, kt * 64, ntile * 256, gain, dst, ldd, dk0, inter, roff, lt); }
    base += ntl;
}
__device__ void phase_prologue(const Params& P, LAS unsigned char* lds) {
    LAS float* lt = (LAS float*)lds;
    const int tid = threadIdx.x, wid = tid >> 6, lane = tid & 63, G = gridDim.x;
    for (int row = blockIdx.x * 8 + wid; row < T_; row += G * 8) {
        const float* xr = P.x + (size_t)row * DM; f32x4 v[8]; float ss = 0.f;
#pragma unroll
        for (int i = 0; i < 8; ++i) { v[i] = *(const f32x4*)(xr + 4 * lane + 256 * i); ss += v[i][0] * v[i][0] + v[i][1] * v[i][1] + v[i][2] * v[i][2] + v[i][3] * v[i][3]; }
        ss = wave_sum(ss); const float r = rsqrtf(ss * (1.0f / DM) + EPS);
#pragma unroll
        for (int i = 0; i < 8; ++i) { u32x2 w; w.x = cvt_pk_bf16(v[i][0] * r, v[i][1] * r); w.y = cvt_pk_bf16(v[i][2] * r, v[i][3] * r); *(u32x2*)(P.R1 + (size_t)row * DM + 4 * lane + 256 * i) = w; }
    }
    if (blockIdx.x == 0) { for (int i = tid; i < DM / 2; i += 512) ((unsigned*)(P.R1 + (size_t)ZROW * DM))[i] = 0u; }
    for (size_t i = (size_t)blockIdx.x * 512 + tid; i < (size_t)T_ * DPLE / 8; i += (size_t)G * 512) { const f32x4 a = *(const f32x4*)(P.p + i * 8), b2 = *(const f32x4*)(P.p + i * 8 + 4);
        u32x4 w; w.x = cvt_pk_bf16(a[0], a[1]); w.y = cvt_pk_bf16(a[2], a[3]); w.z = cvt_pk_bf16(b2[0], b2[1]); w.w = cvt_pk_bf16(b2[2], b2[3]); *(u32x4*)(P.pb + i * 8) = w; }
    for (int i = blockIdx.x * 512 + tid; i < NG * NP; i += G * 512) {
        const int g = i / NP;
        const float lr = P.lam_re[i], li = P.lam_im[i]; const float dt = expf(P.log_dt[g]);
        const double mag = exp((double)lr * (double)dt), ang = (double)li * (double)dt;
        const float ar = (float)(mag * cos(ang)), ai = (float)(mag * sin(ang));
        const double magL = exp((double)lr * (double)dt * SCH), angL = ang * SCH;
        P.abar[i] = make_float2(ar, ai); P.aL[i] = make_float2((float)(magL * cos(angL)), (float)(magL * sin(angL)));
        const float nr = ar - 1.0f, ni = ai, den = lr * lr + li * li;
        const float cr = (nr * lr + ni * li) / den, ci = (ni * lr - nr * li) / den;
#pragma unroll
        for (int h = 0; h < GH; ++h) { const float br = P.b_re[(size_t)i * GH + h], bi = P.b_im[(size_t)i * GH + h];
            P.bbar[(size_t)i * GH + h] = make_float2(cr * br - ci * bi, cr * bi + ci * br); }
    }
    for (int i = blockIdx.x * 512 + tid; i < NE * DM; i += G * 512) { const int e = i / DM, k = i % DM; const float w = P.w_router[(size_t)k * NE + e] * P.norm_ffn[k];
        const unsigned hw = cvt_pk_bf16(w, 0.f); const float hf = bf_lo(hw); P.Wr_hi[i] = (bf16_t)(hw & 0xffffu); P.Wr_lo[i] = (bf16_t)(cvt_pk_bf16(w - hf, 0.f) & 0xffffu); }
    long base = 0;
    cvt_job(base, P.w_in, 2048, 4096, P.norm_mix, P.Wt_in, 2048, 0, 0, 0, lt);
    cvt_job(base, P.w_glu, 1024, 1024, nullptr, P.Wt_glu, 1024, 0, 0, 0, lt);
    cvt_job(base, P.w_out, 1024, 2048, P.attn_out_norm, P.Wt_out, 2048, 0, 0, 0, lt);
    cvt_job(base, P.w_out + (size_t)1024 * 2048, 1024, 2048, P.ssm_out_norm, P.Wt_out, 2048, 1024, 0, 0, lt);
    cvt_job(base, P.w_sg, 2048, 512, nullptr, P.Wt_egu + (size_t)NE * 1024 * 2048, 2048, 0, 1, 0, lt);
    cvt_job(base, P.w_su, 2048, 512, nullptr, P.Wt_egu + (size_t)NE * 1024 * 2048, 2048, 0, 1, 128, lt);
    cvt_job(base, P.w_sd, 512, 2048, nullptr, P.Wt_ed + (size_t)NE * 2048 * 512, 512, 0, 0, 0, lt);
    cvt_job(base, P.w_pg, 2048, 2048, P.norm_ple, P.Wt_pg, 2048, 0, 0, 0, lt);
    cvt_job(base, P.w_pp, 256, 2048, nullptr, P.Wt_pp, 256, 0, 0, 0, lt);
    {
        const int ntl = NE * 192; int t = (int)(((long)blockIdx.x - base % G + G) % G);
        for (; t < ntl; t += G) { const int e = t / 192, r = t % 192;
            if (r < 128) { const int up = r >> 6, q = r & 63, kt = q & 31, ntile = q >> 5;
                cvt_tile((up ? P.w_eu : P.w_eg) + (size_t)e * 2048 * 512, 512, kt * 64, ntile * 256, nullptr, P.Wt_egu + (size_t)e * 1024 * 2048, 2048, 0, 1, up ? 128 : 0, lt); }
            else { const int q = r - 128, kt = q & 7, ntile = q >> 3;
                cvt_tile(P.w_ed + (size_t)e * 512 * 2048, 2048, kt * 64, ntile * 256, nullptr, P.Wt_ed + (size_t)e * 2048 * 512, 512, 0, 0, 0, lt); } }
    }
}

#define KSWZ(row, colB) ((row) * 256 + ((colB) ^ (((row) & 7) << 4)))
#define SBAR() __builtin_amdgcn_sched_barrier(0)
__device__ __forceinline__ int crow(int r, int hi) { return (r & 3) + 8 * (r >> 2) + 4 * hi; }
__device__ __forceinline__ void qkt(f32x16& p0, f32x16& p1, const LAS unsigned char* Ks, const bf16x8* qr, int r32, int hi) {
    p0 = f32x16{}; p1 = f32x16{};
#pragma unroll
    for (int d0 = 0; d0 < 8; ++d0) { const int cb = (d0 * 16 + hi * 8) * 2;
        const bf16x8 b0 = *(const LAS bf16x8*)(Ks + KSWZ(r32, cb));
        const bf16x8 b1 = *(const LAS bf16x8*)(Ks + KSWZ(32 + r32, cb));
        p0 = __builtin_amdgcn_mfma_f32_32x32x16_bf16(b0, qr[d0], p0, 0, 0, 0);
        p1 = __builtin_amdgcn_mfma_f32_32x32x16_bf16(b1, qr[d0], p1, 0, 0, 0); }
}
__device__ __forceinline__ int v_st(int k, int c) { const int kk = (k & ~0xC) | ((k & 4) << 1) | ((k & 8) >> 1); return ((kk >> 3) * 4 + (c >> 5)) * 512 + ((kk & 7) * 32 + (c & 31)) * 2; }
__device__ __forceinline__ int v_rd_base(int lane) { return ((lane & 3) << 3) | (((lane >> 2) & 3) << 6) | (((lane >> 4) & 1) << 5) | (((lane >> 5) & 1) << 8); }
constexpr int v_rd_off(int d0, int ks, int half) { return d0 * 512 + ks * 4096 + half * 2048; }
template <int D0> __device__ __forceinline__ void pv_one(f32x16& od, int vb, bf16x8 pa0, bf16x8 pa1, bf16x8 pa2, bf16x8 pa3) {
    s16x4 l0, h0, l1, h1, l2, h2, l3, h3;
    asm volatile("ds_read_b64_tr_b16 %0, %8 offset:%9\n\t"
                 "ds_read_b64_tr_b16 %1, %8 offset:%10\n\t"
                 "ds_read_b64_tr_b16 %2, %8 offset:%11\n\t"
                 "ds_read_b64_tr_b16 %3, %8 offset:%12\n\t"
                 "ds_read_b64_tr_b16 %4, %8 offset:%13\n\t"
                 "ds_read_b64_tr_b16 %5, %8 offset:%14\n\t"
                 "ds_read_b64_tr_b16 %6, %8 offset:%15\n\t"
                 "ds_read_b64_tr_b16 %7, %8 offset:%16\n\t"
                 "s_waitcnt lgkmcnt(0)"
                 : "=&v"(l0), "=&v"(h0), "=&v"(l1), "=&v"(h1), "=&v"(l2), "=&v"(h2), "=&v"(l3), "=&v"(h3)
                 : "v"(vb), "i"(v_rd_off(D0, 0, 0)), "i"(v_rd_off(D0, 0, 1)), "i"(v_rd_off(D0, 1, 0)), "i"(v_rd_off(D0, 1, 1)),
                   "i"(v_rd_off(D0, 2, 0)), "i"(v_rd_off(D0, 2, 1)), "i"(v_rd_off(D0, 3, 0)), "i"(v_rd_off(D0, 3, 1))
                 : "memory");
    SBAR();
#define PK(L, H) (bf16x8){L[0], L[1], L[2], L[3], H[0], H[1], H[2], H[3]}
    od = __builtin_amdgcn_mfma_f32_32x32x16_bf16(pa0, PK(l0, h0), od, 0, 0, 0);
    od = __builtin_amdgcn_mfma_f32_32x32x16_bf16(pa1, PK(l1, h1), od, 0, 0, 0);
    od = __builtin_amdgcn_mfma_f32_32x32x16_bf16(pa2, PK(l2, h2), od, 0, 0, 0);
    od = __builtin_amdgcn_mfma_f32_32x32x16_bf16(pa3, PK(l3, h3), od, 0, 0, 0);
#undef PK
}
__device__ __forceinline__ float softplus_(float z) { return fmaxf(z, 0.f) + __logf(1.0f + __expf(-fabsf(z))); }

__device__ void attn_unit(const Params& P, int unit, LAS unsigned char* lds) {
    const int qb = unit & 7, h = (unit >> 3) & 7, b = unit >> 6;
    const int tid = threadIdx.x, wid = tid >> 6, lane = tid & 63, r32 = lane & 31, hi = lane >> 5;
    const int q0 = qb * 256; const size_t tokbase = (size_t)b * SEQ;
    LAS unsigned char* K_lds = lds; LAS unsigned char* V_lds = lds + 16384; volatile LAS int* flags = (volatile LAS int*)(lds + LDS_FLAGS);
    const int tq = q0 + wid * 32 + r32;
    bf16x8 qr[8];
    {
        const bf16_t* qp = P.zq + (tokbase + tq) * 3072 + h * HD + hi * 8;
        u32x4 raw[8]; float ss = 0.f;
#pragma unroll
        for (int d0 = 0; d0 < 8; ++d0) { raw[d0] = *(const u32x4*)(qp + d0 * 16);
            const float a0 = bf_lo(raw[d0].x), a1 = bf_hi(raw[d0].x), a2 = bf_lo(raw[d0].y), a3 = bf_hi(raw[d0].y), a4 = bf_lo(raw[d0].z), a5 = bf_hi(raw[d0].z), a6 = bf_lo(raw[d0].w), a7 = bf_hi(raw[d0].w);
            ss += a0 * a0 + a1 * a1 + a2 * a2 + a3 * a3 + a4 * a4 + a5 * a5 + a6 * a6 + a7 * a7; }
        ss += __shfl_xor(ss, 32);
        const float rq = rsqrtf(ss * (1.0f / HD) + EPS) * 0.088388347648318440f;
#pragma unroll
        for (int d0 = 0; d0 < 8; ++d0) { const float* gq = P.q_norm + d0 * 16 + hi * 8; const f32x4 g0 = *(const f32x4*)gq, g1 = *(const f32x4*)(gq + 4);
            u32x4 w;
            w.x = cvt_pk_bf16(bf_lo(raw[d0].x) * rq * g0[0], bf_hi(raw[d0].x) * rq * g0[1]); w.y = cvt_pk_bf16(bf_lo(raw[d0].y) * rq * g0[2], bf_hi(raw[d0].y) * rq * g0[3]);
            w.z = cvt_pk_bf16(bf_lo(raw[d0].z) * rq * g1[0], bf_hi(raw[d0].z) * rq * g1[1]); w.w = cvt_pk_bf16(bf_lo(raw[d0].w) * rq * g1[2], bf_hi(raw[d0].w) * rq * g1[3]);
            qr[d0] = *(bf16x8*)&w; }
    }
    const int sr = tid >> 4, sc = (tid & 15) * 8, vst0 = v_st(sr, sc), vst1 = v_st(32 + sr, sc);
    const int vb0 = (int)(unsigned)(uintptr_t)V_lds + v_rd_base(lane);
    const f32x4 gk0 = *(const f32x4*)(P.k_norm + sc), gk1 = *(const f32x4*)(P.k_norm + sc + 4);
    f32x16 o[4]; o[0] = f32x16{}; o[1] = f32x16{}; o[2] = f32x16{}; o[3] = f32x16{};
    float Rc = 0.f; bool done = false;
    const int tw_max = q0 + wid * 32 + 31;
    if (tid < 8) flags[tid] = 0;
    for (int kt = (q0 >> 6) + 3; kt >= 0; --kt) {
        {
            const bf16_t* kp0 = P.zq + (tokbase + kt * 64 + sr) * 3072 + 1024 + h * HD + sc; const bf16_t* kp1 = kp0 + (size_t)32 * 3072;
            const u32x4 k0 = *(const u32x4*)kp0, k1 = *(const u32x4*)kp1, v0 = *(const u32x4*)(kp0 + 1024), v1 = *(const u32x4*)(kp1 + 1024);
            float s0 = bf_lo(k0.x) * bf_lo(k0.x) + bf_hi(k0.x) * bf_hi(k0.x) + bf_lo(k0.y) * bf_lo(k0.y) + bf_hi(k0.y) * bf_hi(k0.y) + bf_lo(k0.z) * bf_lo(k0.z) + bf_hi(k0.z) * bf_hi(k0.z) + bf_lo(k0.w) * bf_lo(k0.w) + bf_hi(k0.w) * bf_hi(k0.w);
            float s1 = bf_lo(k1.x) * bf_lo(k1.x) + bf_hi(k1.x) * bf_hi(k1.x) + bf_lo(k1.y) * bf_lo(k1.y) + bf_hi(k1.y) * bf_hi(k1.y) + bf_lo(k1.z) * bf_lo(k1.z) + bf_hi(k1.z) * bf_hi(k1.z) + bf_lo(k1.w) * bf_lo(k1.w) + bf_hi(k1.w) * bf_hi(k1.w);
#pragma unroll
            for (int o_ = 8; o_ >= 1; o_ >>= 1) { s0 += __shfl_xor(s0, o_); s1 += __shfl_xor(s1, o_); }
            const float r0 = rsqrtf(s0 * (1.0f / HD) + EPS), r1 = rsqrtf(s1 * (1.0f / HD) + EPS);
            u32x4 w0, w1;
            w0.x = cvt_pk_bf16(bf_lo(k0.x) * r0 * gk0[0], bf_hi(k0.x) * r0 * gk0[1]); w0.y = cvt_pk_bf16(bf_lo(k0.y) * r0 * gk0[2], bf_hi(k0.y) * r0 * gk0[3]);
            w0.z = cvt_pk_bf16(bf_lo(k0.z) * r0 * gk1[0], bf_hi(k0.z) * r0 * gk1[1]); w0.w = cvt_pk_bf16(bf_lo(k0.w) * r0 * gk1[2], bf_hi(k0.w) * r0 * gk1[3]);
            w1.x = cvt_pk_bf16(bf_lo(k1.x) * r1 * gk0[0], bf_hi(k1.x) * r1 * gk0[1]); w1.y = cvt_pk_bf16(bf_lo(k1.y) * r1 * gk0[2], bf_hi(k1.y) * r1 * gk0[3]);
            w1.z = cvt_pk_bf16(bf_lo(k1.z) * r1 * gk1[0], bf_hi(k1.z) * r1 * gk1[1]); w1.w = cvt_pk_bf16(bf_lo(k1.w) * r1 * gk1[2], bf_hi(k1.w) * r1 * gk1[3]);
            *(LAS u32x4*)(K_lds + KSWZ(sr, sc * 2)) = w0; *(LAS u32x4*)(K_lds + KSWZ(32 + sr, sc * 2)) = w1;
            *(LAS u32x4*)(V_lds + vst0) = v0; *(LAS u32x4*)(V_lds + vst1) = v1;
        }
        __syncthreads();
        if (!done && kt * 64 < tw_max) {
            f32x16 p0, p1; qkt(p0, p1, K_lds, qr, r32, hi);
            const int kb = kt * 64;
            float gs[8], pg[8], lz[32];
#pragma unroll
            for (int hf = 0; hf < 2; ++hf)
#pragma unroll
                for (int g = 0; g < 4; ++g) { float s = 0.f;
#pragma unroll
                    for (int i = 0; i < 4; ++i) { const int r = 4 * g + i; const float z = hf ? p1[r] : p0[r]; const bool causal = (kb + 32 * hf + crow(r, hi)) < tq;
                        const float spv = softplus_(z); lz[hf * 16 + r] = causal ? (z - spv) : -1e30f; const float spm = causal ? spv : 0.f;
                        if (hf) p1[r] = spm; else p0[r] = spm; s += spm; }
                    gs[hf * 4 + g] = s; }
#pragma unroll
            for (int i = 0; i < 8; ++i) pg[i] = __shfl_xor(gs[i], 32);
            float suf = 0.f;
            float aft[8];
#pragma unroll
            for (int i = 7; i >= 0; --i) { aft[i] = Rc + suf + (hi == 0 ? pg[i] : 0.f); suf += gs[i] + pg[i]; }
            Rc += suf;
#pragma unroll
            for (int hf = 0; hf < 2; ++hf)
#pragma unroll
                for (int g = 0; g < 4; ++g) { float a = aft[hf * 4 + g];
#pragma unroll
                    for (int i = 3; i >= 0; --i) { const int r = 4 * g + i; const float spm = hf ? p1[r] : p0[r]; const float wv = __expf(lz[hf * 16 + r] - a); a += spm;
                        if (hf) p1[r] = wv; else p0[r] = wv; } }
            bf16x8 pa0, pa1, pa2, pa3;
#define PK4(Pv, BASE, OUT) do { unsigned a0 = cvt_pk_bf16(Pv[BASE + 0], Pv[BASE + 1]), a1 = cvt_pk_bf16(Pv[BASE + 2], Pv[BASE + 3]);   \
    unsigned b0 = cvt_pk_bf16(Pv[BASE + 4], Pv[BASE + 5]), b1 = cvt_pk_bf16(Pv[BASE + 6], Pv[BASE + 7]);                              \
    auto r0 = __builtin_amdgcn_permlane32_swap(a0, b0, false, false); auto r1 = __builtin_amdgcn_permlane32_swap(a1, b1, false, false); \
    u32x4 w = {r0[0], r1[0], r0[1], r1[1]}; OUT = *reinterpret_cast<bf16x8*>(&w); } while (0)
            PK4(p0, 0, pa0); PK4(p0, 8, pa1); PK4(p1, 0, pa2); PK4(p1, 8, pa3);
#undef PK4
            SBAR();
            pv_one<0>(o[0], vb0, pa0, pa1, pa2, pa3); pv_one<1>(o[1], vb0, pa0, pa1, pa2, pa3); pv_one<2>(o[2], vb0, pa0, pa1, pa2, pa3); pv_one<3>(o[3], vb0, pa0, pa1, pa2, pa3);
            done = __all(Rc > 110.0f);
            if (done && lane == 0) flags[wid] = 1;
        }
        __syncthreads();
        int nd = 0;
#pragma unroll
        for (int w = 0; w < 8; ++w) nd += flags[w];
        if (nd == 8) break;
    }
    bf16_t* ob = P.mix + (tokbase + q0 + wid * 32) * 2048 + h * HD;
#pragma unroll
    for (int r = 0; r < 16; ++r) { const int orow = crow(r, hi);
#pragma unroll
        for (int d0 = 0; d0 < 4; ++d0) ob[(size_t)orow * 2048 + d0 * 32 + r32] = (bf16_t)(cvt_pk_bf16(o[d0][r], 0.f) & 0xffffu); }
    __syncthreads();
}

__device__ __forceinline__ float xhalf(float x, int hi) { const auto r = __builtin_amdgcn_permlane32_swap(__float_as_uint(x), __float_as_uint(x), false, false); return __uint_as_float(hi ? r[0] : r[1]); }
__device__ __forceinline__ float2 cmul(float2 a, float2 b) { return make_float2(a.x * b.x - a.y * b.y, a.x * b.y + a.y * b.x); }
__device__ __forceinline__ float2 cfma(float2 a, float2 x, float2 c) { return make_float2(a.x * x.x - a.y * x.y + c.x, a.x * x.y + a.y * x.x + c.y); }
template <bool OUT>
__device__ __forceinline__ void ssm_item(const Params& P, int item, LAS unsigned char* lds) {
    const int tid = threadIdx.x, wid = tid >> 6, lane = tid & 63, r32 = lane & 31, hi = lane >> 5, hh = lane & 15, kq = lane >> 4;
    const int g = item % NG, sc = (item / NG) % NSC, b = item / (NSC * NG);
    LAS unsigned* xs = (LAS unsigned*)(lds + wid * 8192);
    float2 a1[2], a2[2], a3[2], a4[2], cst[2]; bf16x8 bre[2], bim[2];
#pragma unroll
    for (int pb = 0; pb < 2; ++pb) { const int gp = g * NP + pb * 32 + r32;
        a1[pb] = P.abar[gp]; a2[pb] = cmul(a1[pb], a1[pb]); a3[pb] = cmul(a2[pb], a1[pb]); a4[pb] = cmul(a2[pb], a2[pb]);
        const float* bp = (const float*)(P.bbar + (size_t)gp * GH + 8 * hi); const f32x4 v0 = *(const f32x4*)bp, v1 = *(const f32x4*)(bp + 4), v2 = *(const f32x4*)(bp + 8), v3 = *(const f32x4*)(bp + 12);
        u32x4 wr_, wi_; wr_.x = cvt_pk_bf16(v0[0], v0[2]); wr_.y = cvt_pk_bf16(v1[0], v1[2]); wr_.z = cvt_pk_bf16(v2[0], v2[2]); wr_.w = cvt_pk_bf16(v3[0], v3[2]);
        wi_.x = cvt_pk_bf16(v0[1], v0[3]); wi_.y = cvt_pk_bf16(v1[1], v1[3]); wi_.z = cvt_pk_bf16(v2[1], v2[3]); wi_.w = cvt_pk_bf16(v3[1], v3[3]);
        bre[pb] = *(bf16x8*)&wr_; bim[pb] = *(bf16x8*)&wi_;
        cst[pb] = make_float2(0.f, 0.f);
        if (OUT) { const float2 aL = P.aL[gp]; const float2* ep = P.Est + ((size_t)(b * NG + g) * NSC) * NP + pb * 32 + r32; float2 e[NSC - 1];
#pragma unroll
            for (int cc = 0; cc < NSC - 1; ++cc) e[cc] = ep[(size_t)cc * NP];
#pragma unroll
            for (int cc = 0; cc < NSC - 1; ++cc) if (cc < sc) cst[pb] = cfma(aL, cst[pb], e[cc]); } }
    bf16x8 cf[4], dfr; float dsk = 0.f;
    if (OUT) {
#pragma unroll
        for (int s_ = 0; s_ < 4; ++s_) { const size_t ci = ((size_t)g * GH + hh) * NP + 16 * s_ + 4 * kq; const f32x4 cr = *(const f32x4*)(P.c_re + ci), cim = *(const f32x4*)(P.c_im + ci);
            u32x4 w; w.x = cvt_pk_bf16(cr[0], -cim[0]); w.y = cvt_pk_bf16(cr[1], -cim[1]); w.z = cvt_pk_bf16(cr[2], -cim[2]); w.w = cvt_pk_bf16(cr[3], -cim[3]); cf[s_] = *(bf16x8*)&w; }
        dsk = P.ssm_d[g * GH + hh];
        float dv[8];
#pragma unroll
        for (int j = 0; j < 8; ++j) dv[j] = (8 * kq + j == hh) ? dsk : 0.f;
        u32x4 w; w.x = cvt_pk_bf16(dv[0], dv[1]); w.y = cvt_pk_bf16(dv[2], dv[3]); w.z = cvt_pk_bf16(dv[4], dv[5]); w.w = cvt_pk_bf16(dv[6], dv[7]); dfr = *(bf16x8*)&w;
    }
    const float* ubase = P.u + ((size_t)b * SEQ + sc * SCH) * 1024 + g * GH;
    f32x4 un0 = *(const f32x4*)(ubase + (size_t)r32 * 1024 + 8 * hi), un1 = *(const f32x4*)(ubase + (size_t)r32 * 1024 + 8 * hi + 4);
    for (int blk = 0; blk < SCH / 32; ++blk) {
        u32x4 aw; aw.x = cvt_pk_bf16(un0[0], un0[1]); aw.y = cvt_pk_bf16(un0[2], un0[3]); aw.z = cvt_pk_bf16(un1[0], un1[1]); aw.w = cvt_pk_bf16(un1[2], un1[3]);
        bf16x8 Au = *(bf16x8*)&aw; mfma_operand_ready(Au);
        if (blk + 1 < SCH / 32) { const float* up = ubase + (size_t)((blk + 1) * 32 + r32) * 1024 + 8 * hi; un0 = *(const f32x4*)up; un1 = *(const f32x4*)(up + 4); }
#pragma unroll
        for (int pb = 0; pb < 2; ++pb) {
            f32x16 dre = __builtin_amdgcn_mfma_f32_32x32x16_bf16(Au, bre[pb], f32x16{}, 0, 0, 0);
            f32x16 dim = __builtin_amdgcn_mfma_f32_32x32x16_bf16(Au, bim[pb], f32x16{}, 0, 0, 0);
#pragma unroll
            for (int q = 0; q < 4; ++q)
#pragma unroll
                for (int i = 1; i < 4; ++i) { const float2 x = cfma(a1[pb], make_float2(dre[4 * q + i - 1], dim[4 * q + i - 1]), make_float2(dre[4 * q + i], dim[4 * q + i])); dre[4 * q + i] = x.x; dim[4 * q + i] = x.y; }
            float2 cin[4]; float2 cc = cst[pb];
#pragma unroll
            for (int q = 0; q < 4; ++q) { const float2 le = make_float2(dre[4 * q + 3], dim[4 * q + 3]);
                const float2 e0 = cfma(a4[pb], cc, le);
                const float2 pe0 = make_float2(xhalf(e0.x, hi), xhalf(e0.y, hi));
                const float2 e1 = cfma(a4[pb], pe0, le);
                const float2 pe1 = make_float2(xhalf(e1.x, hi), xhalf(e1.y, hi));
                cin[q] = hi ? pe0 : cc; cc = hi ? e1 : pe1; }
            cst[pb] = cc;
            if (OUT) {
#pragma unroll
                for (int q = 0; q < 4; ++q) { const float2 f1 = cmul(a1[pb], cin[q]), f2 = cmul(a2[pb], cin[q]), f3 = cmul(a3[pb], cin[q]), f4 = cmul(a4[pb], cin[q]);
                    const float2 x0 = make_float2(dre[4 * q + 0] + f1.x, dim[4 * q + 0] + f1.y), x1 = make_float2(dre[4 * q + 1] + f2.x, dim[4 * q + 1] + f2.y);
                    const float2 x2 = make_float2(dre[4 * q + 2] + f3.x, dim[4 * q + 2] + f3.y), x3 = make_float2(dre[4 * q + 3] + f4.x, dim[4 * q + 3] + f4.y);
                    LAS unsigned* xp = xs + (8 * q + 4 * hi) * 64 + pb * 32 + r32;
                    xp[0] = cvt_pk_bf16(x0.x, x0.y); xp[64] = cvt_pk_bf16(x1.x, x1.y); xp[128] = cvt_pk_bf16(x2.x, x2.y); xp[192] = cvt_pk_bf16(x3.x, x3.y); }
            }
        }
        if (OUT) {
            asm volatile("s_waitcnt lgkmcnt(0)" ::: "memory");
#pragma unroll
            for (int th = 0; th < 2; ++th) {
                f32x4 yacc = (f32x4){0.f, 0.f, 0.f, 0.f};
#pragma unroll
                for (int s_ = 0; s_ < 4; ++s_) { const bf16x8 af = *(const LAS bf16x8*)((const LAS unsigned char*)xs + (th * 16 + hh) * 256 + s_ * 64 + kq * 16);
                    yacc = __builtin_amdgcn_mfma_f32_16x16x32_bf16(af, cf[s_], yacc, 0, 0, 0); }
                u32x4 uw;
                { const float* up = ubase + (size_t)(blk * 32 + th * 16 + hh) * 1024 + 8 * (kq & 1); const f32x4 y0 = *(const f32x4*)up, y1 = *(const f32x4*)(up + 4);
                    uw.x = cvt_pk_bf16(y0[0], y0[1]); uw.y = cvt_pk_bf16(y0[2], y0[3]); uw.z = cvt_pk_bf16(y1[0], y1[1]); uw.w = cvt_pk_bf16(y1[2], y1[3]); }
                { bf16x8 ua = *(bf16x8*)&uw; mfma_operand_ready(ua); yacc = __builtin_amdgcn_mfma_f32_16x16x32_bf16(ua, dfr, yacc, 0, 0, 0); }
#pragma unroll
                for (int j = 0; j < 4; ++j) { const int t = blk * 32 + th * 16 + 4 * kq + j; const float yv = gelu_tanh(yacc[j]);
                    P.ybuf[((size_t)b * SEQ + sc * SCH + t) * 1024 + g * GH + hh] = (bf16_t)(cvt_pk_bf16(yv, 0.f) & 0xffffu); }
            }
            asm volatile("s_waitcnt lgkmcnt(0)" ::: "memory");
        }
    }
    if (!OUT) { if (hi == 0) {
#pragma unroll
        for (int pb = 0; pb < 2; ++pb) P.Est[((size_t)(b * NG + g) * NSC + sc) * NP + pb * 32 + r32] = cst[pb]; } }
}

__device__ void phase_mixnorm(const Params& P) {
    const int tid = threadIdx.x, wid = tid >> 6, lane = tid & 63, G = gridDim.x;
    for (int row = blockIdx.x * 8 + wid; row < T_; row += G * 8) {
        const bf16_t* mp = P.mix + (size_t)row * 2048; u32x4 v[4]; float ssa = 0.f, ssb = 0.f;
#pragma unroll
        for (int i = 0; i < 4; ++i) { v[i] = *(const u32x4*)(mp + lane * 8 + 512 * i);
            const float s = bf_lo(v[i].x) * bf_lo(v[i].x) + bf_hi(v[i].x) * bf_hi(v[i].x) + bf_lo(v[i].y) * bf_lo(v[i].y) + bf_hi(v[i].y) * bf_hi(v[i].y) + bf_lo(v[i].z) * bf_lo(v[i].z) + bf_hi(v[i].z) * bf_hi(v[i].z) + bf_lo(v[i].w) * bf_lo(v[i].w) + bf_hi(v[i].w) * bf_hi(v[i].w);
            if (i < 2) ssa += s; else ssb += s; }
        ssa = wave_sum(ssa); ssb = wave_sum(ssb);
        const float ra = rsqrtf(ssa * (1.0f / 1024) + EPS), rb = rsqrtf(ssb * (1.0f / 1024) + EPS);
#pragma unroll
        for (int i = 0; i < 4; ++i) { const float r = i < 2 ? ra : rb; u32x4 w;
            w.x = cvt_pk_bf16(bf_lo(v[i].x) * r, bf_hi(v[i].x) * r); w.y = cvt_pk_bf16(bf_lo(v[i].y) * r, bf_hi(v[i].y) * r);
            w.z = cvt_pk_bf16(bf_lo(v[i].z) * r, bf_hi(v[i].z) * r); w.w = cvt_pk_bf16(bf_lo(v[i].w) * r, bf_hi(v[i].w) * r);
            *(u32x4*)(P.R1 + (size_t)row * 2048 + lane * 8 + 512 * i) = w; }
    }
}

__device__ void phase_router(const Params& P, LAS unsigned char* lds) {
    const int tid = threadIdx.x, wid = tid >> 6, lane = tid & 63, r32 = lane & 31, kh = lane >> 5, G = gridDim.x;
    LAS float* part = (LAS float*)lds;
    LAS float* ssq = (LAS float*)(lds + 65536);
    LAS float* rinv = (LAS float*)(lds + 65536 + 1024);
    LAS int* lsel = (LAS int*)(lds + 65536 + 2048); LAS int* lrank = lsel + 32 * TOPK;
    for (int unit = blockIdx.x; unit < T_ / 32; unit += G) {
        const int tok0 = unit * 32;
        f32x16 acc0 = f32x16{}, acc1 = f32x16{}; float ss = 0.f;
        const float* ap = P.h1 + (size_t)(tok0 + r32) * DM + 256 * wid + 8 * kh;
        const bf16_t* bh = P.Wr_hi + (size_t)r32 * DM + 256 * wid + 8 * kh; const bf16_t* bl = P.Wr_lo + (size_t)r32 * DM + 256 * wid + 8 * kh;
#pragma unroll 4
        for (int s_ = 0; s_ < 16; ++s_) {
            const f32x4 x0 = *(const f32x4*)(ap + 16 * s_), x1 = *(const f32x4*)(ap + 16 * s_ + 4);
            ss += x0[0] * x0[0] + x0[1] * x0[1] + x0[2] * x0[2] + x0[3] * x0[3] + x1[0] * x1[0] + x1[1] * x1[1] + x1[2] * x1[2] + x1[3] * x1[3];
            u32x4 hw, lw;
            hw.x = cvt_pk_bf16(x0[0], x0[1]); hw.y = cvt_pk_bf16(x0[2], x0[3]); hw.z = cvt_pk_bf16(x1[0], x1[1]); hw.w = cvt_pk_bf16(x1[2], x1[3]);
            lw.x = cvt_pk_bf16(x0[0] - bf_lo(hw.x), x0[1] - bf_hi(hw.x)); lw.y = cvt_pk_bf16(x0[2] - bf_lo(hw.y), x0[3] - bf_hi(hw.y));
            lw.z = cvt_pk_bf16(x1[0] - bf_lo(hw.z), x1[1] - bf_hi(hw.z)); lw.w = cvt_pk_bf16(x1[2] - bf_lo(hw.w), x1[3] - bf_hi(hw.w));
            bf16x8 Ah = *(bf16x8*)&hw, Al = *(bf16x8*)&lw; mfma_operand_ready(Ah, Al);
            const bf16x8 Bh0 = *(const bf16x8*)(bh + 16 * s_), Bh1 = *(const bf16x8*)(bh + (size_t)32 * DM + 16 * s_);
            const bf16x8 Bl0 = *(const bf16x8*)(bl + 16 * s_), Bl1 = *(const bf16x8*)(bl + (size_t)32 * DM + 16 * s_);
            acc0 = __builtin_amdgcn_mfma_f32_32x32x16_bf16(Ah, Bh0, acc0, 0, 0, 0); acc1 = __builtin_amdgcn_mfma_f32_32x32x16_bf16(Ah, Bh1, acc1, 0, 0, 0);
            acc0 = __builtin_amdgcn_mfma_f32_32x32x16_bf16(Ah, Bl0, acc0, 0, 0, 0); acc1 = __builtin_amdgcn_mfma_f32_32x32x16_bf16(Ah, Bl1, acc1, 0, 0, 0);
            acc0 = __builtin_amdgcn_mfma_f32_32x32x16_bf16(Al, Bh0, acc0, 0, 0, 0); acc1 = __builtin_amdgcn_mfma_f32_32x32x16_bf16(Al, Bh1, acc1, 0, 0, 0);
        }
#pragma unroll
        for (int r = 0; r < 16; ++r) { const int tl = crow(r, kh); part[(wid * 32 + tl) * 64 + r32] = acc0[r]; part[(wid * 32 + tl) * 64 + 32 + r32] = acc1[r]; }
        ss += __shfl_xor(ss, 32); if (kh == 0) ssq[wid * 32 + r32] = ss;
        __syncthreads();
        if (tid < 32) { float sq = 0.f;
#pragma unroll
            for (int w = 0; w < 8; ++w) sq += ssq[w * 32 + tid];
            rinv[tid] = rsqrtf(sq * (1.0f / DM) + EPS); }
        __syncthreads();
        int selE[4]; float selG[4];
#pragma unroll
        for (int tt = 0; tt < 4; ++tt) { const int tl = 4 * wid + tt; float lg = 0.f;
#pragma unroll
            for (int w = 0; w < 8; ++w) lg += part[(w * 32 + tl) * 64 + lane];
            lg *= rinv[tl];
            const float score = 1.0f / (1.0f + expf(-lg)); float selv = score + P.router_bias[lane];
            int myE = 0; float myG = 0.f, gsum = 0.f;
#pragma unroll
            for (int j = 0; j < TOPK; ++j) { const float mx = wave_max(selv); const unsigned long long bal = __ballot(selv == mx); const int first = __builtin_amdgcn_readfirstlane((int)__builtin_ctzll(bal));
                const float gsel = __shfl(score, first); gsum += gsel; if (lane == j) { myE = first; myG = gsel; } if (lane == first) selv = -3.0e38f; }
            selE[tt] = myE; selG[tt] = myG / gsum * 2.5f;
            if (lane < TOPK) lsel[tl * TOPK + lane] = myE; }
        __syncthreads();
        if (wid == 0) { int cn = 0;
            for (int i = 0; i < 32 * TOPK; ++i) { const int se = lsel[i]; if (se == lane) { lrank[i] = cn; ++cn; } }
            P.cntw[unit * NE + lane] = cn; }
        __syncthreads();
        if (lane < TOPK) {
#pragma unroll
            for (int tt = 0; tt < 4; ++tt) { const int tl = 4 * wid + tt, tok = tok0 + tl;
                P.sel_e[tok * TOPK + lane] = selE[tt]; P.sel_pos[tok * TOPK + lane] = lrank[tl * TOPK + lane]; P.sel_gate[tok * TOPK + lane] = selG[tt]; } }
#pragma unroll
        for (int tt = 0; tt < 4; ++tt) { const int tl = 4 * wid + tt; const float r = rinv[tl]; const float* hp = P.h1 + (size_t)(tok0 + tl) * DM;
#pragma unroll
            for (int i = 0; i < 8; ++i) { const f32x4 v = *(const f32x4*)(hp + 4 * lane + 256 * i); const f32x4 gn = *(const f32x4*)(P.norm_ffn + 4 * lane + 256 * i); const f32x4 mv = v * r * gn;
                u32x2 w; w.x = cvt_pk_bf16(mv[0], mv[1]); w.y = cvt_pk_bf16(mv[2], mv[3]); *(u32x2*)(P.R1 + (size_t)(tok0 + tl) * DM + 4 * lane + 256 * i) = w; } }
        __syncthreads();
    }
}

constexpr int NU = T_ / 32;
__device__ __forceinline__ void moe_sum_units(const Params& P, LAS int* tmp, LAS int* out, int ulim) {
    const int e = threadIdx.x & 63, part = threadIdx.x >> 6; int sacc = 0;
#pragma unroll 8
    for (int i = 0; i < NU / 8; ++i) { const int v = part * (NU / 8) + i; const int cv = P.cntw[v * NE + e]; sacc += (v < ulim) ? cv : 0; }
    tmp[part * 64 + e] = sacc;
    __syncthreads();
    if (threadIdx.x < NE) { int tot = 0;
#pragma unroll
        for (int p = 0; p < 8; ++p) tot += tmp[p * 64 + threadIdx.x];
        out[threadIdx.x] = tot; }
    __syncthreads();
}
__device__ int build_moe_tables(const Params& P, LAS unsigned char* lds) {
    LAS int* rt_e = (LAS int*)(lds + LDS_TAB); LAS int* rt_j = rt_e + 256; volatile LAS int* nrt = (volatile LAS int*)(rt_e + 512); LAS int* rt_n = rt_e + 640;
    __syncthreads();
    if (threadIdx.x < NE) { const int e = threadIdx.x; const int n = (int)P.cnt[e]; const int ntile = (n + 255) >> 8; int pre = ntile;
#pragma unroll
        for (int o = 1; o < 64; o <<= 1) { const int t = __shfl_up(pre, o); if (e >= o) pre += t; }
        const int rt = pre - ntile;
        for (int j = 0; j < ntile; ++j) if (rt + j < 256) { rt_e[rt + j] = e; rt_j[rt + j] = j; rt_n[rt + j] = (n - j * 256) < 256 ? (n - j * 256) : 256; }
        if (e == NE - 1) *nrt = pre < 256 ? pre : 256; }
    __syncthreads();
    return *nrt;
}
__device__ void moe_scatter(const Params& P, LAS unsigned char* lds) {
    LAS int* bs = (LAS int*)(lds + LDS_TAB + 2100);
    const int tid = threadIdx.x, G = gridDim.x;
    for (int u = blockIdx.x; u < NU; u += G) {
        __syncthreads();
        moe_sum_units(P, (LAS int*)lds, bs, u);
        if (tid < NE) { P.basew[u * NE + tid] = bs[tid]; if (u == NU - 1) P.cnt[tid] = (unsigned)(bs[tid] + P.cntw[u * NE + tid]); }
        if (tid < 32 * TOPK) { const int tok = u * 32 + tid / TOPK, k = tid % TOPK; const int e = P.sel_e[tok * TOPK + k], loc = P.sel_pos[tok * TOPK + k];
            __hip_atomic_store(&P.tok_of_row[(size_t)e * CAP + bs[e] + loc], tok, __ATOMIC_RELAXED, __HIP_MEMORY_SCOPE_AGENT); }
    }
}

__device__ void phase_combine(const Params& P, LAS unsigned char* lds) {
    const int tid = threadIdx.x, wid = tid >> 6, lane = tid & 63, G = gridDim.x;
    LAS int* rt0 = (LAS int*)(lds + LDS_TAB);
    __syncthreads();
    if (tid < NE) { const int ntile = ((int)P.cnt[tid] + 255) >> 8; int pre = ntile;
#pragma unroll
        for (int o = 1; o < 64; o <<= 1) { const int t = __shfl_up(pre, o); if (tid >= o) pre += t; }
        rt0[tid] = pre - ntile; }
    __syncthreads();
    for (int row = blockIdx.x * 8 + wid; row < T_; row += G * 8) {
        int crw = 0; float gte = 0.f;
        if (lane < TOPK) { const int e = P.sel_e[row * TOPK + lane]; crw = rt0[e] * 256 + P.basew[(row >> 5) * NE + e] + P.sel_pos[row * TOPK + lane]; gte = P.sel_gate[row * TOPK + lane]; }
        float hv[4][8]; float ss = 0.f;
#pragma unroll
        for (int i = 0; i < 4; ++i) { const size_t o = (size_t)row * DM + lane * 8 + 512 * i; const f32x4 a = *(const f32x4*)(P.h1 + o), b2 = *(const f32x4*)(P.h1 + o + 4);
            hv[i][0] = a[0]; hv[i][1] = a[1]; hv[i][2] = a[2]; hv[i][3] = a[3]; hv[i][4] = b2[0]; hv[i][5] = b2[1]; hv[i][6] = b2[2]; hv[i][7] = b2[3];
            const u32x4 sv = *(const u32x4*)(P.Ysh + o);
            hv[i][0] += bf_lo(sv.x); hv[i][1] += bf_hi(sv.x); hv[i][2] += bf_lo(sv.y); hv[i][3] += bf_hi(sv.y); hv[i][4] += bf_lo(sv.z); hv[i][5] += bf_hi(sv.z); hv[i][6] += bf_lo(sv.w); hv[i][7] += bf_hi(sv.w); }
#pragma unroll
        for (int k = 0; k < TOPK; ++k) { const int cr = __builtin_amdgcn_readlane(crw, k); const float gt = __uint_as_float((unsigned)__builtin_amdgcn_readlane((int)__float_as_uint(gte), k)); const bf16_t* yp = P.Y + (size_t)cr * DM + lane * 8;
#pragma unroll
            for (int i = 0; i < 4; ++i) { const u32x4 y = *(const u32x4*)(yp + 512 * i);
                hv[i][0] += gt * bf_lo(y.x); hv[i][1] += gt * bf_hi(y.x); hv[i][2] += gt * bf_lo(y.y); hv[i][3] += gt * bf_hi(y.y); hv[i][4] += gt * bf_lo(y.z); hv[i][5] += gt * bf_hi(y.z); hv[i][6] += gt * bf_lo(y.w); hv[i][7] += gt * bf_hi(y.w); } }
#pragma unroll
        for (int i = 0; i < 4; ++i)
#pragma unroll
            for (int j = 0; j < 8; ++j) ss += hv[i][j] * hv[i][j];
        ss = wave_sum(ss); const float r = rsqrtf(ss * (1.0f / DM) + EPS);
#pragma unroll
        for (int i = 0; i < 4; ++i) { const size_t o = (size_t)row * DM + lane * 8 + 512 * i;
            *(f32x4*)(P.h1 + o) = (f32x4){hv[i][0], hv[i][1], hv[i][2], hv[i][3]}; *(f32x4*)(P.h1 + o + 4) = (f32x4){hv[i][4], hv[i][5], hv[i][6], hv[i][7]};
            u32x4 w; w.x = cvt_pk_bf16(hv[i][0] * r, hv[i][1] * r); w.y = cvt_pk_bf16(hv[i][2] * r, hv[i][3] * r); w.z = cvt_pk_bf16(hv[i][4] * r, hv[i][5] * r); w.w = cvt_pk_bf16(hv[i][6] * r, hv[i][7] * r);
            *(u32x4*)(P.R3 + o) = w; }
    }
}

constexpr int NPHASE = 13;
__global__ void __launch_bounds__(512, 2) fwd(Params P) {
    extern __shared__ __attribute__((aligned(16))) unsigned char shm_raw[];
    LAS unsigned char* lds = (LAS unsigned char*)shm_raw;
    const int G = gridDim.x, c = blockIdx.x;
    for (int i = threadIdx.x; i < LDS_BYTES / 16; i += 512) ((LAS u32x4*)lds)[i] = (u32x4){0u, 0u, 0u, 0u};
    __syncthreads();
    XcdBarrier bar; bar.bar = P.bar; bar.x = 0; bar.st = (volatile LAS unsigned*)(lds + LDS_BARW);
    const int lo = (int)P.ph_lo, hi = (int)P.ph_hi;
    if (hi - lo > 1) bar = xcd_barrier_post(P.bar, (volatile LAS unsigned*)(lds + LDS_BARW));
#define RUN(k) (lo <= (k) && (k) < hi)
#define SEAM(k) do { if (lo <= (k) && (k) + 1 < hi) xcd_barrier(bar); } while (0)
    auto phase_fn_0 = [&]() {
    if (RUN(0)) phase_prologue(P, lds);
    };
    phase_fn_0();
#if REP_PHASE == 0
    xcd_barrier(bar); phase_fn_0();
#endif
    SEAM(0);
    auto phase_fn_1 = [&]() {
    if (RUN(1)) { pg8::StaticOrder S; S.init(T_, NZ, DM, G, c); pg8::Gemm g{P.R1, P.Wt_in, DM, nullptr}; EpiQKVU E{P.zq, P.u}; pg8::gemm_phase<EpiQKVU, pg8::StaticOrder, false>(lds, g, S, E); }
    };
    phase_fn_1();
#if REP_PHASE == 1
    xcd_barrier(bar); phase_fn_1();
#endif
    SEAM(1);
    auto phase_fn_2 = [&]() {
    if (RUN(2)) {
        for (int u = c; u < NB * NHEAD * 8; u += G) attn_unit(P, u, lds);
        for (int it = c * 8 + (threadIdx.x >> 6); it < NB * NG * NSC; it += G * 8) ssm_item<false>(P, it, lds);
    }
    };
    phase_fn_2();
#if REP_PHASE == 2
    xcd_barrier(bar); phase_fn_2();
#endif
    SEAM(2);
    auto phase_fn_3 = [&]() {
    if (RUN(3)) { for (int it = c * 8 + (threadIdx.x >> 6); it < NB * NG * NSC; it += G * 8) ssm_item<true>(P, it, lds); }
    };
    phase_fn_3();
#if REP_PHASE == 3
    xcd_barrier(bar); phase_fn_3();
#endif
    SEAM(3);
    auto phase_fn_4 = [&]() {
    if (RUN(4)) {
        const int nglu = (T_ / 256) * (1024 / 256);
        if (G < 2 * nglu || c < nglu) { pg8::StaticOrder S; S.init(T_, 1024, 1024, G, c); pg8::Gemm g{P.ybuf, P.Wt_glu, 1024, nullptr}; EpiGLU E{P.ybuf, P.mix}; pg8::gemm_phase<EpiGLU, pg8::StaticOrder, false>(lds, g, S, E); }
        if (G < 2 * nglu || c >= nglu) { pg8::StaticOrder S; if (G < 2 * nglu) S.init(T_, DM, DPLE, G, c); else S.init(T_, DM, DPLE, G - nglu, c - nglu);
            pg8::Gemm g{P.pb, P.Wt_pp, DPLE, nullptr}; EpiBf16 E{P.proj, DM}; pg8::gemm_phase<EpiBf16, pg8::StaticOrder, false>(lds, g, S, E); }
    }
    };
    phase_fn_4();
#if REP_PHASE == 4
    xcd_barrier(bar); phase_fn_4();
#endif
    SEAM(4);
#if REP_PHASE == 100
    xcd_barrier(bar); xcd_barrier(bar); xcd_barrier(bar); xcd_barrier(bar);
#endif
    auto phase_fn_5 = [&]() {
    if (RUN(5)) phase_mixnorm(P);
    };
    phase_fn_5();
#if REP_PHASE == 5
    xcd_barrier(bar); phase_fn_5();
#endif
    SEAM(5);
    auto phase_fn_6 = [&]() {
    if (RUN(6)) { pg8::StaticOrder S; S.init(T_, DM, DM, G, c); pg8::Gemm g{P.R1, P.Wt_out, DM, nullptr}; EpiRes E{P.x, P.h1}; pg8::gemm_phase<EpiRes, pg8::StaticOrder, false>(lds, g, S, E); }
    };
    phase_fn_6();
#if REP_PHASE == 6
    xcd_barrier(bar); phase_fn_6();
#endif
    SEAM(6);
    auto phase_fn_7 = [&]() {
    if (RUN(7)) phase_router(P, lds);
    };
    phase_fn_7();
#if REP_PHASE == 7
    xcd_barrier(bar); if (blockIdx.x == 0 && threadIdx.x < NE) P.cnt[threadIdx.x * 64] = 0u; xcd_barrier(bar); phase_fn_7();
#endif
    SEAM(7);
    auto phase_fn_8 = [&]() {
    if (RUN(8)) { moe_scatter(P, lds); if (hi - lo > 1) xcd_barrier(bar);
        const int n_rt = build_moe_tables(P, lds);
        MoeSched S; S.G = G; S.c = c; S.n_rt = n_rt; S.NPN = 4; S.K = DM; S.down = false; S.rt_e = (const LAS int*)(lds + LDS_TAB); S.rt_j = S.rt_e + 256; S.rt_n = S.rt_e + 640;
        pg8::Gemm g{P.R1, P.Wt_egu, DM, P.tok_of_row}; EpiSwiGLU E{P.H, P.Hs};
        pg8::gemm_phase<EpiSwiGLU, MoeSched, true>(lds, g, S, E); }
    };
    phase_fn_8();
#if REP_PHASE == 8
    xcd_barrier(bar); phase_fn_8();
#endif
    SEAM(8);
    auto phase_fn_9 = [&]() {
    if (RUN(9)) { const int n_rt = build_moe_tables(P, lds);
        for (int j = (c >> 3) & 7; j > 0; --j) __builtin_amdgcn_s_sleep(37);
        MoeSched S; S.G = G; S.c = c; S.n_rt = n_rt; S.NPN = 8; S.K = DE; S.down = true; S.rt_e = (const LAS int*)(lds + LDS_TAB); S.rt_j = S.rt_e + 256; S.rt_n = S.rt_e + 640;
        pg8::Gemm g{P.H, P.Wt_ed, DE, nullptr}; EpiDown E{P.Y, P.Ysh};
        pg8::gemm_phase<EpiDown, MoeSched, false>(lds, g, S, E); }
    };
    phase_fn_9();
#if REP_PHASE == 9
    xcd_barrier(bar); phase_fn_9();
#endif
    SEAM(9);
    auto phase_fn_10 = [&]() {
    if (RUN(10)) phase_combine(P, lds);
    };
    phase_fn_10();
#if REP_PHASE == 10
    xcd_barrier(bar); phase_fn_10();
#endif
    SEAM(10);
    auto phase_fn_11 = [&]() {
    (void)0;
    };
    phase_fn_11();
#if REP_PHASE == 11
    xcd_barrier(bar); phase_fn_11();
#endif
    auto phase_fn_12 = [&]() {
    if (RUN(12)) { pg8::StaticOrder S; S.init(T_, DM, DM, G, c); pg8::Gemm g{P.R3, P.Wt_pg, DM, nullptr}; EpiPle E{P.out, P.proj, P.h1}; pg8::gemm_phase<EpiPle, pg8::StaticOrder, false>(lds, g, S, E); }
    };
    phase_fn_12();
#if REP_PHASE == 12
    xcd_barrier(bar); phase_fn_12();
#endif
#undef RUN
#undef SEAM
}

extern "C" void kernel_launch(void* const* d_in, const int* in_sizes, int n_in, void* d_out, int out_size, void* d_ws, size_t ws_size, hipStream_t stream) {
    static int grid = 0;
    size_t off = 0;
    auto take = [&](size_t bytes) { const size_t o = off; off += (bytes + 255) & ~(size_t)255; return o; };
    const size_t o_ctl = take(32768);
    const size_t o_Wt_in = take((size_t)4096 * 2048 * 2), o_Wt_glu = take((size_t)1024 * 1024 * 2), o_Wt_out = take((size_t)2048 * 2048 * 2), o_Wt_pg = take((size_t)2048 * 2048 * 2),
                 o_Wt_pp = take((size_t)2048 * 256 * 2), o_Wt_egu = take((size_t)(NE + 1) * 1024 * 2048 * 2), o_Wt_ed = take((size_t)(NE + 1) * 2048 * 512 * 2);
    const size_t o_R1 = take((size_t)(T_ + 1) * DM * 2), o_h1 = take((size_t)T_ * DM * 4), o_tok = take((size_t)NE * CAP * 4), o_sele = take((size_t)T_ * TOPK * 4), o_selp = take((size_t)T_ * TOPK * 4),
                 o_selg = take((size_t)T_ * TOPK * 4), o_cntw = take((size_t)(T_ / 32) * NE * 4), o_basew = take((size_t)(T_ / 32) * NE * 4), o_H = take((size_t)(65536 + T_) * DE * 2), o_Ysh = take((size_t)T_ * DM * 2), o_proj = take((size_t)T_ * DM * 2), o_pb = take((size_t)T_ * DPLE * 2),
                 o_abar = take((size_t)NG * NP * 8), o_aL = take((size_t)NG * NP * 8), o_bbar = take((size_t)NG * NP * GH * 8), o_wrh = take((size_t)NE * DM * 2), o_wrl = take((size_t)NE * DM * 2), o_R3 = take((size_t)T_ * DM * 2);
    const size_t o_Y = take((size_t)65536 * DM * 2);
    size_t off2 = o_Y; auto take2 = [&](size_t bytes) { const size_t o = off2; off2 += (bytes + 255) & ~(size_t)255; return o; };
    const size_t o_zq = take2((size_t)T_ * 3072 * 2), o_u = take2((size_t)T_ * 1024 * 4), o_mix = take2((size_t)T_ * 2048 * 2), o_y = take2((size_t)T_ * 1024 * 2), o_E = take2((size_t)NB * NG * NSC * NP * 8);
    const size_t ws_need = off > off2 ? off : off2;
    if (grid == 0) {
        if (n_in != 30 || in_sizes[0] != T_ * DM || out_size != T_ * DM || ws_size < ws_need) {
            fprintf(stderr, "kernel_launch: unexpected shapes: n_in %d in0 %d out %d ws %zu (need %zu); nothing launched\n", n_in, n_in > 0 ? in_sizes[0] : -1, out_size, ws_size, ws_need); grid = -1; return; }
        int dev = 0, cus = 0, per_cu = 0;
        if (hipGetDevice(&dev) != hipSuccess || hipDeviceGetAttribute(&cus, hipDeviceAttributeMultiprocessorCount, dev) != hipSuccess) { fprintf(stderr, "kernel_launch: device query failed\n"); grid = -1; return; }
        if (hipFuncSetAttribute((const void*)fwd, hipFuncAttributeMaxDynamicSharedMemorySize, LDS_BYTES) != hipSuccess) { fprintf(stderr, "kernel_launch: hipFuncSetAttribute failed\n"); grid = -1; return; }
        if (hipOccupancyMaxActiveBlocksPerMultiprocessor(&per_cu, (const void*)fwd, 512, LDS_BYTES) != hipSuccess || per_cu < 1) fprintf(stderr, "kernel_launch: note: occupancy query reports %d\n", per_cu);
        (void)hipGetLastError();
        grid = cus;
    }
    if (grid < 0) return;
    char* ws = (char*)d_ws;
    if (hipMemsetAsync(ws + o_ctl, 0, 32768, stream) != hipSuccess) { fprintf(stderr, "kernel_launch: memset failed\n"); return; }
    Params P; memset(&P, 0, sizeof(P));
    const float** inp = &P.x;
    for (int i = 0; i < 30; ++i) inp[i] = (const float*)d_in[i];
    P.out = (float*)d_out;
    P.bar = (unsigned*)(ws + o_ctl); P.cnt = (unsigned*)(ws + o_ctl + 16384);
    P.Wt_in = (bf16_t*)(ws + o_Wt_in); P.Wt_glu = (bf16_t*)(ws + o_Wt_glu); P.Wt_out = (bf16_t*)(ws + o_Wt_out); P.Wt_pg = (bf16_t*)(ws + o_Wt_pg); P.Wt_pp = (bf16_t*)(ws + o_Wt_pp);
    P.Wt_egu = (bf16_t*)(ws + o_Wt_egu); P.Wt_ed = (bf16_t*)(ws + o_Wt_ed);
    P.R3 = (bf16_t*)(ws + o_R3); P.R1 = (bf16_t*)(ws + o_R1); P.zq = (bf16_t*)(ws + o_zq); P.mix = (bf16_t*)(ws + o_mix); P.ybuf = (bf16_t*)(ws + o_y);
    P.H = (bf16_t*)(ws + o_H); P.Hs = P.H + (size_t)65536 * DE; P.Y = (bf16_t*)(ws + o_Y); P.Ysh = (bf16_t*)(ws + o_Ysh); P.proj = (bf16_t*)(ws + o_proj); P.pb = (bf16_t*)(ws + o_pb);
    P.u = (float*)(ws + o_u); P.h1 = (float*)(ws + o_h1); P.sel_gate = (float*)(ws + o_selg);
    P.Est = (float2*)(ws + o_E); P.abar = (float2*)(ws + o_abar); P.aL = (float2*)(ws + o_aL); P.bbar = (float2*)(ws + o_bbar);
    P.tok_of_row = (int*)(ws + o_tok); P.sel_e = (int*)(ws + o_sele); P.sel_pos = (int*)(ws + o_selp); P.cntw = (int*)(ws + o_cntw); P.basew = (int*)(ws + o_basew); P.Wr_hi = (bf16_t*)(ws + o_wrh); P.Wr_lo = (bf16_t*)(ws + o_wrl);
#if MK_LAUNCHES == 1
    P.ph_lo = 0; P.ph_hi = NPHASE;
    hipLaunchKernelGGL(fwd, dim3(grid), dim3(512), LDS_BYTES, stream, P);
#else
    for (int k = 0; k < NPHASE; ++k) { P.ph_lo = k; P.ph_hi = k + 1; hipLaunchKernelGGL(fwd, dim3(grid), dim3(512), LDS_BYTES, stream, P); }
#endif
    const hipError_t le = hipPeekAtLastError();
    if (le != hipSuccess) fprintf(stderr, "kernel_launch: launch failed: %s\n", hipGetErrorName(le));
}
```
